# Optimizing an MI355X kernel written in HIP

```python
import jax, jax.numpy as jnp
from jax import lax
import numpy as np

D_MODEL = 1024
BATCH = 8
SEQ = 2048
DEPTH = 2
DEC_BATCH = 128
DEC_SEQ = 8
PAST_LEN = 16384
PAGE_SIZE = 128

N_MIXERS = 2
N_RWKV = (DEPTH + 1) // 2
N_CONV = DEPTH // 2
N_META = 16
HEAD_DIM = 64
N_HEADS = D_MODEL // HEAD_DIM
D_DECAY_LORA = 64
D_AAA_LORA = 64
D_GATE_LORA = 160
D_FF = 2816
CONV_W = 3
RMS_EPS = 1e-6
GN_EPS = 64e-5

kernel_name = "rwkv7_shortconv_macaron_hybrid_step"


def _rmsnorm(x, g):
    x32 = x.astype(jnp.float32)
    y = x32 * lax.rsqrt(jnp.mean(x32 * x32, axis=-1, keepdims=True) + RMS_EPS)
    return (y * g.astype(jnp.float32)).astype(x.dtype)


def _swiglu(x, w_gu, w_down):
    gate, up = jnp.split(x @ w_gu, 2, axis=-1)
    return (jax.nn.silu(gate) * up) @ w_down


def _rwkv7_time_mix(h, wkv0, shift0, mu, w_rkv, w0, w1, w2, a0, a1, a2, g1, g2,
                    k_k, k_a, r_k, ln_w, ln_b, w_o):
    bsz, t_len, _ = h.shape
    f32 = jnp.float32
    prev = jnp.concatenate([shift0[:, None, :].astype(h.dtype), h[:, :-1]], axis=1)
    xx = prev - h
    xr, xw, xk, xv, xa, xg = [h + xx * mu[c] for c in range(6)]
    r = xr @ w_rkv[0]
    k = xk @ w_rkv[1]
    v = xv @ w_rkv[2]
    w = -jax.nn.softplus(-(w0 + jnp.tanh(xw @ w1) @ w2)) - 0.5
    decay = jnp.exp(-jnp.exp(w.astype(f32)))
    a = jax.nn.sigmoid(a0 + (xa @ a1) @ a2)
    g = jax.nn.sigmoid(xg @ g1) @ g2
    kk = (k * k_k).astype(f32).reshape(bsz, t_len, N_HEADS, HEAD_DIM)
    kk = kk / jnp.maximum(jnp.linalg.norm(kk, axis=-1, keepdims=True), 1e-12)
    k = k * (1.0 + (a - 1.0) * k_a)

    def heads(z):
        return z.astype(f32).reshape(bsz, t_len, N_HEADS, HEAD_DIM)

    r_h, k_h, v_h, a_h, d_h = heads(r), heads(k), heads(v), heads(a), heads(decay)
    b_h = kk * a_h

    def step(S, inp):
        r_t, d_t, k_t, v_t, kk_t, b_t = inp
        S = (S * d_t[..., None, :]
             + jnp.einsum('bhij,bhj->bhi', S, -kk_t)[..., None] * b_t[..., None, :]
             + v_t[..., :, None] * k_t[..., None, :])
        return S, jnp.einsum('bhij,bhj->bhi', S, r_t)

    tm = lambda z: jnp.swapaxes(z, 0, 1)
    S_fin, ys = lax.scan(step, wkv0.astype(f32),
                         (tm(r_h), tm(d_h), tm(k_h), tm(v_h), tm(kk), tm(b_h)))
    y = tm(ys)
    mean = jnp.mean(y, axis=-1, keepdims=True)
    var = jnp.mean(jnp.square(y - mean), axis=-1, keepdims=True)
    yn = ((y - mean) * lax.rsqrt(var + GN_EPS)).reshape(bsz, t_len, D_MODEL)
    yn = yn * ln_w.astype(f32) + ln_b.astype(f32)
    bonus = jnp.sum(r_h * k_h * r_k.astype(f32), axis=-1, keepdims=True) * v_h
    o = ((yn + bonus.reshape(bsz, t_len, D_MODEL)) * g.astype(f32)).astype(h.dtype)
    return o @ w_o, S_fin.astype(wkv0.dtype), h[:, -1].astype(shift0.dtype)


def _short_conv_mix(h, conv0, w_in, conv_w, w_out):
    t_len = h.shape[1]
    gate_b, gate_c, xin = jnp.split(h @ w_in, 3, axis=-1)
    u = gate_c * xin
    pad = jnp.concatenate([conv0.astype(u.dtype), u], axis=1)
    conv = pad[:, 0:t_len] * conv_w[0] + pad[:, 1:t_len + 1] * conv_w[1] + pad[:, 2:t_len + 2] * conv_w[2]
    return (gate_b * conv) @ w_out, pad[:, -(CONV_W - 1):].astype(conv0.dtype)


def _trunk(x, wkv_in, shift_in, conv_in, p):
    new_wkv, new_shift, new_conv = [], [], []
    for i in range(DEPTH):
        x = x + 0.5 * _swiglu(_rmsnorm(x, p['ffn_norm'][i, 0]), p['ffn_w_gu'][i, 0], p['ffn_w_down'][i, 0])
        hn = _rmsnorm(x, p['mix_norm'][i])
        j = i // N_MIXERS
        if i % N_MIXERS == 0:
            out, s_wkv, s_shift = _rwkv7_time_mix(
                hn, wkv_in[j], shift_in[j], p['rk_mu'][j], p['rk_w_rkv'][j], p['rk_w0'][j],
                p['rk_w1'][j], p['rk_w2'][j], p['rk_a0'][j], p['rk_a1'][j], p['rk_a2'][j],
                p['rk_g1'][j], p['rk_g2'][j], p['rk_k_k'][j], p['rk_k_a'][j], p['rk_r_k'][j],
                p['rk_ln_w'][j], p['rk_ln_b'][j], p['rk_w_o'][j])
            new_wkv.append(s_wkv)
            new_shift.append(s_shift)
        else:
            out, s_conv = _short_conv_mix(hn, conv_in[j], p['sc_w_in'][j], p['sc_conv_w'][j], p['sc_w_out'][j])
            new_conv.append(s_conv)
        x = x + out
        x = x + 0.5 * _swiglu(_rmsnorm(x, p['ffn_norm'][i, 1]), p['ffn_w_gu'][i, 1], p['ffn_w_down'][i, 1])
    x = _rmsnorm(x, p['final_norm'])
    return x, jnp.stack(new_wkv), jnp.stack(new_shift), jnp.stack(new_conv)


def setup_inputs(seed: int = 0) -> dict:
    key = jax.random.key(seed)
    ks = iter(jax.random.split(key, 48))
    f32 = jnp.float32

    def nrm(shape, s):
        return jax.random.normal(next(ks), shape, f32) * s

    def unif(shape, lo, hi):
        return jax.random.uniform(next(ks), shape, f32, lo, hi)

    D, H, N, F = D_MODEL, N_HEADS, HEAD_DIM, D_FF
    return {
        'x_prompt': nrm((BATCH, SEQ, D), 1.0),
        'x_sample': nrm((DEC_BATCH, DEC_SEQ, D), 1.0),
        'state_wkv': nrm((N_RWKV, DEC_BATCH, H, N, N), 0.1),
        'state_shift': nrm((N_RWKV, DEC_BATCH, D), 1.0),
        'state_conv': nrm((N_CONV, DEC_BATCH, CONV_W - 1, D), 0.5),
        'meta': nrm((N_META, D), 1.0),
        'ffn_norm': 1.0 + nrm((DEPTH, 2, D), 0.01),
        'ffn_w_gu': nrm((DEPTH, 2, D, 2 * F), D ** -0.5),
        'ffn_w_down': nrm((DEPTH, 2, F, D), F ** -0.5),
        'mix_norm': 1.0 + nrm((DEPTH, D), 0.01),
        'final_norm': 1.0 + nrm((D,), 0.01),
        'rk_mu': unif((N_RWKV, 6, D), 0.0, 1.0),
        'rk_w_rkv': nrm((N_RWKV, 3, D, D), D ** -0.5),
        'rk_w0': unif((N_RWKV, D), -6.5, -1.5),
        'rk_w1': nrm((N_RWKV, D, D_DECAY_LORA), D ** -0.5),
        'rk_w2': nrm((N_RWKV, D_DECAY_LORA, D), 0.1 * D_DECAY_LORA ** -0.5),
        'rk_a0': nrm((N_RWKV, D), 0.1),
        'rk_a1': nrm((N_RWKV, D, D_AAA_LORA), D ** -0.5),
        'rk_a2': nrm((N_RWKV, D_AAA_LORA, D), 0.5 * D_AAA_LORA ** -0.5),
        'rk_g1': nrm((N_RWKV, D, D_GATE_LORA), D ** -0.5),
        'rk_g2': nrm((N_RWKV, D_GATE_LORA, D), D_GATE_LORA ** -0.5),
        'rk_k_k': 0.85 + nrm((N_RWKV, D), 0.05),
        'rk_k_a': 1.0 + nrm((N_RWKV, D), 0.05),
        'rk_r_k': -0.04 + nrm((N_RWKV, H, N), 0.05),
        'rk_ln_w': 1.0 + nrm((N_RWKV, D), 0.01),
        'rk_ln_b': nrm((N_RWKV, D), 0.01),
        'rk_w_o': nrm((N_RWKV, D, D), D ** -0.5),
        'sc_w_in': nrm((N_CONV, D, 3 * D), D ** -0.5),
        'sc_conv_w': nrm((N_CONV, CONV_W, D), CONV_W ** -0.5),
        'sc_w_out': nrm((N_CONV, D, D), D ** -0.5),
    }


def reference(x_prompt, x_sample, state_wkv, state_shift, state_conv, meta, ffn_norm, ffn_w_gu, ffn_w_down,
              mix_norm, final_norm, rk_mu, rk_w_rkv, rk_w0, rk_w1, rk_w2, rk_a0, rk_a1, rk_a2, rk_g1, rk_g2,
              rk_k_k, rk_k_a, rk_r_k, rk_ln_w, rk_ln_b, rk_w_o, sc_w_in, sc_conv_w, sc_w_out):
    p = {
        'ffn_norm': ffn_norm, 'ffn_w_gu': ffn_w_gu, 'ffn_w_down': ffn_w_down, 'mix_norm': mix_norm,
        'final_norm': final_norm, 'rk_mu': rk_mu, 'rk_w_rkv': rk_w_rkv, 'rk_w0': rk_w0, 'rk_w1': rk_w1,
        'rk_w2': rk_w2, 'rk_a0': rk_a0, 'rk_a1': rk_a1, 'rk_a2': rk_a2, 'rk_g1': rk_g1, 'rk_g2': rk_g2,
        'rk_k_k': rk_k_k, 'rk_k_a': rk_k_a, 'rk_r_k': rk_r_k, 'rk_ln_w': rk_ln_w, 'rk_ln_b': rk_ln_b,
        'rk_w_o': rk_w_o, 'sc_w_in': sc_w_in, 'sc_conv_w': sc_conv_w, 'sc_w_out': sc_w_out,
    }
    bp = x_prompt.shape[0]
    xp = jnp.concatenate([jnp.broadcast_to(meta.astype(x_prompt.dtype)[None], (bp, N_META, D_MODEL)), x_prompt], axis=1)
    wkv0 = jnp.zeros((N_RWKV, bp, N_HEADS, HEAD_DIM, HEAD_DIM), state_wkv.dtype)
    shift0 = jnp.zeros((N_RWKV, bp, D_MODEL), state_shift.dtype)
    conv0 = jnp.zeros((N_CONV, bp, CONV_W - 1, D_MODEL), state_conv.dtype)
    yp, wkv_p, shift_p, conv_p = _trunk(xp, wkv0, shift0, conv0, p)
    y_prompt = yp[:, N_META:]
    y_sample, wkv_s, shift_s, conv_s = _trunk(x_sample, state_wkv, state_shift, state_conv, p)
    return (y_prompt, y_sample, wkv_p, shift_p, conv_p, wkv_s, shift_s, conv_s)
```

```cpp
#include <hip/hip_runtime.h>
#include <hip/hip_cooperative_groups.h>
#include <cstdio>
#include <cstdint>
namespace cg = cooperative_groups;

#define LAS __attribute__((address_space(3)))
typedef unsigned short bf16_t;
typedef short bf16x8 __attribute__((ext_vector_type(8)));
typedef float f32x4 __attribute__((ext_vector_type(4)));
typedef float f32x2 __attribute__((ext_vector_type(2)));
typedef unsigned u32x4 __attribute__((ext_vector_type(4)));
typedef unsigned u32x2 __attribute__((ext_vector_type(2)));

constexpr int D = 1024, FF = 2816, NH = 16;
constexpr int PB = 8, PT = 2064, NMETA = 16, PTX = 2048, SBN = 128, STN = 8;
constexpr int MP = PB * PT;
constexpr int MS = SBN * STN;
constexpr int M = MP + MS;
constexpr int MPAD = 17664;
constexpr int NTHREADS = 512;
constexpr int LDS_BYTES = 131072 + 16;

constexpr size_t O_YP = 0;
constexpr size_t O_YS = O_YP + (size_t)PB * PTX * D;
constexpr size_t O_WKVP = O_YS + (size_t)MS * D;
constexpr size_t O_SHP = O_WKVP + (size_t)PB * NH * 64 * 64;
constexpr size_t O_CVP = O_SHP + (size_t)PB * D;
constexpr size_t O_WKVS = O_CVP + (size_t)PB * 2 * D;
constexpr size_t O_SHS = O_WKVS + (size_t)SBN * NH * 64 * 64;
constexpr size_t O_CVS = O_SHS + (size_t)SBN * D;
constexpr size_t O_END = O_CVS + (size_t)SBN * 2 * D;

constexpr size_t AL(size_t x) { return (x + 255) & ~(size_t)255; }
constexpr size_t ROWB = (size_t)MPAD * D * 2;
constexpr size_t WS_BAR = 0;
constexpr size_t WS_CTL_END = 16384;
constexpr size_t WS_SS = 16384;
constexpr size_t WS_SS_END = AL(WS_SS + (size_t)MPAD * 16 * 4);
constexpr size_t WS_X = WS_SS_END;
constexpr size_t WS_MISC = AL(WS_X + (size_t)MPAD * D * 4);
constexpr size_t SZ_WRKV = (size_t)3584 * 2048 * 2;
constexpr size_t SZ_WL2 = (size_t)3072 * 384 * 2;
constexpr size_t SZ_W1K = (size_t)1024 * 1024 * 2;
constexpr size_t WS_WRKV = WS_MISC;
constexpr size_t WS_WL2 = AL(WS_WRKV + SZ_WRKV);
constexpr size_t WS_WO = AL(WS_WL2 + SZ_WL2);
constexpr size_t WS_BIG = AL(WS_WO + SZ_W1K);
constexpr size_t SZ_BIG = (size_t)MPAD * 2048 * 2 * 2 + 4096;
constexpr size_t WS_LAZY = AL(WS_BIG + SZ_BIG);
constexpr size_t SZ_GU = (size_t)5632 * 1024 * 2;
constexpr size_t SZ_DN = (size_t)1024 * 2816 * 2;
constexpr size_t SZ_SLOT = SZ_GU + SZ_DN;
constexpr size_t WS_SLOTA = WS_LAZY;
constexpr size_t WS_SLOTB = WS_SLOTA + SZ_SLOT;
constexpr size_t WS_WIN = WS_SLOTB + SZ_SLOT;
constexpr size_t WS_WOUT = WS_WIN + (size_t)3072 * 1024 * 2;
constexpr size_t WS_END = WS_WOUT + SZ_W1K;
constexpr size_t B_ACT = WS_BIG;
constexpr size_t B_HH = WS_BIG;
constexpr size_t B_R = WS_BIG + 2 * ROWB;
constexpr size_t B_K = WS_BIG + 3 * ROWB;
constexpr size_t B_LW = WS_BIG;
constexpr size_t B_A = WS_BIG + ROWB;
constexpr size_t B_O = WS_BIG;
constexpr size_t B_U = WS_BIG;
constexpr size_t B_GB = WS_BIG + ROWB;
constexpr size_t B_CV = WS_BIG + 2 * ROWB;
constexpr size_t DO_XB = 0;
constexpr size_t DO_L1 = ROWB;
constexpr size_t DO_YPR = ROWB;
static_assert(DO_YPR + (size_t)MP * D * 2 <= O_WKVP * 4, "y-region overflow");
static_assert(DO_L1 + (size_t)MPAD * 384 * 2 <= O_WKVP * 4, "l1 overflow");
constexpr size_t L_G = WS_LAZY;
constexpr size_t L_YS = WS_LAZY + ROWB;
static_assert(L_YS + (size_t)MS * D * 2 <= WS_END, "lazy overflow");
constexpr size_t SZ_ACT = (size_t)MPAD * 2816 * 2;
static_assert(SZ_BIG >= SZ_ACT + (size_t)140 * 32 * 512 * 16, "ACT + split-K slab do not fit");

struct Params {
    const float* in[30];
    float* out;
    unsigned char* ws;
};
typedef const __attribute__((address_space(4))) Params* KP;
struct Ctx { KP p; int tid, bid, G; };

__device__ __forceinline__ unsigned cvt_pk_bf16(float lo, float hi) { unsigned r; asm volatile("v_cvt_pk_bf16_f32 %0, %1, %2" : "=v"(r) : "v"(lo), "v"(hi)); return r; }
__device__ __forceinline__ float bf_lo(unsigned v) { return __uint_as_float(v << 16); }
__device__ __forceinline__ float bf_hi(unsigned v) { return __uint_as_float(v & 0xffff0000u); }
__device__ __forceinline__ float frcp(float x) { return __builtin_amdgcn_rcpf(x); }
__device__ __forceinline__ float fsigmoid(float x) { return frcp(1.f + __expf(-x)); }
__device__ __forceinline__ void unpack8(u32x4 v, float* o) {
    o[0] = bf_lo(v[0]); o[1] = bf_hi(v[0]); o[2] = bf_lo(v[1]); o[3] = bf_hi(v[1]);
    o[4] = bf_lo(v[2]); o[5] = bf_hi(v[2]); o[6] = bf_lo(v[3]); o[7] = bf_hi(v[3]);
}
__device__ __forceinline__ u32x4 pack8(const float* o) {
    u32x4 r; r[0] = cvt_pk_bf16(o[0], o[1]); r[1] = cvt_pk_bf16(o[2], o[3]); r[2] = cvt_pk_bf16(o[4], o[5]); r[3] = cvt_pk_bf16(o[6], o[7]); return r;
}
template <int CTRL> __device__ __forceinline__ float dpp_f(float x) {
    return __int_as_float(__builtin_amdgcn_update_dpp(0, __float_as_int(x), CTRL, 0xF, 0xF, false));
}
__device__ __forceinline__ float allreduce16(float p) {
    p += dpp_f<0xB1>(p); p += dpp_f<0x4E>(p); p += dpp_f<0x124>(p); p += dpp_f<0x128>(p); return p;
}
__device__ __forceinline__ float allreduce8(float p) {
    p += dpp_f<0xB1>(p); p += dpp_f<0x4E>(p); p += __shfl_xor(p, 4); return p;
}
__device__ __forceinline__ float wave_sum(float p) {
#pragma unroll
    for (int o = 32; o >= 1; o >>= 1) p += __shfl_xor(p, o);
    return p;
}
__device__ __forceinline__ float row_rs(const float* ssp, int r) {
    const f32x4 a = *(const f32x4*)(ssp + (size_t)r * 16), b = *(const f32x4*)(ssp + (size_t)r * 16 + 4), c = *(const f32x4*)(ssp + (size_t)r * 16 + 8), d = *(const f32x4*)(ssp + (size_t)r * 16 + 12);
    const float s = ((a[0] + a[1]) + (a[2] + a[3])) + ((b[0] + b[1]) + (b[2] + b[3])) + ((c[0] + c[1]) + (c[2] + c[3])) + ((d[0] + d[1]) + (d[2] + d[3]));
    return rsqrtf(s * (1.f / 1024.f) + 1e-6f);
}
__device__ __forceinline__ void row_info(int m, int& t, int& T, int& seq) {
    if (m < MP) { seq = m / PT; t = m - seq * PT; T = PT; }
    else { const int q = m - MP; seq = 8 + (q >> 3); t = q & 7; T = STN; }
}

namespace pg8 {
constexpr int BM = 256, BK = 64, HALF = 128, HTB = HALF * BK * 2, STAGE_BYTES = 8 * HTB, NXCD = 8, WGM = 4;
__host__ __device__ __forceinline__ int lds_byte(int r, int c) { const int st = (r >> 4) * 2 + (c >> 5), rr = r & 15, cc = c & 31, ob = rr * 64 + cc * 2; return st * 1024 + (ob ^ (((ob >> 9) & 1) << 5)); }
__host__ __device__ __forceinline__ void stage_rc(int b, int& R, int& C) { const int st = b / 1024, sb = b % 1024, swz = sb ^ (((sb >> 9) & 1) << 5); R = (st >> 1) * 16 + swz / 64; C = (st & 1) * 32 + (swz % 64) / 2; }
__host__ __device__ __forceinline__ int perm32(int rho) { const int n = rho >> 4, i = rho & 15; return 8 * (i >> 2) + 4 * n + (i & 3); }

struct Unit { int pm, pn, k0, nt, sub; };
struct Gemm { const bf16_t* A; const bf16_t* Bt; int K; };
struct StaticOrder {
    int nM, nN, nwg, G, c;
    int ntK;
    __device__ __forceinline__ void init(int nM_, int nN_, int G_, int c_, int K_) { nM = nM_; nN = nN_; nwg = nM * nN; G = G_; c = c_; ntK = K_ / BK; }
    __device__ __forceinline__ void tile(int L, Unit& u) const {
        int wgid = L; { const int q = nwg / NXCD, r = nwg % NXCD, xcd = wgid % NXCD, off = wgid / NXCD; wgid = (xcd < r ? xcd * (q + 1) : r * (q + 1) + (xcd - r) * q) + off; }
        const int nig = WGM * nN, gid = wgid / nig, fm = gid * WGM, gsz = (nM - fm) < WGM ? (nM - fm) : WGM;
        u.pm = fm + ((wgid % nig) % gsz); u.pn = (wgid % nig) / gsz; u.k0 = 0; u.nt = ntK; u.sub = -1;
    }
    __device__ __forceinline__ bool next(int i, Unit& u) const {
        const long L = (long)i * G + c; if (L >= nwg) return false;
        u.k0 = 0; u.nt = ntK; u.sub = -1;
        int wgid = (int)L; { const int q = nwg / NXCD, r = nwg % NXCD, xcd = wgid % NXCD, off = wgid / NXCD; wgid = (xcd < r ? xcd * (q + 1) : r * (q + 1) + (xcd - r) * q) + off; }
        const int nig = WGM * nN, gid = wgid / nig, fm = gid * WGM, gsz = (nM - fm) < WGM ? (nM - fm) : WGM;
        u.pm = fm + ((wgid % nig) % gsz); u.pn = (wgid % nig) / gsz; return true;
    }
};

struct SplitOrder : StaticOrder {
    __device__ __forceinline__ bool next(int i, Unit& u) const {
        if (i == 0) { tile(c, u); return true; }
        if (i == 1 && c < 140) { tile(256 + c / 7, u); const int part = c % 7; u.k0 = part * 6; u.nt = part == 6 ? 8 : 6; u.sub = c; return true; }
        return false;
    }
};
template <class Epi, class Sched>
__device__ __forceinline__ void gemm_phase(LAS unsigned char* lds, const Gemm g, const Sched& S, const Epi& E, const int tid_, f32x4* slab = nullptr) {
    const int tid = tid_, wid = __builtin_amdgcn_readfirstlane(tid >> 6), lane = tid & 63, wr = wid >> 2, wc = wid & 3, fr = lane & 15, fq = lane >> 4;
    const int K = g.K;
    unsigned voffA[2], voffB[2];
#pragma unroll
    for (int i = 0; i < 2; ++i) { int R, C; stage_rc(tid * 16 + i * 8192, R, C); const int Rb = (R & ~31) + perm32(R & 31);
        voffA[i] = (unsigned)(R * K + C) * 2u; voffB[i] = (unsigned)(Rb * K + C) * 2u; }
    const size_t kstep = (size_t)(BK * 2);
    const size_t hstep = (size_t)HALF * K * 2;
    const size_t tstep = 2 * hstep;
    const unsigned ldsw = (unsigned)wid * 1024u;
    const int aoff = lds_byte(wr * 64 + fr, fq * 8), boff = lds_byte(wc * 32 + fr, fq * 8);
#define PG8_SA(b, h) (((b) * 2 + (h)) * HTB)
#define PG8_SB(b, h) ((4 + (b) * 2 + (h)) * HTB)
#define PG8_STAGE(bufoff, gbase, voff) do { _Pragma("unroll") for (int _i = 0; _i < 2; ++_i) \
        __builtin_amdgcn_global_load_lds((const unsigned*)((const char*)(gbase) + (voff)[_i]), (LAS unsigned*)(lds + (bufoff) + ldsw + _i * 8192), 16, 0, 0); } while (0)
#define PG8_LDA(dst, b, h) do { _Pragma("unroll") for (int m = 0; m < 4; ++m) _Pragma("unroll") for (int k = 0; k < 2; ++k) dst[m][k] = *(const LAS bf16x8*)(lds + PG8_SA(b, h) + aoff + m * 2048 + k * 1024); } while (0)
#define PG8_LDB(dst, b, h) do { _Pragma("unroll") for (int n = 0; n < 2; ++n) _Pragma("unroll") for (int k = 0; k < 2; ++k) dst[n][k] = *(const LAS bf16x8*)(lds + PG8_SB(b, h) + boff + n * 2048 + k * 1024); } while (0)
#define PG8_MMA(ai, bj, At, Bt) do { __builtin_amdgcn_s_setprio(1); _Pragma("unroll") for (int m = 0; m < 4; ++m) _Pragma("unroll") for (int n = 0; n < 2; ++n) _Pragma("unroll") for (int k = 0; k < 2; ++k) \
        acc[ai][bj][m][n] = __builtin_amdgcn_mfma_f32_16x16x32_bf16(Bt[n][k], At[m][k], acc[ai][bj][m][n], 0, 0, 0); __builtin_amdgcn_s_setprio(0); } while (0)
#define PG8_WAIT_V(n) asm volatile("s_waitcnt vmcnt(" #n ")" ::: "memory")
#define PG8_WAIT_L(n) asm volatile("s_waitcnt lgkmcnt(" #n ")" ::: "memory")
#define PG8_BAR __builtin_amdgcn_s_barrier()
#define PG8_SCHED __builtin_amdgcn_sched_barrier(0)
    Unit cur, nxt; int ui = 0;
    if (!S.next(0, cur)) return;
    f32x4 acc[2][2][4][2];
#pragma unroll
    for (int a = 0; a < 2; ++a)
#pragma unroll
        for (int b = 0; b < 2; ++b)
#pragma unroll
            for (int m = 0; m < 4; ++m)
#pragma unroll
                for (int n = 0; n < 2; ++n) acc[a][b][m][n] = (f32x4){0.f, 0.f, 0.f, 0.f};
    bf16x8 At[4][2], B0[2][2], B1[2][2];
    const char* cA = (const char*)g.A + (size_t)cur.pm * tstep + (size_t)cur.k0 * kstep; const char* cB = (const char*)g.Bt + (size_t)cur.pn * tstep + (size_t)cur.k0 * kstep;
    PG8_STAGE(PG8_SB(0, 0), cB, voffB); PG8_STAGE(PG8_SA(0, 0), cA, voffA); PG8_STAGE(PG8_SB(0, 1), cB + hstep, voffB); PG8_STAGE(PG8_SA(0, 1), cA + hstep, voffA);
    if (wr == 1) PG8_BAR;
    PG8_WAIT_V(4); PG8_BAR;
    PG8_STAGE(PG8_SB(1, 0), cB + kstep, voffB); PG8_STAGE(PG8_SA(1, 0), cA + kstep, voffA); PG8_STAGE(PG8_SB(1, 1), cB + hstep + kstep, voffB);
    PG8_WAIT_V(6); PG8_BAR;
    for (;;) {
        const bool has_next = S.next(ui + 1, nxt);
        const char* nA = has_next ? (const char*)g.A + (size_t)nxt.pm * tstep + (size_t)nxt.k0 * kstep : cA; const char* nB = has_next ? (const char*)g.Bt + (size_t)nxt.pn * tstep + (size_t)nxt.k0 * kstep : cB;
        const int nt = cur.nt;
        for (int t = 0; t < nt; t += 2) {
            const bool last = (t == nt - 2);
            const char* a1 = cA + (size_t)(t + 1) * kstep;
            const char* a2 = last ? nA : cA + (size_t)(t + 2) * kstep; const char* b2 = last ? nB : cB + (size_t)(t + 2) * kstep;
            const char* a3 = a2 + kstep; const char* b3 = b2 + kstep;
            PG8_LDB(B0, 0, 0); PG8_SCHED; PG8_LDA(At, 0, 0); PG8_STAGE(PG8_SA(1, 1), a1 + hstep, voffA);
            PG8_WAIT_L(8); PG8_BAR; PG8_WAIT_L(0); PG8_MMA(0, 0, At, B0); PG8_BAR; PG8_SCHED;
            PG8_LDB(B1, 0, 1); PG8_STAGE(PG8_SB(0, 0), b2, voffB);
            PG8_BAR; PG8_WAIT_L(0); PG8_MMA(0, 1, At, B1); PG8_BAR;
            PG8_LDA(At, 0, 1); PG8_STAGE(PG8_SA(0, 0), a2, voffA);
            PG8_BAR; PG8_WAIT_L(0); PG8_MMA(1, 0, At, B0); PG8_BAR; PG8_SCHED;
            PG8_STAGE(PG8_SB(0, 1), b2 + hstep, voffB);
            PG8_WAIT_V(6); PG8_BAR; PG8_MMA(1, 1, At, B1); PG8_BAR;
            PG8_LDB(B0, 1, 0); PG8_SCHED; PG8_LDA(At, 1, 0); PG8_STAGE(PG8_SA(0, 1), a2 + hstep, voffA);
            PG8_WAIT_L(8); PG8_BAR; PG8_WAIT_L(0); PG8_MMA(0, 0, At, B0); PG8_BAR; PG8_SCHED;
            PG8_LDB(B1, 1, 1); PG8_STAGE(PG8_SB(1, 0), b3, voffB);
            PG8_BAR; PG8_WAIT_L(0); PG8_MMA(0, 1, At, B1); PG8_BAR;
            PG8_LDA(At, 1, 1); PG8_STAGE(PG8_SA(1, 0), a3, voffA);
            PG8_BAR; PG8_WAIT_L(0); PG8_MMA(1, 0, At, B0); PG8_BAR; PG8_SCHED;
            PG8_STAGE(PG8_SB(1, 1), b3 + hstep, voffB);
            PG8_WAIT_V(6); PG8_BAR; PG8_MMA(1, 1, At, B1); PG8_BAR;
        }
        if (cur.sub < 0) { int fr_ = fr, fq_ = fq; asm volatile("" : "+v"(fr_), "+v"(fq_)); E(acc, cur, wr, wc, fr_, fq_); }
        else {
            int t_ = tid; asm volatile("" : "+v"(t_));
            f32x4* sp = slab + (size_t)cur.sub * 32 * 512 + t_;
#pragma unroll
            for (int a = 0; a < 2; ++a)
#pragma unroll
                for (int b = 0; b < 2; ++b)
#pragma unroll
                    for (int m = 0; m < 4; ++m)
#pragma unroll
                        for (int n = 0; n < 2; ++n) sp[(size_t)(((a * 2 + b) * 4 + m) * 2 + n) * 512] = acc[a][b][m][n];
        }
        if (!has_next) break;
#pragma unroll
        for (int a = 0; a < 2; ++a)
#pragma unroll
            for (int b = 0; b < 2; ++b)
#pragma unroll
                for (int m = 0; m < 4; ++m)
#pragma unroll
                    for (int n = 0; n < 2; ++n) acc[a][b][m][n] = (f32x4){0.f, 0.f, 0.f, 0.f};
        cur = nxt; cA = nA; cB = nB; ++ui;
    }
    PG8_WAIT_V(0);
    if (wr == 0) PG8_BAR;
    PG8_BAR;
#undef PG8_SA
#undef PG8_SB
#undef PG8_STAGE
#undef PG8_LDA
#undef PG8_LDB
#undef PG8_MMA
#undef PG8_WAIT_V
#undef PG8_WAIT_L
#undef PG8_BAR
#undef PG8_SCHED
}
}
using pg8::Unit;

__device__ __forceinline__ void rows_rs8(const float* ss, int row0  , int fq, float (&rsv)[8]) {
    f32x4 part[8];
#pragma unroll
    for (int i = 0; i < 8; ++i) part[i] = *(const f32x4*)(ss + (size_t)(row0 + (i >> 2) * 128 + (i & 3) * 16) * 16 + 4 * fq);
#pragma unroll
    for (int i = 0; i < 8; ++i) {
        float t = (part[i][0] + part[i][1]) + (part[i][2] + part[i][3]);
        t += __shfl_xor(t, 16); t += __shfl_xor(t, 32);
        rsv[i] = rsqrtf(t * (1.f / 1024.f) + 1e-6f);
    }
}
struct EpiGU {
    const float* ss; bf16_t* act;
    __device__ __forceinline__ void operator()(const f32x4 (&acc)[2][2][4][2], const Unit& u, int wr, int wc, int fr, int fq) const {
        const int col = u.pn * 128 + wc * 32 + 8 * fq;
        const int row0 = u.pm * 256 + wr * 64 + fr;
        float rsv[8]; rows_rs8(ss, row0, fq, rsv);
#pragma unroll
        for (int ai = 0; ai < 2; ++ai)
#pragma unroll
            for (int m = 0; m < 4; ++m) {
                const int r = row0 + ai * 128 + m * 16;
                const float rs = rsv[ai * 4 + m];
                float o[8];
#pragma unroll
                for (int n = 0; n < 2; ++n)
#pragma unroll
                    for (int j = 0; j < 4; ++j) { const float gt = acc[ai][0][m][n][j] * rs, up = acc[ai][1][m][n][j] * rs; o[n * 4 + j] = gt * fsigmoid(gt) * up; }
                *(u32x4*)(act + (size_t)r * FF + col) = pack8(o);
            }
    }
};
struct EpiRes {
    bf16_t* XB; float* ssout; float scale;
    __device__ __forceinline__ void operator()(const f32x4 (&acc)[2][2][4][2], const Unit& u, int wr, int wc, int fr, int fq) const {
        const int row0 = u.pm * 256 + wr * 64 + fr, col0 = u.pn * 256 + wc * 32 + 8 * fq;
#pragma unroll
        for (int ai = 0; ai < 2; ++ai) {
            u32x4 xv[4][2];
#pragma unroll
            for (int m = 0; m < 4; ++m)
#pragma unroll
                for (int bj = 0; bj < 2; ++bj) xv[m][bj] = *(const u32x4*)(XB + (size_t)(row0 + ai * 128 + m * 16) * D + col0 + bj * 128);
#pragma unroll
            for (int m = 0; m < 4; ++m) {
                const int r = row0 + ai * 128 + m * 16;
                float ssum = 0.f;
#pragma unroll
                for (int bj = 0; bj < 2; ++bj) {
                    float o[8]; unpack8(xv[m][bj], o);
#pragma unroll
                    for (int j = 0; j < 4; ++j) { o[j] += acc[ai][bj][m][0][j] * scale; o[4 + j] += acc[ai][bj][m][1][j] * scale; }
                    *(u32x4*)(XB + (size_t)r * D + col0 + bj * 128) = pack8(o);
#pragma unroll
                    for (int j = 0; j < 8; ++j) ssum += o[j] * o[j];
                }
                ssum += __shfl_xor(ssum, 16); ssum += __shfl_xor(ssum, 32);
                if (fq == 0) ssout[(size_t)r * 16 + u.pn * 4 + wc] = ssum;
            }
        }
    }
};
struct EpiRKV {
    unsigned char* ws; unsigned char* dob;
    __device__ __forceinline__ void operator()(const f32x4 (&acc)[2][2][4][2], const Unit& u, int wr, int wc, int fr, int fq) const {
        if (u.pn < 12) {
            bf16_t* base = (u.pn < 8) ? (bf16_t*)(ws + B_R + (size_t)(u.pn >> 2) * ROWB) : (bf16_t*)(dob + DO_XB);
#pragma unroll
            for (int ai = 0; ai < 2; ++ai)
#pragma unroll
                for (int m = 0; m < 4; ++m) {
                    const int row = u.pm * 256 + ai * 128 + wr * 64 + m * 16 + fr;
#pragma unroll
                    for (int bj = 0; bj < 2; ++bj) {
                        const int c = (u.pn & 3) * 256 + bj * 128 + wc * 32 + 8 * fq;
                        float o[8] = {acc[ai][bj][m][0][0], acc[ai][bj][m][0][1], acc[ai][bj][m][0][2], acc[ai][bj][m][0][3], acc[ai][bj][m][1][0], acc[ai][bj][m][1][1], acc[ai][bj][m][1][2], acc[ai][bj][m][1][3]};
                        *(u32x4*)(base + (size_t)row * D + c) = pack8(o);
                    }
                }
        } else {
#pragma unroll
            for (int ai = 0; ai < 2; ++ai)
#pragma unroll
                for (int m = 0; m < 4; ++m) {
                    const int row = u.pm * 256 + ai * 128 + wr * 64 + m * 16 + fr;
#pragma unroll
                    for (int bj = 0; bj < 2; ++bj) {
                        const int c = (u.pn - 12) * 256 + bj * 128 + wc * 32 + 8 * fq;
                        if (c >= 384) continue;
                        float o[8];
#pragma unroll
                        for (int n = 0; n < 2; ++n)
#pragma unroll
                            for (int j = 0; j < 4; ++j) {
                                const float a = acc[ai][bj][m][n][j]; float val;
                                if (c < 64) val = 1.f - 2.f * frcp(1.f + __expf(2.f * a));
                                else if (c < 128) val = a;
                                else if (c < 288) val = fsigmoid(a);
                                else val = 0.f;
                                o[n * 4 + j] = val;
                            }
                        *(u32x4*)((bf16_t*)(dob + DO_L1) + (size_t)row * 384 + c) = pack8(o);
                    }
                }
        }
    }
};
struct EpiL2 {
    unsigned char* ws; const float* w0; const float* a0;
    __device__ __forceinline__ void operator()(const f32x4 (&acc)[2][2][4][2], const Unit& u, int wr, int wc, int fr, int fq) const {
        const int kind = u.pn >> 2;
        bf16_t* base = (bf16_t*)(ws + (kind == 2 ? L_G : B_LW + (size_t)kind * ROWB));
        const float* bsrc = kind == 0 ? w0 : a0;
        const float bmul = kind == 2 ? 0.f : 1.f;
        f32x4 bvv[2][2];
#pragma unroll
        for (int bj = 0; bj < 2; ++bj)
#pragma unroll
            for (int n = 0; n < 2; ++n) bvv[bj][n] = *(const f32x4*)(bsrc + (u.pn & 3) * 256 + bj * 128 + wc * 32 + 8 * fq + 4 * n) * bmul;
#pragma unroll
        for (int ai = 0; ai < 2; ++ai)
#pragma unroll
            for (int m = 0; m < 4; ++m) {
                const int row = u.pm * 256 + ai * 128 + wr * 64 + m * 16 + fr;
#pragma unroll
                for (int bj = 0; bj < 2; ++bj) {
                    const int c = (u.pn & 3) * 256 + bj * 128 + wc * 32 + 8 * fq;
                    float o[8];
#pragma unroll
                    for (int n = 0; n < 2; ++n) {
                        const f32x4 bv = bvv[bj][n];
#pragma unroll
                        for (int j = 0; j < 4; ++j) {
                            const float z = acc[ai][bj][m][n][j] + bv[j];
                            const float sg = fsigmoid(z);
                            o[n * 4 + j] = kind == 0 ? -0.60653065971f * sg : (kind == 1 ? sg : z);
                        }
                    }
                    *(u32x4*)(base + (size_t)row * D + c) = pack8(o);
                }
            }
    }
};
struct EpiCI {
    const float* ss; bf16_t* U; bf16_t* GB; float* out;
    __device__ __forceinline__ void operator()(const f32x4 (&acc)[2][2][4][2], const Unit& u, int wr, int wc, int fr, int fq) const {
        float rsv[8]; rows_rs8(ss, u.pm * 256 + wr * 64 + fr, fq, rsv);
#pragma unroll
        for (int ai = 0; ai < 2; ++ai)
#pragma unroll
            for (int m = 0; m < 4; ++m) {
                const int row = u.pm * 256 + ai * 128 + wr * 64 + m * 16 + fr;
                const float rs = rsv[ai * 4 + m];
                if (u.pn < 8) {
                    const int c = u.pn * 128 + wc * 32 + 8 * fq;
                    float o[8];
#pragma unroll
                    for (int n = 0; n < 2; ++n)
#pragma unroll
                        for (int j = 0; j < 4; ++j) o[n * 4 + j] = (acc[ai][0][m][n][j] * rs) * (acc[ai][1][m][n][j] * rs);
                    *(u32x4*)(U + (size_t)row * D + c) = pack8(o);
                    if (row < M) {
                        int t, T, seq; row_info(row, t, T, seq);
                        if (t >= T - 2) {
                            float* op = (seq < 8) ? out + O_CVP + ((size_t)seq * 2 + (t - (T - 2))) * D + c : out + O_CVS + ((size_t)(seq - 8) * 2 + (t - (T - 2))) * D + c;
                            *(f32x4*)op = (f32x4){o[0], o[1], o[2], o[3]}; *(f32x4*)(op + 4) = (f32x4){o[4], o[5], o[6], o[7]};
                        }
                    }
                } else {
#pragma unroll
                    for (int bj = 0; bj < 2; ++bj) {
                        const int c = (u.pn - 8) * 256 + bj * 128 + wc * 32 + 8 * fq;
                        float o[8];
#pragma unroll
                        for (int n = 0; n < 2; ++n)
#pragma unroll
                            for (int j = 0; j < 4; ++j) o[n * 4 + j] = acc[ai][bj][m][n][j] * rs;
                        *(u32x4*)(GB + (size_t)row * D + c) = pack8(o);
                    }
                }
            }
    }
};

struct TSrc { const float* p; int ld; int vk; int vc; const float* scale; int smode; };
__device__ __forceinline__ void tblock(LAS float* tile, const TSrc s, bf16_t* dst  , int kdst, const int tid) {
    const int kr = tid >> 4, c4 = (tid & 15) * 4;
    __syncthreads();
#pragma unroll
    for (int hf = 0; hf < 2; ++hf) {
        const int k = kr + 32 * hf;
        f32x4 v = (f32x4){0.f, 0.f, 0.f, 0.f};
        if (k < s.vk && c4 < s.vc) {
            v = *(const f32x4*)(s.p + (size_t)k * s.ld + c4);
            if (s.smode) { float sc = s.scale[k]; if (s.smode == 2) sc = 1.f - sc; v *= sc; }
        }
        tile[k * 65 + c4 + 0] = v[0]; tile[k * 65 + c4 + 1] = v[1]; tile[k * 65 + c4 + 2] = v[2]; tile[k * 65 + c4 + 3] = v[3];
    }
    __syncthreads();
    const int n = tid >> 3, k8 = (tid & 7) * 8;
    float o[8];
#pragma unroll
    for (int j = 0; j < 8; ++j) o[j] = tile[(k8 + j) * 65 + n];
    *(u32x4*)(dst + (size_t)n * kdst + k8) = pack8(o);
}
enum { T_GU = 0, T_DN, T_RKV, T_L2, T_PLAIN, T_WIN };
__device__ __forceinline__ void convert(LAS float* tile, const Ctx& cx, int type, int f, bf16_t* dst, int wg, int nwg) {
    int Nd, Kd;
    switch (type) { case T_GU: Nd = 5632; Kd = 1024; break; case T_DN: Nd = 1024; Kd = 2816; break; case T_RKV: Nd = 3584; Kd = 2048; break;
                    case T_L2: Nd = 3072; Kd = 384; break; case T_WIN: Nd = 3072; Kd = 1024; break; default: Nd = 1024; Kd = 1024; break; }
    const int nkb = Kd / 64, nblk = (Nd / 64) * nkb;
    for (int blk = wg; blk < nblk; blk += nwg) {
        const int nb = blk / nkb, kb = blk - nb * nkb, n0 = nb * 64, kd0 = kb * 64;
        TSrc s; s.p = nullptr; s.ld = 0; s.vk = 0; s.vc = 0; s.scale = nullptr; s.smode = 0;
        if (type == T_GU) {
            const int pn = n0 >> 8, bj = (n0 >> 7) & 1, i0 = n0 & 127, c0 = bj * FF + 128 * pn + i0;
            s.p = cx.p->in[7] + (size_t)f * D * 2 * FF + (size_t)kd0 * (2 * FF) + c0; s.ld = 2 * FF; s.vk = 64; s.vc = 64; s.scale = cx.p->in[6] + f * D + kd0; s.smode = 1;
        } else if (type == T_DN) {
            s.p = cx.p->in[8] + (size_t)f * FF * D + (size_t)kd0 * D + n0; s.ld = D; s.vk = 64; s.vc = 64;
        } else if (type == T_RKV) {
            const int hf = kd0 >= 1024, ks = kd0 & 1023; s.smode = hf ? 1 : 2; s.vk = 64;
            if (n0 < 3072) { const int pj = n0 >> 10, c0 = n0 & 1023, mi = pj == 0 ? 0 : (pj == 1 ? 2 : 3);
                s.p = cx.p->in[12] + (size_t)pj * D * D + (size_t)ks * D + c0; s.ld = D; s.vc = 64; s.scale = cx.p->in[11] + mi * D + ks; }
            else { const int j0 = n0 - 3072;
                if (j0 < 64) { s.p = cx.p->in[14] + (size_t)ks * 64 + j0; s.ld = 64; s.vc = 64; s.scale = cx.p->in[11] + 1 * D + ks; }
                else if (j0 < 128) { s.p = cx.p->in[17] + (size_t)ks * 64 + (j0 - 64); s.ld = 64; s.vc = 64; s.scale = cx.p->in[11] + 4 * D + ks; }
                else if (j0 < 288) { const int c0 = j0 - 128; s.p = cx.p->in[19] + (size_t)ks * 160 + c0; s.ld = 160; s.vc = (160 - c0) < 64 ? (160 - c0) : 64; s.scale = cx.p->in[11] + 5 * D + ks; }
                else { s.vk = 0; s.vc = 0; s.smode = 0; s.p = cx.p->in[14]; } }
        } else if (type == T_L2) {
            s.p = cx.p->in[15];
            if (n0 < 1024) { if (kd0 == 0) { s.p = cx.p->in[15] + n0; s.ld = D; s.vk = 64; s.vc = 64; } }
            else if (n0 < 2048) { if (kd0 == 64) { s.p = cx.p->in[18] + (n0 - 1024); s.ld = D; s.vk = 64; s.vc = 64; } }
            else { if (kd0 >= 128 && kd0 < 288) { const int k0 = kd0 - 128; s.p = cx.p->in[20] + (size_t)k0 * D + (n0 - 2048); s.ld = D; s.vk = (160 - k0) < 64 ? (160 - k0) : 64; s.vc = 64; } }
        } else if (type == T_WIN) {
            int c0;
            if (n0 < 2048) { const int pn = n0 >> 8, bj = (n0 >> 7) & 1, i0 = n0 & 127; c0 = (bj == 0 ? 1024 : 2048) + 128 * pn + i0; } else c0 = n0 - 2048;
            s.p = cx.p->in[27] + (size_t)kd0 * 3072 + c0; s.ld = 3072; s.vk = 64; s.vc = 64; s.scale = cx.p->in[9] + D + kd0; s.smode = 1;
        } else {
            s.p = cx.p->in[f] + (size_t)kd0 * D + n0; s.ld = D; s.vk = 64; s.vc = 64;
        }
        tblock(tile, s, dst + (size_t)n0 * Kd + kd0, Kd, cx.tid);
    }
}

__device__ __forceinline__ void ld8f(const float* p, float* o) { const f32x4 a = *(const f32x4*)p, b = *(const f32x4*)(p + 4); o[0] = a[0]; o[1] = a[1]; o[2] = a[2]; o[3] = a[3]; o[4] = b[0]; o[5] = b[1]; o[6] = b[2]; o[7] = b[3]; }
__device__ __forceinline__ void ld8b(const bf16_t* p, float* o) { unpack8(*(const u32x4*)p, o); }
__device__ __forceinline__ void phase_x0(const Ctx& cx, bf16_t* XB, float* ss0) {
    const int wave = cx.tid >> 6, lane = cx.tid & 63;
    for (int m = cx.bid * 8 + wave; m < MPAD; m += cx.G * 8) {
        const float* src = nullptr;
        if (m < MP) { const int b = m / PT, t = m - b * PT; src = t < NMETA ? cx.p->in[5] + (size_t)t * D : cx.p->in[0] + ((size_t)b * PTX + (t - NMETA)) * D; }
        else if (m < M) src = cx.p->in[1] + (size_t)(m - MP) * D;
        float s = 0.f;
#pragma unroll
        for (int i = 0; i < 4; ++i) {
            const int c = lane * 4 + i * 256;
            f32x4 v = src ? *(const f32x4*)(src + c) : (f32x4){0.f, 0.f, 0.f, 0.f};
            u32x2 pk; pk[0] = cvt_pk_bf16(v[0], v[1]); pk[1] = cvt_pk_bf16(v[2], v[3]);
            *(u32x2*)(XB + (size_t)m * D + c) = pk;
            s += v[0] * v[0] + v[1] * v[1] + v[2] * v[2] + v[3] * v[3];
        }
        s = wave_sum(s);
        if (lane < 16) ss0[(size_t)m * 16 + lane] = lane == 0 ? s : 0.f;
    }
}
__device__ __forceinline__ void phase_mix(const Ctx& cx, const bf16_t* XB, const float* ss, bf16_t* HH) {
    const int c = (cx.tid & 127) * 8, sub = cx.tid >> 7;
    float g[8];
    { const f32x4 g0 = *(const f32x4*)(cx.p->in[9] + c), g1 = *(const f32x4*)(cx.p->in[9] + c + 4); g[0] = g0[0]; g[1] = g0[1]; g[2] = g0[2]; g[3] = g0[3]; g[4] = g1[0]; g[5] = g1[1]; g[6] = g1[2]; g[7] = g1[3]; }
    for (int m = cx.bid * 4 + sub; m < MPAD; m += cx.G * 4) {
        float hn[8], hp[8];
        if (m < M) {
            int t, T, seq; row_info(m, t, T, seq);
            const float rs = row_rs(ss, m);
            float xc[8]; ld8b(XB + (size_t)m * D + c, xc);
#pragma unroll
            for (int j = 0; j < 8; ++j) hn[j] = xc[j] * rs * g[j];
            if (t > 0) {
                const float rp = row_rs(ss, m - 1);
                float xp[8]; ld8b(XB + (size_t)(m - 1) * D + c, xp);
#pragma unroll
                for (int j = 0; j < 8; ++j) hp[j] = xp[j] * rp * g[j];
            } else if (seq >= 8) {
                const float* sp = cx.p->in[3] + (size_t)(seq - 8) * D + c;
                const f32x4 y0 = *(const f32x4*)sp, y1 = *(const f32x4*)(sp + 4);
#pragma unroll
                for (int j = 0; j < 4; ++j) { hp[j] = y0[j]; hp[4 + j] = y1[j]; }
            } else {
#pragma unroll
                for (int j = 0; j < 8; ++j) hp[j] = 0.f;
            }
            if (t == T - 1) {
                float* op = (seq < 8) ? cx.p->out + O_SHP + (size_t)seq * D + c : cx.p->out + O_SHS + (size_t)(seq - 8) * D + c;
                *(f32x4*)op = (f32x4){hn[0], hn[1], hn[2], hn[3]}; *(f32x4*)(op + 4) = (f32x4){hn[4], hn[5], hn[6], hn[7]};
            }
        } else {
#pragma unroll
            for (int j = 0; j < 8; ++j) { hn[j] = 0.f; hp[j] = 0.f; }
        }
        *(u32x4*)(HH + (size_t)m * 2048 + c) = pack8(hn);
        *(u32x4*)(HH + (size_t)m * 2048 + 1024 + c) = pack8(hp);
    }
}
__device__ __forceinline__ void phase_post(const Ctx& cx, const bf16_t* YP, const bf16_t* YS, const float* CB, const bf16_t* V, const bf16_t* G, bf16_t* O) {
    const int c = (cx.tid & 127) * 8, sub = cx.tid >> 7;
    float lnw[8], lnb[8];
    ld8f(cx.p->in[24] + c, lnw); ld8f(cx.p->in[25] + c, lnb);
    for (int m = cx.bid * 4 + sub; m < MPAD; m += cx.G * 4) {
        float o[8];
        if (m < M) {
            float y[8], v[8], g[8];
            ld8b((m < MP ? YP + (size_t)m * D : YS + (size_t)(m - MP) * D) + c, y);
            ld8b(V + (size_t)m * D + c, v); ld8b(G + (size_t)m * D + c, g);
            const float cb = CB[(size_t)m * NH + (c >> 6)];
            float s = 0.f;
#pragma unroll
            for (int j = 0; j < 8; ++j) s += y[j];
            s = allreduce8(s);
            const float mean = s * (1.f / 64.f);
            float vs = 0.f;
#pragma unroll
            for (int j = 0; j < 8; ++j) { y[j] -= mean; vs += y[j] * y[j]; }
            vs = allreduce8(vs);
            const float rstd = rsqrtf(vs * (1.f / 64.f) + 64e-5f);
#pragma unroll
            for (int j = 0; j < 8; ++j) o[j] = (y[j] * rstd * lnw[j] + lnb[j] + cb * v[j]) * g[j];
        } else {
#pragma unroll
            for (int j = 0; j < 8; ++j) o[j] = 0.f;
        }
        *(u32x4*)(O + (size_t)m * D + c) = pack8(o);
    }
}
__device__ __forceinline__ void phase_conv(const Ctx& cx, const bf16_t* U, const bf16_t* GB, bf16_t* CV) {
    const int c = (cx.tid & 127) * 8, sub = cx.tid >> 7;
    float w0[8], w1[8], w2[8];
    ld8f(cx.p->in[28] + c, w0); ld8f(cx.p->in[28] + D + c, w1); ld8f(cx.p->in[28] + 2 * D + c, w2);
    for (int m = cx.bid * 4 + sub; m < MPAD; m += cx.G * 4) {
        float o[8];
        if (m < M) {
            int t, T, seq; row_info(m, t, T, seq);
            float u2[8], u1[8], u0[8], gb[8];
            ld8b(U + (size_t)m * D + c, u2); ld8b(GB + (size_t)m * D + c, gb);
            if (t >= 1) ld8b(U + (size_t)(m - 1) * D + c, u1);
            else if (seq >= 8) ld8f(cx.p->in[4] + ((size_t)(seq - 8) * 2 + 1) * D + c, u1);
            else {
#pragma unroll
                for (int j = 0; j < 8; ++j) u1[j] = 0.f; }
            if (t >= 2) ld8b(U + (size_t)(m - 2) * D + c, u0);
            else if (seq >= 8) ld8f(cx.p->in[4] + ((size_t)(seq - 8) * 2 + t) * D + c, u0);
            else {
#pragma unroll
                for (int j = 0; j < 8; ++j) u0[j] = 0.f; }
#pragma unroll
            for (int j = 0; j < 8; ++j) o[j] = gb[j] * (w0[j] * u0[j] + w1[j] * u1[j] + w2[j] * u2[j]);
        } else {
#pragma unroll
            for (int j = 0; j < 8; ++j) o[j] = 0.f;
        }
        *(u32x4*)(CV + (size_t)m * D + c) = pack8(o);
    }
}
__device__ __forceinline__ void phase_final(const Ctx& cx, const bf16_t* XB, const float* ss) {
    const int wave = cx.tid >> 6, lane = cx.tid & 63;
    for (int m = cx.bid * 8 + wave; m < M; m += cx.G * 8) {
        float* dst;
        if (m < MP) { const int b = m / PT, t = m - b * PT; if (t < NMETA) continue; dst = cx.p->out + O_YP + ((size_t)b * PTX + (t - NMETA)) * D; }
        else dst = cx.p->out + O_YS + (size_t)(m - MP) * D;
        const float rs = row_rs(ss, m);
#pragma unroll
        for (int i = 0; i < 4; ++i) {
            const int c = lane * 4 + i * 256;
            const u32x2 xb = *(const u32x2*)(XB + (size_t)m * D + c); const f32x4 g = *(const f32x4*)(cx.p->in[10] + c);
            const f32x4 v = {bf_lo(xb[0]), bf_hi(xb[0]), bf_lo(xb[1]), bf_hi(xb[1])};
            *(f32x4*)(dst + c) = v * rs * g;
        }
    }
}

struct ScanBufs { const bf16_t* R; const bf16_t* K; const bf16_t* V; const bf16_t* LW; const bf16_t* A; bf16_t* YP; bf16_t* YS; float* CB; };
__device__ __forceinline__ void scan_item_info(int item, int& m0, int& T, int& h, int& half, int& sb) {
    if (item < 256) { const int b = item >> 5; h = (item >> 1) & 15; half = item & 1; m0 = b * PT; T = PT; sb = -1 - b; }
    else { const int q = item - 256; sb = q >> 5; h = (q >> 1) & 15; half = q & 1; m0 = MP + sb * STN; T = STN; }
}
__device__ __forceinline__ void phase_scan(LAS float* lds, const Ctx& cx, const ScanBufs B) {
    const int tid = cx.tid, G = cx.G;
    const int nitems = 256 + 4096;
    const bool consumer = tid < 256;
    const int rp = (tid >> 4) & 15, seg = tid & 15;
    const int ptid = tid - 256, tl = ptid >> 3, cs = ptid & 7;
    int ci = cx.bid, ct0 = 0, k = 0;
    f32x2 sA0 = {0.f, 0.f}, sA1 = {0.f, 0.f}, sB0 = {0.f, 0.f}, sB1 = {0.f, 0.f};
    f32x4 pf[4][2]; bool pf_valid = false;
#pragma unroll
    for (int q = 0; q < 4; ++q) { pf[q][0] = (f32x4){0.f, 0.f, 0.f, 0.f}; pf[q][1] = pf[q][0]; }

    auto prep = [&](int pi, int pt0, int buf) __attribute__((always_inline)) {
        LAS float* ob = lds + buf * 11264;
        int item, t;
        if (pi < 256) { item = pi; t = pt0 + tl; } else { item = pi + (tl >> 3) * G; t = tl & 7; }
        if (item < nitems) {
            int pm0, pT, ph, phalf, psb; scan_item_info(item, pm0, pT, ph, phalf, psb);
            if (t < pT) {
                const size_t o = (size_t)(pm0 + t) * D + ph * 64 + cs * 8;
                float kf[8], rf[8], af[8], wf[8];
                ld8b(B.K + o, kf); ld8b(B.R + o, rf); ld8b(B.A + o, af); ld8b(B.LW + o, wf);
                const u32x2 vv = *(const u32x2*)(B.V + (size_t)(pm0 + t) * D + ph * 64 + phalf * 32 + cs * 4);
                float kkc[8], kac[8];
                ld8f(cx.p->in[21] + ph * 64 + cs * 8, kkc); ld8f(cx.p->in[22] + ph * 64 + cs * 8, kac);
                float kk[8]; float n2 = 0.f;
#pragma unroll
                for (int j = 0; j < 8; ++j) { kk[j] = kf[j] * kkc[j]; n2 += kk[j] * kk[j]; }
                n2 = allreduce8(n2);
                const float inv = 1.f / fmaxf(sqrtf(n2), 1e-12f);
                float vd[8], vb[8], vk[8];
#pragma unroll
                for (int j = 0; j < 8; ++j) { kk[j] *= inv; vb[j] = kk[j] * af[j]; vk[j] = kf[j] * (1.f + (af[j] - 1.f) * kac[j]); vd[j] = __expf(wf[j]); }
                if (phalf == 0) {
                    float rkc[8]; ld8f(cx.p->in[23] + ph * 64 + cs * 8, rkc);
                    float cbv = 0.f;
#pragma unroll
                    for (int j = 0; j < 8; ++j) cbv += rf[j] * vk[j] * rkc[j];
                    cbv = allreduce8(cbv);
                    if (cs == 0) B.CB[(size_t)(pm0 + t) * NH + ph] = cbv;
                }
                LAS float* q = ob + tl * 64 + cs * 8;
                *(LAS f32x4*)(q) = (f32x4){vd[0], vd[1], vd[2], vd[3]}; *(LAS f32x4*)(q + 4) = (f32x4){vd[4], vd[5], vd[6], vd[7]};
                *(LAS f32x4*)(q + 2048) = (f32x4){kk[0], kk[1], kk[2], kk[3]}; *(LAS f32x4*)(q + 2048 + 4) = (f32x4){kk[4], kk[5], kk[6], kk[7]};
                *(LAS f32x4*)(q + 4096) = (f32x4){vb[0], vb[1], vb[2], vb[3]}; *(LAS f32x4*)(q + 4096 + 4) = (f32x4){vb[4], vb[5], vb[6], vb[7]};
                *(LAS f32x4*)(q + 6144) = (f32x4){vk[0], vk[1], vk[2], vk[3]}; *(LAS f32x4*)(q + 6144 + 4) = (f32x4){vk[4], vk[5], vk[6], vk[7]};
                *(LAS f32x4*)(q + 8192) = (f32x4){rf[0], rf[1], rf[2], rf[3]}; *(LAS f32x4*)(q + 8192 + 4) = (f32x4){rf[4], rf[5], rf[6], rf[7]};
                *(LAS f32x4*)(ob + 10240 + tl * 32 + cs * 4) = (f32x4){bf_lo(vv[0]), bf_hi(vv[0]), bf_lo(vv[1]), bf_hi(vv[1])};
            }
        }
    };
    auto yout = [&](int pi, int pt0, int ybuf) __attribute__((always_inline)) {
        int item, t;
        if (pi < 256) { item = pi; t = pt0 + tl; } else { item = pi + (tl >> 3) * G; t = tl & 7; }
        if (item < nitems) {
            int pm0, pT, ph, phalf, psb; scan_item_info(item, pm0, pT, ph, phalf, psb);
            if (t < pT) {
                const f32x4 y = *(const LAS f32x4*)(lds + 22528 + ybuf * 1024 + tl * 32 + cs * 4);
                u32x2 pk; pk[0] = cvt_pk_bf16(y[0], y[1]); pk[1] = cvt_pk_bf16(y[2], y[3]);
                bf16_t* yb = (pm0 < MP) ? B.YP + (size_t)pm0 * D : B.YS + (size_t)(pm0 - MP) * D;
                *(u32x2*)(yb + (size_t)t * D + ph * 64 + phalf * 32 + cs * 4) = pk;
            }
        }
    };
    auto run_steps = [&](int slot0, int ns) __attribute__((always_inline)) {
        const LAS float* ob = lds + (k & 1) * 11264 + seg * 4 + slot0 * 64;
        const LAS float* vbp = lds + (k & 1) * 11264 + 10240 + 2 * rp + slot0 * 32;
        LAS float* yb = lds + 22528 + (k & 1) * 1024 + 2 * rp + slot0 * 32;
#define SCAN_LOAD(P, tt) do { const int o_ = (tt) * 64; P##d = *(const LAS f32x4*)(ob + o_); P##kk = *(const LAS f32x4*)(ob + 2048 + o_); P##b = *(const LAS f32x4*)(ob + 4096 + o_); \
            P##k = *(const LAS f32x4*)(ob + 6144 + o_); P##r = *(const LAS f32x4*)(ob + 8192 + o_); P##v = *(const LAS f32x2*)(vbp + (tt) * 32); } while (0)
#define SCAN_STEP(P, q0, q1) do { \
            const f32x2 dl = {P##d[0], P##d[1]}, dh = {P##d[2], P##d[3]}, kkl = {P##kk[0], P##kk[1]}, kkh = {P##kk[2], P##kk[3]}, bl = {P##b[0], P##b[1]}, bh = {P##b[2], P##b[3]}; \
            const f32x2 kl = {P##k[0], P##k[1]}, kh = {P##k[2], P##k[3]}, rl = {P##r[0], P##r[1]}, rh = {P##r[2], P##r[3]}; \
            f32x2 pa = sA0 * kkl; pa = sA1 * kkh + pa; f32x2 pb = sB0 * kkl; pb = sB1 * kkh + pb; \
            float p0 = pa[0] + pa[1], p1 = pb[0] + pb[1]; \
            const f32x2 sdA0 = sA0 * dl + kl * P##v[0], sdA1 = sA1 * dh + kh * P##v[0], sdB0 = sB0 * dl + kl * P##v[1], sdB1 = sB1 * dh + kh * P##v[1]; \
            p0 += dpp_f<0xB1>(p0); p1 += dpp_f<0xB1>(p1); p0 += dpp_f<0x4E>(p0); p1 += dpp_f<0x4E>(p1); p0 += dpp_f<0x124>(p0); p1 += dpp_f<0x124>(p1); p0 += dpp_f<0x128>(p0); p1 += dpp_f<0x128>(p1); \
            sA0 = sdA0 - bl * p0; sA1 = sdA1 - bh * p0; sB0 = sdB0 - bl * p1; sB1 = sdB1 - bh * p1; \
            f32x2 qa = sA0 * rl; qa = sA1 * rh + qa; f32x2 qb = sB0 * rl; qb = sB1 * rh + qb; \
            q0 = qa[0] + qa[1]; q1 = qb[0] + qb[1]; } while (0)
        f32x4 Xd, Xkk, Xb, Xk, Xr, Yd, Ykk, Yb, Yk, Yr, Zd, Zkk, Zb, Zk, Zr, Wd, Wkk, Wb, Wk, Wr; f32x2 Xv, Yv, Zv, Wv;
        const bool l0 = (seg & 1) != 0, l1 = (seg & 2) != 0;
#define SCAN_YRED(a0, a1, a2, a3, tt, ok) do { \
            const float s0 = l0 ? a0 : a1, s1 = l0 ? a2 : a3, k0 = l0 ? a1 : a0, k1 = l0 ? a3 : a2; \
            const float w0 = k0 + dpp_f<0xB1>(s0), w1 = k1 + dpp_f<0xB1>(s1); \
            const float s2 = l1 ? w0 : w1, k2 = l1 ? w1 : w0; \
            float z = k2 + dpp_f<0x4E>(s2); \
            z += dpp_f<0x124>(z); z += dpp_f<0x128>(z); \
            if (seg < 4 && (ok)) yb[((tt) + (seg >> 1)) * 32 + (seg & 1)] = z; } while (0)
        __builtin_amdgcn_s_setprio(3);
        SCAN_LOAD(X, 0); SCAN_LOAD(Y, 1);
        float pv0 = 0.f, pv1 = 0.f, pv2 = 0.f, pv3 = 0.f;
        for (int t = 0; t < ns; t += 4) {
            SCAN_LOAD(Z, t + 2); SCAN_LOAD(W, t + 3);
            __builtin_amdgcn_sched_barrier(0);
            { float v0, v1, v2, v3; SCAN_STEP(X, v0, v1); SCAN_YRED(pv0, pv1, pv2, pv3, t - 2, t > 0); SCAN_STEP(Y, v2, v3); pv0 = v0; pv1 = v1; pv2 = v2; pv3 = v3; }
            __builtin_amdgcn_sched_barrier(0);
            { const int tn = (t + 4 < ns) ? t + 4 : t; SCAN_LOAD(X, tn); SCAN_LOAD(Y, tn + 1); }
            __builtin_amdgcn_sched_barrier(0);
            { float v0, v1, v2, v3; SCAN_STEP(Z, v0, v1); SCAN_YRED(pv0, pv1, pv2, pv3, t, true); SCAN_STEP(W, v2, v3); pv0 = v0; pv1 = v1; pv2 = v2; pv3 = v3; }
            __builtin_amdgcn_sched_barrier(0);
        }
        SCAN_YRED(pv0, pv1, pv2, pv3, ns - 2, true);
        __builtin_amdgcn_s_setprio(0);
#undef SCAN_YRED
#undef SCAN_LOAD
#undef SCAN_STEP
    };
    auto state_ptr = [&](int item, bool out) __attribute__((always_inline)) -> float* {
        int pm0, pT, ph, phalf, psb; scan_item_info(item, pm0, pT, ph, phalf, psb);
        const size_t o = (((size_t)psb * NH + ph) * 64 + phalf * 32 + 2 * rp) * 64 + seg * 4;
        return out ? cx.p->out + O_WKVS + o : const_cast<float*>(cx.p->in[2]) + o;
    };

    if (ci < nitems && !consumer) prep(ci, 0, 0);
    __syncthreads();
    int pci = 0, pct0 = 0; bool have_prev = false;
    while (ci < nitems) {
        int ni, nt0 = 0;
        if (ci < 256) { ni = ci; nt0 = ct0 + 32; if (nt0 >= PT) { ni = ci + G; nt0 = 0; } } else ni = ci + 4 * G;
        if (consumer) {
            const bool next_is_group = (ni >= 256) && (ni < nitems) && (ni != ci);
            if (ci < 256) {
                if (ct0 == 0) { sA0 = (f32x2){0.f, 0.f}; sA1 = sA0; sB0 = sA0; sB1 = sA0; }
                if (next_is_group) {
#pragma unroll
                    for (int q = 0; q < 4; ++q) if (ni + q * G < nitems) { const float* sp = state_ptr(ni + q * G, false); pf[q][0] = *(const f32x4*)sp; pf[q][1] = *(const f32x4*)(sp + 64); }
                    pf_valid = true;
                }
                const int ns = (PT - ct0) < 32 ? (PT - ct0) : 32;
                run_steps(0, ns);
                if (ct0 + 32 >= PT) {
                    int pm0, pT, ph, phalf, psb; scan_item_info(ci, pm0, pT, ph, phalf, psb);
                    float* sp = cx.p->out + O_WKVP + (((size_t)(-1 - psb) * NH + ph) * 64 + phalf * 32 + 2 * rp) * 64 + seg * 4;
                    *(f32x4*)sp = (f32x4){sA0[0], sA0[1], sA1[0], sA1[1]}; *(f32x4*)(sp + 64) = (f32x4){sB0[0], sB0[1], sB1[0], sB1[1]};
                }
            } else {
                f32x4 st[4][2];
#pragma unroll
                for (int q = 0; q < 4; ++q) {
                    if (pf_valid) { st[q][0] = pf[q][0]; st[q][1] = pf[q][1]; }
                    else if (ci + q * G < nitems) { const float* sp = state_ptr(ci + q * G, false); st[q][0] = *(const f32x4*)sp; st[q][1] = *(const f32x4*)(sp + 64); }
                    else { st[q][0] = (f32x4){0.f, 0.f, 0.f, 0.f}; st[q][1] = st[q][0]; }
                }
                pf_valid = false;
                if (next_is_group) {
#pragma unroll
                    for (int q = 0; q < 4; ++q) if (ni + q * G < nitems) { const float* sp = state_ptr(ni + q * G, false); pf[q][0] = *(const f32x4*)sp; pf[q][1] = *(const f32x4*)(sp + 64); }
                    pf_valid = true;
                }
#pragma unroll
                for (int q = 0; q < 4; ++q) {
                    if (ci + q * G < nitems) {
                        sA0 = (f32x2){st[q][0][0], st[q][0][1]}; sA1 = (f32x2){st[q][0][2], st[q][0][3]}; sB0 = (f32x2){st[q][1][0], st[q][1][1]}; sB1 = (f32x2){st[q][1][2], st[q][1][3]};
                        asm volatile("" :: "v"(sA0[0]), "v"(sA1[0]), "v"(sB0[0]), "v"(sB1[0]));
                        run_steps(8 * q, 8);
                        float* sp = state_ptr(ci + q * G, true);
                        *(f32x4*)sp = (f32x4){sA0[0], sA0[1], sA1[0], sA1[1]}; *(f32x4*)(sp + 64) = (f32x4){sB0[0], sB0[1], sB1[0], sB1[1]};
                    }
                }
            }
        } else {
            if (ni < nitems) prep(ni, nt0, (k + 1) & 1);
            if (have_prev) yout(pci, pct0, (k - 1) & 1);
        }
        __syncthreads();
        pci = ci; pct0 = ct0; have_prev = true;
        ci = ni; ct0 = nt0; ++k;
    }
    if (have_prev && !consumer) yout(pci, pct0, (k - 1) & 1);
    __syncthreads();
}

#define XB_TMO      128
#define XB_XCNT(j)  (256  + 64 * (j))
#define XB_XSUB(j)  (1280 + 64 * (j))
#define XB_XGEN(j)  (2304 + 64 * (j))
#define XB_TOP      3328
#define XB_TOPGEN   3392
#define XCD_BAR_WORDS 3456
#define XB_SPIN_CAP (1u << 18)
__device__ __forceinline__ unsigned xb_ld(unsigned* p)              { return __hip_atomic_load(p, __ATOMIC_RELAXED, __HIP_MEMORY_SCOPE_AGENT); }
__device__ __forceinline__ unsigned xb_add(unsigned* p, unsigned v) { return __hip_atomic_fetch_add(p, v, __ATOMIC_RELAXED, __HIP_MEMORY_SCOPE_AGENT); }
__device__ __forceinline__ unsigned xb_xcc_id() { return (unsigned)__builtin_amdgcn_s_getreg((3 << 11) | 20) & 0xFu; }
#define XB_SPIN(cond, bar) do { unsigned _sp = 0; while (cond) { __builtin_amdgcn_s_sleep(1); \
    if ((++_sp & 255u) == 0u) { if (xb_ld(&(bar)[XB_TMO])) break; if (_sp > XB_SPIN_CAP) { atomicAdd(&(bar)[XB_TMO], 1u); break; } } } } while (0)
__device__ __forceinline__ void xcd_barrier_complete(unsigned* bar, unsigned x, unsigned G, unsigned& nloc, unsigned& nx) {
    unsigned sum, cnt, mine, sp = 0u;
    for (;;) {
        sum = 0u; cnt = 0u; mine = 0u;
#pragma unroll
        for (unsigned j = 0; j < 16; ++j) { const unsigned c = xb_ld(&bar[XB_XCNT(j)]); sum += c; cnt += (c > 0u) ? 1u : 0u; mine = (j == x) ? c : mine; }
        if (sum == G) break;
        __builtin_amdgcn_s_sleep(1);
        if ((++sp & 255u) == 0u) { if (xb_ld(&bar[XB_TMO])) break; if (sp > XB_SPIN_CAP) { atomicAdd(&bar[XB_TMO], 1u); break; } }
    }
    nloc = mine > 0u ? mine : 1u; nx = cnt > 0u ? cnt : 1u;
}
__device__ __forceinline__ void xcd_barrier(unsigned* bar, volatile LAS unsigned* st, int tid, unsigned G) {
    asm volatile("s_waitcnt vmcnt(0)" ::: "memory");
    __syncthreads();
    if (tid == 0) {
        const unsigned x = xb_xcc_id();
        __builtin_amdgcn_s_waitcnt(0);
        unsigned nloc = st[0], nx = st[1];
        if (nloc == 0u) { xcd_barrier_complete(bar, x, G, nloc, nx); st[0] = nloc; st[1] = nx; }
        const unsigned old = xb_add(&bar[XB_XSUB(x)], 1u);
        const unsigned gen = old / nloc;
        if (old + 1u == (gen + 1u) * nloc) {
            __builtin_amdgcn_fence(__ATOMIC_RELEASE, "agent");
            asm volatile("s_waitcnt vmcnt(0)" ::: "memory");
            const unsigned og = xb_add(&bar[XB_TOP], 1u);
            const unsigned tg = og / nx;
            if (og + 1u == (tg + 1u) * nx) xb_add(&bar[XB_TOPGEN], 1u);
            else XB_SPIN(xb_ld(&bar[XB_TOPGEN]) == tg, bar);
            __builtin_amdgcn_fence(__ATOMIC_ACQUIRE, "agent");
            xb_add(&bar[XB_XGEN(x)], 1u);
            asm volatile("s_waitcnt vmcnt(0)" ::: "memory");
        } else {
            XB_SPIN(xb_ld(&bar[XB_XGEN(x)]) == gen, bar);
            __builtin_amdgcn_fence(__ATOMIC_ACQUIRE, "agent");
            asm volatile("s_waitcnt vmcnt(0)" ::: "memory");
        }
    }
    __syncthreads();
}

#define X_ ((float*)(ws + WS_X))
#define SS_(i) ((float*)(ws + WS_SS))
#define XB_ ((bf16_t*)(ws + WS_X))
__global__ void __launch_bounds__(NTHREADS, 2) mega(Params p) {
    extern __shared__ __attribute__((aligned(16))) unsigned char shm[];
    LAS unsigned char* lds = (LAS unsigned char*)shm;
    LAS float* ldsf = (LAS float*)shm;
    volatile LAS unsigned* bst = (volatile LAS unsigned*)(shm + 131072);
    if (threadIdx.x == 0) { bst[0] = 0u; bst[1] = 0u; (void)xb_add((unsigned*)(p.ws + WS_BAR) + XB_XCNT(xb_xcc_id()), 1u); }
    __syncthreads();
    const int wv_ = __builtin_amdgcn_readfirstlane(threadIdx.x >> 6);
    for (int ph = 0; ph < 19; ++ph) {
#ifdef REP_MASK
        for (int rep = 0; rep < 1 + ((REP_MASK >> ph) & 1); ++rep) {
#else
        { const int rep = 0;
#endif
        Ctx cx;
        { KP kp = (KP)__builtin_amdgcn_kernarg_segment_ptr(); int t_ = wv_ * 64 + (int)__builtin_amdgcn_mbcnt_hi(~0u, __builtin_amdgcn_mbcnt_lo(~0u, 0u)), b_ = blockIdx.x, g_ = gridDim.x;
          asm volatile("" : "+s"(kp), "+v"(t_), "+s"(b_), "+s"(g_));
          cx.p = kp; cx.tid = t_; cx.bid = b_; cx.G = g_; }
        unsigned char* ws = cx.p->ws;
        unsigned char* dob = (unsigned char*)cx.p->out;
        const int G = cx.G, c = cx.bid;
        int kind, f = 0;
        switch (ph) {
            case 0: kind = 0; break;
            case 1: kind = 1; f = 0; break;  case 2: kind = 2; f = 0; break;
            case 3: kind = 3; break; case 4: kind = 4; break; case 5: kind = 5; break; case 6: kind = 6; break; case 7: kind = 7; break;
            case 8: kind = 2; f = 4; break;
            case 9: kind = 1; f = 1; break;  case 10: kind = 2; f = 1; break;
            case 11: kind = 1; f = 2; break; case 12: kind = 2; f = 2; break;
            case 13: kind = 8; break; case 14: kind = 9; break;
            case 15: kind = 2; f = 5; break;
            case 16: kind = 1; f = 3; break; case 17: kind = 2; f = 3; break;
            default: kind = 10; break;
        }
        if (kind == 0) {
            phase_x0(cx, XB_, SS_(0));
            convert(ldsf, cx, T_GU, 0, (bf16_t*)(ws + WS_SLOTA), c, G);
            convert(ldsf, cx, T_DN, 0, (bf16_t*)(ws + WS_SLOTA + SZ_GU), c, G);
            convert(ldsf, cx, T_RKV, 0, (bf16_t*)(ws + WS_WRKV), c, G);
            convert(ldsf, cx, T_L2, 0, (bf16_t*)(ws + WS_WL2), c, G);
            convert(ldsf, cx, T_PLAIN, 26, (bf16_t*)(ws + WS_WO), c, G);
        } else if (kind == 1) {
            const int ssi = f == 0 ? 0 : (f == 1 ? 2 : (f == 2 ? 3 : 5));
            const unsigned char* slot = ws + ((f & 1) ? WS_SLOTB : WS_SLOTA);
            pg8::Gemm g; g.A = XB_; g.Bt = (const bf16_t*)slot; g.K = D;
            pg8::StaticOrder S; S.init(MPAD / 256, 22, G, c, g.K);
            EpiGU E; E.ss = SS_(ssi); E.act = (bf16_t*)(ws + B_ACT);
            pg8::gemm_phase(lds, g, S, E, cx.tid);
        } else if (kind == 2) {
            pg8::Gemm g; EpiRes E; E.XB = XB_;
            if (f < 4) { g.A = (const bf16_t*)(ws + B_ACT); g.Bt = (const bf16_t*)(ws + ((f & 1) ? WS_SLOTB : WS_SLOTA) + SZ_GU); g.K = FF; E.scale = 0.5f;
                         E.ssout = SS_(f == 0 ? 1 : (f == 1 ? 3 : (f == 2 ? 4 : 6))); }
            else if (f == 4) { g.A = (const bf16_t*)(ws + B_O); g.Bt = (const bf16_t*)(ws + WS_WO); g.K = D; E.scale = 1.f; E.ssout = SS_(2); }
            else { g.A = (const bf16_t*)(ws + B_CV); g.Bt = (const bf16_t*)(ws + WS_WOUT); g.K = D; E.scale = 1.f; E.ssout = SS_(5); }
            if (rep) E.scale = 0.f;
            if (f < 4 && G == 256) {
                f32x4* slab = (f32x4*)(ws + WS_BIG + SZ_ACT);
                pg8::SplitOrder S; S.init(MPAD / 256, 4, G, c, g.K);
                pg8::gemm_phase(lds, g, S, E, cx.tid, slab);
                if (rep == 0 && f == 2 && c >= 140) {
                    convert(ldsf, cx, T_GU, 3, (bf16_t*)(ws + WS_SLOTB), c - 140, G - 140);
                    convert(ldsf, cx, T_DN, 3, (bf16_t*)(ws + WS_SLOTB + SZ_GU), c - 140, G - 140);
                }
                xcd_barrier((unsigned*)(ws + WS_BAR), bst, cx.tid, (unsigned)G);
                if (c < 160) {
                    const int lt = c >> 3;
                    pg8::Unit u; S.tile(256 + lt, u);
                    int t_ = cx.tid; asm volatile("" : "+v"(t_));
                    const int wid = t_ >> 6, lane = t_ & 63, wr = wid >> 2, wc = wid & 3, fr = lane & 15, fq = lane >> 4;
                    const f32x4* sp = slab + (size_t)(lt * 7) * 32 * 512 + t_;
                    const int row0 = u.pm * 256 + wr * 64 + fr, col0 = u.pn * 256 + wc * 32 + 8 * fq;
                    {
                        const int am = c & 7;
                        const int ai = am >> 2, m = am & 3, r = row0 + ai * 128 + m * 16;
                        f32x4 a[2][2];
#pragma unroll
                        for (int bj = 0; bj < 2; ++bj)
#pragma unroll
                            for (int n = 0; n < 2; ++n) {
                                const int idx = ((ai * 2 + bj) * 4 + m) * 2 + n;
                                f32x4 t = sp[(size_t)idx * 512];
#pragma unroll
                                for (int part = 1; part < 7; ++part) t += sp[(size_t)(part * 32 + idx) * 512];
                                a[bj][n] = t;
                            }
                        float ssum = 0.f;
#pragma unroll
                        for (int bj = 0; bj < 2; ++bj) {
                            bf16_t* xp = E.XB + (size_t)r * D + col0 + bj * 128;
                            float o[8]; unpack8(*(const u32x4*)xp, o);
#pragma unroll
                            for (int jj = 0; jj < 4; ++jj) { o[jj] += a[bj][0][jj] * E.scale; o[4 + jj] += a[bj][1][jj] * E.scale; }
                            *(u32x4*)xp = pack8(o);
#pragma unroll
                            for (int jj = 0; jj < 8; ++jj) ssum += o[jj] * o[jj];
                        }
                        ssum += __shfl_xor(ssum, 16); ssum += __shfl_xor(ssum, 32);
                        if (fq == 0) E.ssout[(size_t)r * 16 + u.pn * 4 + wc] = ssum;
                    }
                }
            } else {
            pg8::StaticOrder S; S.init(MPAD / 256, 4, G, c, g.K);
            pg8::gemm_phase(lds, g, S, E, cx.tid);
            if (rep == 0) {
            const int nbusy = (MPAD / 256) * 4 - G;
            if (G > 2 * nbusy && nbusy >= 0) {
                if (c >= nbusy) {
                    const int wg = c - nbusy, nwg = G - nbusy;
                    if (f == 4) {
                        convert(ldsf, cx, T_GU, 1, (bf16_t*)(ws + WS_SLOTB), wg, nwg);
                        convert(ldsf, cx, T_DN, 1, (bf16_t*)(ws + WS_SLOTB + SZ_GU), wg, nwg);
                        convert(ldsf, cx, T_GU, 2, (bf16_t*)(ws + WS_SLOTA), wg, nwg);
                        convert(ldsf, cx, T_DN, 2, (bf16_t*)(ws + WS_SLOTA + SZ_GU), wg, nwg);
                        convert(ldsf, cx, T_WIN, 0, (bf16_t*)(ws + WS_WIN), wg, nwg);
                        convert(ldsf, cx, T_PLAIN, 29, (bf16_t*)(ws + WS_WOUT), wg, nwg);
                    } else if (f == 2) {
                        convert(ldsf, cx, T_GU, 3, (bf16_t*)(ws + WS_SLOTB), wg, nwg);
                        convert(ldsf, cx, T_DN, 3, (bf16_t*)(ws + WS_SLOTB + SZ_GU), wg, nwg);
                    }
                }
            } else {
                if (f == 4) {
                    convert(ldsf, cx, T_GU, 1, (bf16_t*)(ws + WS_SLOTB), c, G);
                    convert(ldsf, cx, T_DN, 1, (bf16_t*)(ws + WS_SLOTB + SZ_GU), c, G);
                    convert(ldsf, cx, T_GU, 2, (bf16_t*)(ws + WS_SLOTA), c, G);
                    convert(ldsf, cx, T_DN, 2, (bf16_t*)(ws + WS_SLOTA + SZ_GU), c, G);
                    convert(ldsf, cx, T_WIN, 0, (bf16_t*)(ws + WS_WIN), c, G);
                    convert(ldsf, cx, T_PLAIN, 29, (bf16_t*)(ws + WS_WOUT), c, G);
                } else if (f == 2) {
                    convert(ldsf, cx, T_GU, 3, (bf16_t*)(ws + WS_SLOTB), c, G);
                    convert(ldsf, cx, T_DN, 3, (bf16_t*)(ws + WS_SLOTB + SZ_GU), c, G);
                }
            }
            }
            }
        } else if (kind == 3) {
            phase_mix(cx, XB_, SS_(1), (bf16_t*)(ws + B_HH));
        } else if (kind == 4) {
            pg8::Gemm g; g.A = (const bf16_t*)(ws + B_HH); g.Bt = (const bf16_t*)(ws + WS_WRKV); g.K = 2048;
            pg8::StaticOrder S; S.init(MPAD / 256, 14, G, c, g.K);
            EpiRKV E; E.ws = ws; E.dob = dob;
            pg8::gemm_phase(lds, g, S, E, cx.tid);
        } else if (kind == 5) {
            pg8::Gemm g; g.A = (const bf16_t*)(dob + DO_L1); g.Bt = (const bf16_t*)(ws + WS_WL2); g.K = 384;
            pg8::StaticOrder S; S.init(MPAD / 256, 12, G, c, g.K);
            EpiL2 E; E.ws = ws; E.w0 = cx.p->in[13]; E.a0 = cx.p->in[16];
            pg8::gemm_phase(lds, g, S, E, cx.tid);
        } else if (kind == 6) {
            ScanBufs sbf; sbf.R = (const bf16_t*)(ws + B_R); sbf.K = (const bf16_t*)(ws + B_K); sbf.V = (const bf16_t*)(dob + DO_XB); sbf.LW = (const bf16_t*)(ws + B_LW);
            sbf.A = (const bf16_t*)(ws + B_A); sbf.YP = (bf16_t*)(dob + DO_YPR); sbf.YS = (bf16_t*)(ws + L_YS); sbf.CB = (float*)(ws + WS_X + ROWB);
            phase_scan(ldsf, cx, sbf);
        } else if (kind == 7) {
            phase_post(cx, (const bf16_t*)(dob + DO_YPR), (const bf16_t*)(ws + L_YS), (const float*)(ws + WS_X + ROWB), (const bf16_t*)(dob + DO_XB),
                       (const bf16_t*)(ws + L_G), (bf16_t*)(ws + B_O));
        } else if (kind == 8) {
            pg8::Gemm g; g.A = XB_; g.Bt = (const bf16_t*)(ws + WS_WIN); g.K = D;
            pg8::StaticOrder S; S.init(MPAD / 256, 12, G, c, g.K);
            EpiCI E; E.ss = SS_(4); E.U = (bf16_t*)(ws + B_U); E.GB = (bf16_t*)(ws + B_GB); E.out = cx.p->out;
            pg8::gemm_phase(lds, g, S, E, cx.tid);
        } else if (kind == 9) {
            phase_conv(cx, (const bf16_t*)(ws + B_U), (const bf16_t*)(ws + B_GB), (bf16_t*)(ws + B_CV));
        } else {
            phase_final(cx, XB_, SS_(6));
        }
        if (ph < 18) xcd_barrier((unsigned*)(ws + WS_BAR), bst, cx.tid, (unsigned)G);
        }
    }
}

extern "C" void kernel_launch(void* const* d_in, const int* in_sizes, int n_in, void* d_out, int out_size, void* d_ws, size_t ws_size, hipStream_t stream) {
    static int grid_blocks = 0;
    if (grid_blocks == 0) {
        if (n_in != 30 || (size_t)out_size != O_END || ws_size < WS_END) {
            fprintf(stderr, "kernel_launch: unexpected shapes: n_in %d out_size %d ws_size %zu (need %zu)\n", n_in, out_size, ws_size, (size_t)WS_END);
            grid_blocks = -1; return;
        }
        int dev = 0, cus = 0, per_cu = 0;
        (void)hipGetDevice(&dev);
        (void)hipDeviceGetAttribute(&cus, hipDeviceAttributeMultiprocessorCount, dev);
        (void)hipFuncSetAttribute((const void*)mega, hipFuncAttributeMaxDynamicSharedMemorySize, LDS_BYTES);
        (void)hipOccupancyMaxActiveBlocksPerMultiprocessor(&per_cu, (const void*)mega, NTHREADS, LDS_BYTES);
        if (per_cu < 1) per_cu = 1;
        grid_blocks = cus * per_cu;
        if (grid_blocks > 256) grid_blocks = 256;
    }
    if (grid_blocks < 0) return;
    (void)hipMemsetAsync((char*)d_ws, 0, WS_CTL_END, stream);
    Params p{};
    for (int i = 0; i < 30; ++i) p.in[i] = (const float*)d_in[i];
    p.out = (float*)d_out; p.ws = (unsigned char*)d_ws;
    void* args[] = {&p};
    hipError_t e = hipLaunchCooperativeKernel((const void*)mega, dim3(grid_blocks), dim3(NTHREADS), args, LDS_BYTES, stream);
    if (e != hipSuccess) fprintf(stderr, "cooperative launch failed: %s (grid %d)\n", hipGetErrorString(e), grid_blocks);
}
```

```cpp
#include <hip/hip_runtime.h>
#include <hip/hip_cooperative_groups.h>
#include <cstdio>
#include <cstdint>
namespace cg = cooperative_groups;

#define LAS __attribute__((address_space(3)))
typedef unsigned short bf16_t;
typedef short bf16x8 __attribute__((ext_vector_type(8)));
typedef float f32x4 __attribute__((ext_vector_type(4)));
typedef float f32x2 __attribute__((ext_vector_type(2)));
typedef unsigned u32x4 __attribute__((ext_vector_type(4)));
typedef unsigned u32x2 __attribute__((ext_vector_type(2)));

constexpr int D = 1024, FF = 2816, NH = 16;
constexpr int PB = 8, PT = 2064, NMETA = 16, PTX = 2048, SBN = 128, STN = 8;
constexpr int MP = PB * PT;
constexpr int MS = SBN * STN;
constexpr int M = MP + MS;
constexpr int MPAD = 17664;
constexpr int NTHREADS = 512;
constexpr int LDS_BYTES = 131072 + 16;

constexpr size_t O_YP = 0;
constexpr size_t O_YS = O_YP + (size_t)PB * PTX * D;
constexpr size_t O_WKVP = O_YS + (size_t)MS * D;
constexpr size_t O_SHP = O_WKVP + (size_t)PB * NH * 64 * 64;
constexpr size_t O_CVP = O_SHP + (size_t)PB * D;
constexpr size_t O_WKVS = O_CVP + (size_t)PB * 2 * D;
constexpr size_t O_SHS = O_WKVS + (size_t)SBN * NH * 64 * 64;
constexpr size_t O_CVS = O_SHS + (size_t)SBN * D;
constexpr size_t O_END = O_CVS + (size_t)SBN * 2 * D;

constexpr size_t AL(size_t x) { return (x + 255) & ~(size_t)255; }
constexpr size_t ROWB = (size_t)MPAD * D * 2;
constexpr size_t WS_BAR = 0;
constexpr size_t WS_CTL_END = 16384;
constexpr size_t WS_SS = 16384;
constexpr size_t WS_SS_END = AL(WS_SS + (size_t)MPAD * 16 * 4);
constexpr size_t WS_X = WS_SS_END;
constexpr size_t WS_MISC = AL(WS_X + (size_t)MPAD * D * 4);
constexpr size_t SZ_WRKV = (size_t)3584 * 2048 * 2;
constexpr size_t SZ_WL2 = (size_t)3072 * 384 * 2;
constexpr size_t SZ_W1K = (size_t)1024 * 1024 * 2;
constexpr size_t WS_WRKV = WS_MISC;
constexpr size_t WS_WL2 = AL(WS_WRKV + SZ_WRKV);
constexpr size_t WS_WO = AL(WS_WL2 + SZ_WL2);
constexpr size_t WS_BIG = AL(WS_WO + SZ_W1K);
constexpr size_t SZ_BIG = (size_t)MPAD * 2048 * 2 * 2 + 4096;
constexpr size_t WS_LAZY = AL(WS_BIG + SZ_BIG);
constexpr size_t SZ_GU = (size_t)5632 * 1024 * 2;
constexpr size_t SZ_DN = (size_t)1024 * 2816 * 2;
constexpr size_t SZ_SLOT = SZ_GU + SZ_DN;
constexpr size_t WS_SLOTA = WS_LAZY;
constexpr size_t WS_SLOTB = WS_SLOTA + SZ_SLOT;
constexpr size_t WS_WIN = WS_SLOTB + SZ_SLOT;
constexpr size_t WS_WOUT = WS_WIN + (size_t)3072 * 1024 * 2;
constexpr size_t WS_END = WS_WOUT + SZ_W1K;
constexpr size_t B_ACT = WS_BIG;
constexpr size_t B_HH = WS_BIG;
constexpr size_t B_R = WS_BIG + 2 * ROWB;
constexpr size_t B_K = WS_BIG + 3 * ROWB;
constexpr size_t B_LW = WS_BIG;
constexpr size_t B_A = WS_BIG + ROWB;
constexpr size_t B_O = WS_BIG;
constexpr size_t B_U = WS_BIG;
constexpr size_t B_GB = WS_BIG + ROWB;
constexpr size_t B_CV = WS_BIG + 2 * ROWB;
constexpr size_t DO_XB = 0;
constexpr size_t DO_L1 = ROWB;
constexpr size_t DO_YPR = ROWB;
static_assert(DO_YPR + (size_t)MP * D * 2 <= O_WKVP * 4, "y-region overflow");
static_assert(DO_L1 + (size_t)MPAD * 384 * 2 <= O_WKVP * 4, "l1 overflow");
constexpr size_t L_G = WS_LAZY;
constexpr size_t L_YS = WS_LAZY + ROWB;
static_assert(L_YS + (size_t)MS * D * 2 <= WS_END, "lazy overflow");
constexpr size_t SZ_ACT = (size_t)MPAD * 2816 * 2;
static_assert(SZ_BIG >= SZ_ACT + (size_t)140 * 32 * 512 * 16, "ACT + split-K slab do not fit");

struct Params {
    const float* in[30];
    float* out;
    unsigned char* ws;
};
typedef const __attribute__((address_space(4))) Params* KP;
struct Ctx { KP p; int tid, bid, G; };

__device__ __forceinline__ unsigned cvt_pk_bf16(float lo, float hi) { unsigned r; asm volatile("v_cvt_pk_bf16_f32 %0, %1, %2" : "=v"(r) : "v"(lo), "v"(hi)); return r; }
__device__ __forceinline__ float bf_lo(unsigned v) { return __uint_as_float(v << 16); }
__device__ __forceinline__ float bf_hi(unsigned v) { return __uint_as_float(v & 0xffff0000u); }
__device__ __forceinline__ float frcp(float x) { return __builtin_amdgcn_rcpf(x); }
__device__ __forceinline__ float fsigmoid(float x) { return frcp(1.f + __expf(-x)); }
__device__ __forceinline__ void unpack8(u32x4 v, float* o) {
    o[0] = bf_lo(v[0]); o[1] = bf_hi(v[0]); o[2] = bf_lo(v[1]); o[3] = bf_hi(v[1]);
    o[4] = bf_lo(v[2]); o[5] = bf_hi(v[2]); o[6] = bf_lo(v[3]); o[7] = bf_hi(v[3]);
}
__device__ __forceinline__ u32x4 pack8(const float* o) {
    u32x4 r; r[0] = cvt_pk_bf16(o[0], o[1]); r[1] = cvt_pk_bf16(o[2], o[3]); r[2] = cvt_pk_bf16(o[4], o[5]); r[3] = cvt_pk_bf16(o[6], o[7]); return r;
}
template <int CTRL> __device__ __forceinline__ float dpp_f(float x) {
    return __int_as_float(__builtin_amdgcn_update_dpp(0, __float_as_int(x), CTRL, 0xF, 0xF, false));
}
__device__ __forceinline__ float allreduce16(float p) {
    p += dpp_f<0xB1>(p); p += dpp_f<0x4E>(p); p += dpp_f<0x124>(p); p += dpp_f<0x128>(p); return p;
}
__device__ __forceinline__ float allreduce8(float p) {
    p += dpp_f<0xB1>(p); p += dpp_f<0x4E>(p); p += __shfl_xor(p, 4); return p;
}
__device__ __forceinline__ float wave_sum(float p) {
#pragma unroll
    for (int o = 32; o >= 1; o >>= 1) p += __shfl_xor(p, o);
    return p;
}
__device__ __forceinline__ float row_rs(const float* ssp, int r) {
    const f32x4 a = *(const f32x4*)(ssp + (size_t)r * 16), b = *(const f32x4*)(ssp + (size_t)r * 16 + 4), c = *(const f32x4*)(ssp + (size_t)r * 16 + 8), d = *(const f32x4*)(ssp + (size_t)r * 16 + 12);
    const float s = ((a[0] + a[1]) + (a[2] + a[3])) + ((b[0] + b[1]) + (b[2] + b[3])) + ((c[0] + c[1]) + (c[2] + c[3])) + ((d[0] + d[1]) + (d[2] + d[3]));
    return rsqrtf(s * (1.f / 1024.f) + 1e-6f);
}
__device__ __forceinline__ void row_info(int m, int& t, int& T, int& seq) {
    if (m < MP) { seq = m / PT; t = m - seq * PT; T = PT; }
    else { const int q = m - MP; seq = 8 + (q >> 3); t = q & 7; T = STN; }
}

namespace pg8 {
constexpr int BM = 256, BK = 64, HALF = 128, HTB = HALF * BK * 2, STAGE_BYTES = 8 * HTB, NXCD = 8, WGM = 4;
__host__ __device__ __forceinline__ int lds_byte(int r, int c) { const int st = (r >> 4) * 2 + (c >> 5), rr = r & 15, cc = c & 31, ob = rr * 64 + cc * 2; return st * 1024 + (ob ^ (((ob >> 9) & 1) << 5)); }
__host__ __device__ __forceinline__ void stage_rc(int b, int& R, int& C) { const int st = b / 1024, sb = b % 1024, swz = sb ^ (((sb >> 9) & 1) << 5); R = (st >> 1) * 16 + swz / 64; C = (st & 1) * 32 + (swz % 64) / 2; }
__host__ __device__ __forceinline__ int perm32(int rho) { const int n = rho >> 4, i = rho & 15; return 8 * (i >> 2) + 4 * n + (i & 3); }

struct Unit { int pm, pn, k0, nt, sub; };
struct Gemm { const bf16_t* A; const bf16_t* Bt; int K; };
struct StaticOrder {
    int nM, nN, nwg, G, c;
    int ntK; int wgm;
    __device__ __forceinline__ void init(int nM_, int nN_, int G_, int c_, int K_) { nM = nM_; nN = nN_; nwg = nM * nN; G = G_; c = c_; ntK = K_ / BK; wgm = (nN_ == 22) ? 8 : 4; }
    __device__ __forceinline__ void tile(int L, Unit& u) const {
        int wgid = L; { const int q = nwg / NXCD, r = nwg % NXCD, xcd = wgid % NXCD, off = wgid / NXCD; wgid = (xcd < r ? xcd * (q + 1) : r * (q + 1) + (xcd - r) * q) + off; }
        const int nig = wgm * nN, gid = wgid / nig, fm = gid * wgm, gsz = (nM - fm) < wgm ? (nM - fm) : wgm;
        u.pm = fm + ((wgid % nig) % gsz); u.pn = (wgid % nig) / gsz; u.k0 = 0; u.nt = ntK; u.sub = -1;
    }
    __device__ __forceinline__ bool next(int i, Unit& u) const {
        const long L = (long)i * G + c; if (L >= nwg) return false;
        u.k0 = 0; u.nt = ntK; u.sub = -1;
        int wgid = (int)L; { const int q = nwg / NXCD, r = nwg % NXCD, xcd = wgid % NXCD, off = wgid / NXCD; wgid = (xcd < r ? xcd * (q + 1) : r * (q + 1) + (xcd - r) * q) + off; }
        const int nig = wgm * nN, gid = wgid / nig, fm = gid * wgm, gsz = (nM - fm) < wgm ? (nM - fm) : wgm;
        u.pm = fm + ((wgid % nig) % gsz); u.pn = (wgid % nig) / gsz; return true;
    }
};

struct SplitOrder : StaticOrder {
    __device__ __forceinline__ bool next(int i, Unit& u) const {
        if (i == 0) { tile(c, u); return true; }
        if (i == 1 && c < 140) { tile(256 + c / 7, u); const int part = c % 7; u.k0 = part * 6; u.nt = part == 6 ? 8 : 6; u.sub = c; return true; }
        return false;
    }
};
struct L2Order : StaticOrder {
    __device__ __forceinline__ bool next(int i, Unit& u) const {
        if (!StaticOrder::next(i, u)) return false;
        if (u.pn < 8) { u.k0 = 0; u.nt = 2; } else { u.k0 = 2; u.nt = 4; }
        return true;
    }
};
template <class Epi, class Sched>
__device__ __forceinline__ void gemm_phase(LAS unsigned char* lds, const Gemm g, const Sched& S, const Epi& E, const int tid_, f32x4* slab = nullptr) {
    const int tid = tid_, wid = __builtin_amdgcn_readfirstlane(tid >> 6), lane = tid & 63, wr = wid >> 2, wc = wid & 3, fr = lane & 15, fq = lane >> 4;
    const int K = g.K;
    unsigned voffA[2], voffB[2];
#pragma unroll
    for (int i = 0; i < 2; ++i) { int R, C; stage_rc(tid * 16 + i * 8192, R, C); const int Rb = (R & ~31) + perm32(R & 31);
        voffA[i] = (unsigned)(R * K + C) * 2u; voffB[i] = (unsigned)(Rb * K + C) * 2u; }
    const size_t kstep = (size_t)(BK * 2);
    const size_t hstep = (size_t)HALF * K * 2;
    const size_t tstep = 2 * hstep;
    const unsigned ldsw = (unsigned)wid * 1024u;
    const int aoff = lds_byte(wr * 64 + fr, fq * 8), boff = lds_byte(wc * 32 + fr, fq * 8);
#define PG8_SA(b, h) (((b) * 2 + (h)) * HTB)
#define PG8_SB(b, h) ((4 + (b) * 2 + (h)) * HTB)
#define PG8_STAGE(bufoff, gbase, voff) do { _Pragma("unroll") for (int _i = 0; _i < 2; ++_i) \
        __builtin_amdgcn_global_load_lds((const unsigned*)((const char*)(gbase) + (voff)[_i]), (LAS unsigned*)(lds + (bufoff) + ldsw + _i * 8192), 16, 0, 0); } while (0)
#define PG8_LDA(dst, b, h) do { _Pragma("unroll") for (int m = 0; m < 4; ++m) _Pragma("unroll") for (int k = 0; k < 2; ++k) dst[m][k] = *(const LAS bf16x8*)(lds + PG8_SA(b, h) + aoff + m * 2048 + k * 1024); } while (0)
#define PG8_LDB(dst, b, h) do { _Pragma("unroll") for (int n = 0; n < 2; ++n) _Pragma("unroll") for (int k = 0; k < 2; ++k) dst[n][k] = *(const LAS bf16x8*)(lds + PG8_SB(b, h) + boff + n * 2048 + k * 1024); } while (0)
#define PG8_MMA(ai, bj, At, Bt) do { __builtin_amdgcn_s_setprio(1); _Pragma("unroll") for (int m = 0; m < 4; ++m) _Pragma("unroll") for (int n = 0; n < 2; ++n) _Pragma("unroll") for (int k = 0; k < 2; ++k) \
        acc[ai][bj][m][n] = __builtin_amdgcn_mfma_f32_16x16x32_bf16(Bt[n][k], At[m][k], acc[ai][bj][m][n], 0, 0, 0); __builtin_amdgcn_s_setprio(0); } while (0)
#define PG8_WAIT_V(n) asm volatile("s_waitcnt vmcnt(" #n ")" ::: "memory")
#define PG8_WAIT_L(n) asm volatile("s_waitcnt lgkmcnt(" #n ")" ::: "memory")
#define PG8_BAR __builtin_amdgcn_s_barrier()
#define PG8_SCHED __builtin_amdgcn_sched_barrier(0)
    Unit cur, nxt; int ui = 0;
    if (!S.next(0, cur)) return;
    f32x4 acc[2][2][4][2];
#pragma unroll
    for (int a = 0; a < 2; ++a)
#pragma unroll
        for (int b = 0; b < 2; ++b)
#pragma unroll
            for (int m = 0; m < 4; ++m)
#pragma unroll
                for (int n = 0; n < 2; ++n) acc[a][b][m][n] = (f32x4){0.f, 0.f, 0.f, 0.f};
    bf16x8 At[4][2], B0[2][2], B1[2][2];
    const char* cA = (const char*)g.A + (size_t)cur.pm * tstep + (size_t)cur.k0 * kstep; const char* cB = (const char*)g.Bt + (size_t)cur.pn * tstep + (size_t)cur.k0 * kstep;
    PG8_STAGE(PG8_SB(0, 0), cB, voffB); PG8_STAGE(PG8_SA(0, 0), cA, voffA); PG8_STAGE(PG8_SB(0, 1), cB + hstep, voffB); PG8_STAGE(PG8_SA(0, 1), cA + hstep, voffA);
    if (wr == 1) PG8_BAR;
    PG8_WAIT_V(4); PG8_BAR;
    PG8_STAGE(PG8_SB(1, 0), cB + kstep, voffB); PG8_STAGE(PG8_SA(1, 0), cA + kstep, voffA); PG8_STAGE(PG8_SB(1, 1), cB + hstep + kstep, voffB);
    PG8_WAIT_V(6); PG8_BAR;
    for (;;) {
        const bool has_next = S.next(ui + 1, nxt);
        const char* nA = has_next ? (const char*)g.A + (size_t)nxt.pm * tstep + (size_t)nxt.k0 * kstep : cA; const char* nB = has_next ? (const char*)g.Bt + (size_t)nxt.pn * tstep + (size_t)nxt.k0 * kstep : cB;
        const int nt = cur.nt;
        for (int t = 0; t < nt; t += 2) {
            const bool last = (t == nt - 2);
            const char* a1 = cA + (size_t)(t + 1) * kstep;
            const char* a2 = last ? nA : cA + (size_t)(t + 2) * kstep; const char* b2 = last ? nB : cB + (size_t)(t + 2) * kstep;
            const char* a3 = a2 + kstep; const char* b3 = b2 + kstep;
            PG8_LDB(B0, 0, 0); PG8_SCHED; PG8_LDA(At, 0, 0); PG8_STAGE(PG8_SA(1, 1), a1 + hstep, voffA);
            PG8_WAIT_L(8); PG8_BAR; PG8_WAIT_L(0); PG8_MMA(0, 0, At, B0); PG8_BAR; PG8_SCHED;
            PG8_LDB(B1, 0, 1); PG8_STAGE(PG8_SB(0, 0), b2, voffB);
            PG8_BAR; PG8_WAIT_L(0); PG8_MMA(0, 1, At, B1); PG8_BAR;
            PG8_LDA(At, 0, 1); PG8_STAGE(PG8_SA(0, 0), a2, voffA);
            PG8_BAR; PG8_WAIT_L(0); PG8_MMA(1, 0, At, B0); PG8_BAR; PG8_SCHED;
            PG8_STAGE(PG8_SB(0, 1), b2 + hstep, voffB);
            PG8_WAIT_V(6); PG8_BAR; PG8_MMA(1, 1, At, B1); PG8_BAR;
            PG8_LDB(B0, 1, 0); PG8_SCHED; PG8_LDA(At, 1, 0); PG8_STAGE(PG8_SA(0, 1), a2 + hstep, voffA);
            PG8_WAIT_L(8); PG8_BAR; PG8_WAIT_L(0); PG8_MMA(0, 0, At, B0); PG8_BAR; PG8_SCHED;
            PG8_LDB(B1, 1, 1); PG8_STAGE(PG8_SB(1, 0), b3, voffB);
            PG8_BAR; PG8_WAIT_L(0); PG8_MMA(0, 1, At, B1); PG8_BAR;
            PG8_LDA(At, 1, 1); PG8_STAGE(PG8_SA(1, 0), a3, voffA);
            PG8_BAR; PG8_WAIT_L(0); PG8_MMA(1, 0, At, B0); PG8_BAR; PG8_SCHED;
            PG8_STAGE(PG8_SB(1, 1), b3 + hstep, voffB);
            PG8_WAIT_V(6); PG8_BAR; PG8_MMA(1, 1, At, B1); PG8_BAR;
        }
        if (cur.sub < 0) { int fr_ = fr, fq_ = fq; asm volatile("" : "+v"(fr_), "+v"(fq_)); E(acc, cur, wr, wc, fr_, fq_); }
        else {
            int t_ = tid; asm volatile("" : "+v"(t_));
            f32x4* sp = slab + (size_t)cur.sub * 32 * 512 + t_;
#pragma unroll
            for (int a = 0; a < 2; ++a)
#pragma unroll
                for (int b = 0; b < 2; ++b)
#pragma unroll
                    for (int m = 0; m < 4; ++m)
#pragma unroll
                        for (int n = 0; n < 2; ++n) sp[(size_t)(((a * 2 + b) * 4 + m) * 2 + n) * 512] = acc[a][b][m][n];
        }
        if (!has_next) break;
#pragma unroll
        for (int a = 0; a < 2; ++a)
#pragma unroll
            for (int b = 0; b < 2; ++b)
#pragma unroll
                for (int m = 0; m < 4; ++m)
#pragma unroll
                    for (int n = 0; n < 2; ++n) acc[a][b][m][n] = (f32x4){0.f, 0.f, 0.f, 0.f};
        cur = nxt; cA = nA; cB = nB; ++ui;
    }
    PG8_WAIT_V(0);
    if (wr == 0) PG8_BAR;
    PG8_BAR;
#undef PG8_SA
#undef PG8_SB
#undef PG8_STAGE
#undef PG8_LDA
#undef PG8_LDB
#undef PG8_MMA
#undef PG8_WAIT_V
#undef PG8_WAIT_L
#undef PG8_BAR
#undef PG8_SCHED
}
}
using pg8::Unit;

__device__ __forceinline__ void rows_rs8(const float* ss, int row0  , int fq, float (&rsv)[8]) {
    f32x4 part[8];
#pragma unroll
    for (int i = 0; i < 8; ++i) part[i] = *(const f32x4*)(ss + (size_t)(row0 + (i >> 2) * 128 + (i & 3) * 16) * 16 + 4 * fq);
#pragma unroll
    for (int i = 0; i < 8; ++i) {
        float t = (part[i][0] + part[i][1]) + (part[i][2] + part[i][3]);
        t += __shfl_xor(t, 16); t += __shfl_xor(t, 32);
        rsv[i] = rsqrtf(t * (1.f / 1024.f) + 1e-6f);
    }
}
struct EpiGU {
    const float* ss; bf16_t* act;
    __device__ __forceinline__ void operator()(const f32x4 (&acc)[2][2][4][2], const Unit& u, int wr, int wc, int fr, int fq) const {
        const int col = u.pn * 128 + wc * 32 + 8 * fq;
        const int row0 = u.pm * 256 + wr * 64 + fr;
        float rsv[8]; rows_rs8(ss, row0, fq, rsv);
#pragma unroll
        for (int ai = 0; ai < 2; ++ai)
#pragma unroll
            for (int m = 0; m < 4; ++m) {
                const int r = row0 + ai * 128 + m * 16;
                const float rs = rsv[ai * 4 + m];
                float o[8];
#pragma unroll
                for (int n = 0; n < 2; ++n)
#pragma unroll
                    for (int j = 0; j < 4; ++j) { const float gt = acc[ai][0][m][n][j] * rs, up = acc[ai][1][m][n][j] * rs; o[n * 4 + j] = gt * fsigmoid(gt) * up; }
                *(u32x4*)(act + (size_t)r * FF + col) = pack8(o);
            }
    }
};
struct EpiRes {
    bf16_t* XB; float* ssout; float scale;
    __device__ __forceinline__ void operator()(const f32x4 (&acc)[2][2][4][2], const Unit& u, int wr, int wc, int fr, int fq) const {
        const int row0 = u.pm * 256 + wr * 64 + fr, col0 = u.pn * 256 + wc * 32 + 8 * fq;
#pragma unroll
        for (int ai = 0; ai < 2; ++ai) {
            u32x4 xv[4][2];
#pragma unroll
            for (int m = 0; m < 4; ++m)
#pragma unroll
                for (int bj = 0; bj < 2; ++bj) xv[m][bj] = *(const u32x4*)(XB + (size_t)(row0 + ai * 128 + m * 16) * D + col0 + bj * 128);
#pragma unroll
            for (int m = 0; m < 4; ++m) {
                const int r = row0 + ai * 128 + m * 16;
                float ssum = 0.f;
#pragma unroll
                for (int bj = 0; bj < 2; ++bj) {
                    float o[8]; unpack8(xv[m][bj], o);
#pragma unroll
                    for (int j = 0; j < 4; ++j) { o[j] += acc[ai][bj][m][0][j] * scale; o[4 + j] += acc[ai][bj][m][1][j] * scale; }
                    *(u32x4*)(XB + (size_t)r * D + col0 + bj * 128) = pack8(o);
#pragma unroll
                    for (int j = 0; j < 8; ++j) ssum += o[j] * o[j];
                }
                ssum += __shfl_xor(ssum, 16); ssum += __shfl_xor(ssum, 32);
                if (fq == 0) ssout[(size_t)r * 16 + u.pn * 4 + wc] = ssum;
            }
        }
    }
};
struct EpiRKV {
    unsigned char* ws; unsigned char* dob;
    __device__ __forceinline__ void operator()(const f32x4 (&acc)[2][2][4][2], const Unit& u, int wr, int wc, int fr, int fq) const {
        if (u.pn < 12) {
            bf16_t* base = (u.pn < 8) ? (bf16_t*)(ws + B_R + (size_t)(u.pn >> 2) * ROWB) : (bf16_t*)(dob + DO_XB);
#pragma unroll
            for (int ai = 0; ai < 2; ++ai)
#pragma unroll
                for (int m = 0; m < 4; ++m) {
                    const int row = u.pm * 256 + ai * 128 + wr * 64 + m * 16 + fr;
#pragma unroll
                    for (int bj = 0; bj < 2; ++bj) {
                        const int c = (u.pn & 3) * 256 + bj * 128 + wc * 32 + 8 * fq;
                        float o[8] = {acc[ai][bj][m][0][0], acc[ai][bj][m][0][1], acc[ai][bj][m][0][2], acc[ai][bj][m][0][3], acc[ai][bj][m][1][0], acc[ai][bj][m][1][1], acc[ai][bj][m][1][2], acc[ai][bj][m][1][3]};
                        *(u32x4*)(base + (size_t)row * D + c) = pack8(o);
                    }
                }
        } else {
#pragma unroll
            for (int ai = 0; ai < 2; ++ai)
#pragma unroll
                for (int m = 0; m < 4; ++m) {
                    const int row = u.pm * 256 + ai * 128 + wr * 64 + m * 16 + fr;
#pragma unroll
                    for (int bj = 0; bj < 2; ++bj) {
                        const int c = (u.pn - 12) * 256 + bj * 128 + wc * 32 + 8 * fq;
                        if (c >= 384) continue;
                        float o[8];
#pragma unroll
                        for (int n = 0; n < 2; ++n)
#pragma unroll
                            for (int j = 0; j < 4; ++j) {
                                const float a = acc[ai][bj][m][n][j]; float val;
                                if (c < 64) val = 1.f - 2.f * frcp(1.f + __expf(2.f * a));
                                else if (c < 128) val = a;
                                else if (c < 288) val = fsigmoid(a);
                                else val = 0.f;
                                o[n * 4 + j] = val;
                            }
                        *(u32x4*)((bf16_t*)(dob + DO_L1) + (size_t)row * 384 + c) = pack8(o);
                    }
                }
        }
    }
};
struct EpiL2 {
    unsigned char* ws; const float* w0; const float* a0;
    __device__ __forceinline__ void operator()(const f32x4 (&acc)[2][2][4][2], const Unit& u, int wr, int wc, int fr, int fq) const {
        const int kind = u.pn >> 2;
        bf16_t* base = (bf16_t*)(ws + (kind == 2 ? L_G : B_LW + (size_t)kind * ROWB));
        const float* bsrc = kind == 0 ? w0 : a0;
        const float bmul = kind == 2 ? 0.f : 1.f;
        f32x4 bvv[2][2];
#pragma unroll
        for (int bj = 0; bj < 2; ++bj)
#pragma unroll
            for (int n = 0; n < 2; ++n) bvv[bj][n] = *(const f32x4*)(bsrc + (u.pn & 3) * 256 + bj * 128 + wc * 32 + 8 * fq + 4 * n) * bmul;
#pragma unroll
        for (int ai = 0; ai < 2; ++ai)
#pragma unroll
            for (int m = 0; m < 4; ++m) {
                const int row = u.pm * 256 + ai * 128 + wr * 64 + m * 16 + fr;
#pragma unroll
                for (int bj = 0; bj < 2; ++bj) {
                    const int c = (u.pn & 3) * 256 + bj * 128 + wc * 32 + 8 * fq;
                    float o[8];
#pragma unroll
                    for (int n = 0; n < 2; ++n) {
                        const f32x4 bv = bvv[bj][n];
#pragma unroll
                        for (int j = 0; j < 4; ++j) {
                            const float z = acc[ai][bj][m][n][j] + bv[j];
                            const float sg = fsigmoid(z);
                            o[n * 4 + j] = kind == 0 ? -0.60653065971f * sg : (kind == 1 ? sg : z);
                        }
                    }
                    *(u32x4*)(base + (size_t)row * D + c) = pack8(o);
                }
            }
    }
};
struct EpiCI {
    const float* ss; bf16_t* U; bf16_t* GB; float* out;
    __device__ __forceinline__ void operator()(const f32x4 (&acc)[2][2][4][2], const Unit& u, int wr, int wc, int fr, int fq) const {
        float rsv[8]; rows_rs8(ss, u.pm * 256 + wr * 64 + fr, fq, rsv);
#pragma unroll
        for (int ai = 0; ai < 2; ++ai)
#pragma unroll
            for (int m = 0; m < 4; ++m) {
                const int row = u.pm * 256 + ai * 128 + wr * 64 + m * 16 + fr;
                const float rs = rsv[ai * 4 + m];
                if (u.pn < 8) {
                    const int c = u.pn * 128 + wc * 32 + 8 * fq;
                    float o[8];
#pragma unroll
                    for (int n = 0; n < 2; ++n)
#pragma unroll
                        for (int j = 0; j < 4; ++j) o[n * 4 + j] = (acc[ai][0][m][n][j] * rs) * (acc[ai][1][m][n][j] * rs);
                    *(u32x4*)(U + (size_t)row * D + c) = pack8(o);
                    if (row < M) {
                        int t, T, seq; row_info(row, t, T, seq);
                        if (t >= T - 2) {
                            float* op = (seq < 8) ? out + O_CVP + ((size_t)seq * 2 + (t - (T - 2))) * D + c : out + O_CVS + ((size_t)(seq - 8) * 2 + (t - (T - 2))) * D + c;
                            *(f32x4*)op = (f32x4){o[0], o[1], o[2], o[3]}; *(f32x4*)(op + 4) = (f32x4){o[4], o[5], o[6], o[7]};
                        }
                    }
                } else {
#pragma unroll
                    for (int bj = 0; bj < 2; ++bj) {
                        const int c = (u.pn - 8) * 256 + bj * 128 + wc * 32 + 8 * fq;
                        float o[8];
#pragma unroll
                        for (int n = 0; n < 2; ++n)
#pragma unroll
                            for (int j = 0; j < 4; ++j) o[n * 4 + j] = acc[ai][bj][m][n][j] * rs;
                        *(u32x4*)(GB + (size_t)row * D + c) = pack8(o);
                    }
                }
            }
    }
};

struct TSrc { const float* p; int ld; int vk; int vc; const float* scale; int smode; };
__device__ __forceinline__ void tblock(LAS float* tile, const TSrc s, bf16_t* dst  , int kdst, const int tid) {
    const int kr = tid >> 4, c4 = (tid & 15) * 4;
    __syncthreads();
#pragma unroll
    for (int hf = 0; hf < 2; ++hf) {
        const int k = kr + 32 * hf;
        f32x4 v = (f32x4){0.f, 0.f, 0.f, 0.f};
        if (k < s.vk && c4 < s.vc) {
            v = *(const f32x4*)(s.p + (size_t)k * s.ld + c4);
            if (s.smode) { float sc = s.scale[k]; if (s.smode == 2) sc = 1.f - sc; v *= sc; }
        }
        tile[k * 65 + c4 + 0] = v[0]; tile[k * 65 + c4 + 1] = v[1]; tile[k * 65 + c4 + 2] = v[2]; tile[k * 65 + c4 + 3] = v[3];
    }
    __syncthreads();
    const int n = tid >> 3, k8 = (tid & 7) * 8;
    float o[8];
#pragma unroll
    for (int j = 0; j < 8; ++j) o[j] = tile[(k8 + j) * 65 + n];
    *(u32x4*)(dst + (size_t)n * kdst + k8) = pack8(o);
}
enum { T_GU = 0, T_DN, T_RKV, T_L2, T_PLAIN, T_WIN };
__device__ __forceinline__ void convert(LAS float* tile, const Ctx& cx, int type, int f, bf16_t* dst, int wg, int nwg) {
    int Nd, Kd;
    switch (type) { case T_GU: Nd = 5632; Kd = 1024; break; case T_DN: Nd = 1024; Kd = 2816; break; case T_RKV: Nd = 3584; Kd = 2048; break;
                    case T_L2: Nd = 3072; Kd = 384; break; case T_WIN: Nd = 3072; Kd = 1024; break; default: Nd = 1024; Kd = 1024; break; }
    const int nkb = Kd / 64, nblk = (Nd / 64) * nkb;
    for (int blk = wg; blk < nblk; blk += nwg) {
        const int nb = blk / nkb, kb = blk - nb * nkb, n0 = nb * 64, kd0 = kb * 64;
        TSrc s; s.p = nullptr; s.ld = 0; s.vk = 0; s.vc = 0; s.scale = nullptr; s.smode = 0;
        if (type == T_GU) {
            const int pn = n0 >> 8, bj = (n0 >> 7) & 1, i0 = n0 & 127, c0 = bj * FF + 128 * pn + i0;
            s.p = cx.p->in[7] + (size_t)f * D * 2 * FF + (size_t)kd0 * (2 * FF) + c0; s.ld = 2 * FF; s.vk = 64; s.vc = 64; s.scale = cx.p->in[6] + f * D + kd0; s.smode = 1;
        } else if (type == T_DN) {
            s.p = cx.p->in[8] + (size_t)f * FF * D + (size_t)kd0 * D + n0; s.ld = D; s.vk = 64; s.vc = 64;
        } else if (type == T_RKV) {
            const int hf = kd0 >= 1024, ks = kd0 & 1023; s.smode = hf ? 1 : 2; s.vk = 64;
            if (n0 < 3072) { const int pj = n0 >> 10, c0 = n0 & 1023, mi = pj == 0 ? 0 : (pj == 1 ? 2 : 3);
                s.p = cx.p->in[12] + (size_t)pj * D * D + (size_t)ks * D + c0; s.ld = D; s.vc = 64; s.scale = cx.p->in[11] + mi * D + ks; }
            else { const int j0 = n0 - 3072;
                if (j0 < 64) { s.p = cx.p->in[14] + (size_t)ks * 64 + j0; s.ld = 64; s.vc = 64; s.scale = cx.p->in[11] + 1 * D + ks; }
                else if (j0 < 128) { s.p = cx.p->in[17] + (size_t)ks * 64 + (j0 - 64); s.ld = 64; s.vc = 64; s.scale = cx.p->in[11] + 4 * D + ks; }
                else if (j0 < 288) { const int c0 = j0 - 128; s.p = cx.p->in[19] + (size_t)ks * 160 + c0; s.ld = 160; s.vc = (160 - c0) < 64 ? (160 - c0) : 64; s.scale = cx.p->in[11] + 5 * D + ks; }
                else { s.vk = 0; s.vc = 0; s.smode = 0; s.p = cx.p->in[14]; } }
        } else if (type == T_L2) {
            s.p = cx.p->in[15];
            if (n0 < 1024) { if (kd0 == 0) { s.p = cx.p->in[15] + n0; s.ld = D; s.vk = 64; s.vc = 64; } }
            else if (n0 < 2048) { if (kd0 == 64) { s.p = cx.p->in[18] + (n0 - 1024); s.ld = D; s.vk = 64; s.vc = 64; } }
            else { if (kd0 >= 128 && kd0 < 288) { const int k0 = kd0 - 128; s.p = cx.p->in[20] + (size_t)k0 * D + (n0 - 2048); s.ld = D; s.vk = (160 - k0) < 64 ? (160 - k0) : 64; s.vc = 64; } }
        } else if (type == T_WIN) {
            int c0;
            if (n0 < 2048) { const int pn = n0 >> 8, bj = (n0 >> 7) & 1, i0 = n0 & 127; c0 = (bj == 0 ? 1024 : 2048) + 128 * pn + i0; } else c0 = n0 - 2048;
            s.p = cx.p->in[27] + (size_t)kd0 * 3072 + c0; s.ld = 3072; s.vk = 64; s.vc = 64; s.scale = cx.p->in[9] + D + kd0; s.smode = 1;
        } else {
            s.p = cx.p->in[f] + (size_t)kd0 * D + n0; s.ld = D; s.vk = 64; s.vc = 64;
        }
        tblock(tile, s, dst + (size_t)n0 * Kd + kd0, Kd, cx.tid);
    }
}

__device__ __forceinline__ void ld8f(const float* p, float* o) { const f32x4 a = *(const f32x4*)p, b = *(const f32x4*)(p + 4); o[0] = a[0]; o[1] = a[1]; o[2] = a[2]; o[3] = a[3]; o[4] = b[0]; o[5] = b[1]; o[6] = b[2]; o[7] = b[3]; }
__device__ __forceinline__ void ld8b(const bf16_t* p, float* o) { unpack8(*(const u32x4*)p, o); }
__device__ __forceinline__ void phase_x0(const Ctx& cx, bf16_t* XB, float* ss0) {
    const int wave = cx.tid >> 6, lane = cx.tid & 63;
    for (int m = cx.bid * 8 + wave; m < MPAD; m += cx.G * 8) {
        const float* src = nullptr;
        if (m < MP) { const int b = m / PT, t = m - b * PT; src = t < NMETA ? cx.p->in[5] + (size_t)t * D : cx.p->in[0] + ((size_t)b * PTX + (t - NMETA)) * D; }
        else if (m < M) src = cx.p->in[1] + (size_t)(m - MP) * D;
        float s = 0.f;
#pragma unroll
        for (int i = 0; i < 4; ++i) {
            const int c = lane * 4 + i * 256;
            f32x4 v = src ? *(const f32x4*)(src + c) : (f32x4){0.f, 0.f, 0.f, 0.f};
            u32x2 pk; pk[0] = cvt_pk_bf16(v[0], v[1]); pk[1] = cvt_pk_bf16(v[2], v[3]);
            *(u32x2*)(XB + (size_t)m * D + c) = pk;
            s += v[0] * v[0] + v[1] * v[1] + v[2] * v[2] + v[3] * v[3];
        }
        s = wave_sum(s);
        if (lane < 16) ss0[(size_t)m * 16 + lane] = lane == 0 ? s : 0.f;
    }
}
__device__ __forceinline__ void phase_mix(const Ctx& cx, const bf16_t* XB, const float* ss, bf16_t* HH) {
    const int c = (cx.tid & 127) * 8, sub = cx.tid >> 7;
    float g[8];
    { const f32x4 g0 = *(const f32x4*)(cx.p->in[9] + c), g1 = *(const f32x4*)(cx.p->in[9] + c + 4); g[0] = g0[0]; g[1] = g0[1]; g[2] = g0[2]; g[3] = g0[3]; g[4] = g1[0]; g[5] = g1[1]; g[6] = g1[2]; g[7] = g1[3]; }
    for (int m = cx.bid * 4 + sub; m < MPAD; m += cx.G * 4) {
        float hn[8], hp[8];
        if (m < M) {
            int t, T, seq; row_info(m, t, T, seq);
            const float rs = row_rs(ss, m);
            float xc[8]; ld8b(XB + (size_t)m * D + c, xc);
#pragma unroll
            for (int j = 0; j < 8; ++j) hn[j] = xc[j] * rs * g[j];
            if (t > 0) {
                const float rp = row_rs(ss, m - 1);
                float xp[8]; ld8b(XB + (size_t)(m - 1) * D + c, xp);
#pragma unroll
                for (int j = 0; j < 8; ++j) hp[j] = xp[j] * rp * g[j];
            } else if (seq >= 8) {
                const float* sp = cx.p->in[3] + (size_t)(seq - 8) * D + c;
                const f32x4 y0 = *(const f32x4*)sp, y1 = *(const f32x4*)(sp + 4);
#pragma unroll
                for (int j = 0; j < 4; ++j) { hp[j] = y0[j]; hp[4 + j] = y1[j]; }
            } else {
#pragma unroll
                for (int j = 0; j < 8; ++j) hp[j] = 0.f;
            }
            if (t == T - 1) {
                float* op = (seq < 8) ? cx.p->out + O_SHP + (size_t)seq * D + c : cx.p->out + O_SHS + (size_t)(seq - 8) * D + c;
                *(f32x4*)op = (f32x4){hn[0], hn[1], hn[2], hn[3]}; *(f32x4*)(op + 4) = (f32x4){hn[4], hn[5], hn[6], hn[7]};
            }
        } else {
#pragma unroll
            for (int j = 0; j < 8; ++j) { hn[j] = 0.f; hp[j] = 0.f; }
        }
        *(u32x4*)(HH + (size_t)m * 2048 + c) = pack8(hn);
        *(u32x4*)(HH + (size_t)m * 2048 + 1024 + c) = pack8(hp);
    }
}
__device__ __forceinline__ void phase_post(const Ctx& cx, const bf16_t* YP, const bf16_t* YS, const float* CB, const bf16_t* V, const bf16_t* G, bf16_t* O) {
    const int c = (cx.tid & 127) * 8, sub = cx.tid >> 7;
    float lnw[8], lnb[8];
    ld8f(cx.p->in[24] + c, lnw); ld8f(cx.p->in[25] + c, lnb);
    for (int m = cx.bid * 4 + sub; m < MPAD; m += cx.G * 4) {
        float o[8];
        if (m < M) {
            float y[8], v[8], g[8];
            ld8b((m < MP ? YP + (size_t)m * D : YS + (size_t)(m - MP) * D) + c, y);
            ld8b(V + (size_t)m * D + c, v); ld8b(G + (size_t)m * D + c, g);
            const float cb = CB[(size_t)m * NH + (c >> 6)];
            float s = 0.f;
#pragma unroll
            for (int j = 0; j < 8; ++j) s += y[j];
            s = allreduce8(s);
            const float mean = s * (1.f / 64.f);
            float vs = 0.f;
#pragma unroll
            for (int j = 0; j < 8; ++j) { y[j] -= mean; vs += y[j] * y[j]; }
            vs = allreduce8(vs);
            const float rstd = rsqrtf(vs * (1.f / 64.f) + 64e-5f);
#pragma unroll
            for (int j = 0; j < 8; ++j) o[j] = (y[j] * rstd * lnw[j] + lnb[j] + cb * v[j]) * g[j];
        } else {
#pragma unroll
            for (int j = 0; j < 8; ++j) o[j] = 0.f;
        }
        *(u32x4*)(O + (size_t)m * D + c) = pack8(o);
    }
}
__device__ __forceinline__ void phase_conv(const Ctx& cx, const bf16_t* U, const bf16_t* GB, bf16_t* CV) {
    const int c = (cx.tid & 127) * 8, sub = cx.tid >> 7;
    float w0[8], w1[8], w2[8];
    ld8f(cx.p->in[28] + c, w0); ld8f(cx.p->in[28] + D + c, w1); ld8f(cx.p->in[28] + 2 * D + c, w2);
    for (int m = cx.bid * 4 + sub; m < MPAD; m += cx.G * 4) {
        float o[8];
        if (m < M) {
            int t, T, seq; row_info(m, t, T, seq);
            float u2[8], u1[8], u0[8], gb[8];
            ld8b(U + (size_t)m * D + c, u2); ld8b(GB + (size_t)m * D + c, gb);
            if (t >= 1) ld8b(U + (size_t)(m - 1) * D + c, u1);
            else if (seq >= 8) ld8f(cx.p->in[4] + ((size_t)(seq - 8) * 2 + 1) * D + c, u1);
            else {
#pragma unroll
                for (int j = 0; j < 8; ++j) u1[j] = 0.f; }
            if (t >= 2) ld8b(U + (size_t)(m - 2) * D + c, u0);
            else if (seq >= 8) ld8f(cx.p->in[4] + ((size_t)(seq - 8) * 2 + t) * D + c, u0);
            else {
#pragma unroll
                for (int j = 0; j < 8; ++j) u0[j] = 0.f; }
#pragma unroll
            for (int j = 0; j < 8; ++j) o[j] = gb[j] * (w0[j] * u0[j] + w1[j] * u1[j] + w2[j] * u2[j]);
        } else {
#pragma unroll
            for (int j = 0; j < 8; ++j) o[j] = 0.f;
        }
        *(u32x4*)(CV + (size_t)m * D + c) = pack8(o);
    }
}
__device__ __forceinline__ void phase_final(const Ctx& cx, const bf16_t* XB, const float* ss) {
    const int wave = cx.tid >> 6, lane = cx.tid & 63;
    for (int m = cx.bid * 8 + wave; m < M; m += cx.G * 8) {
        float* dst;
        if (m < MP) { const int b = m / PT, t = m - b * PT; if (t < NMETA) continue; dst = cx.p->out + O_YP + ((size_t)b * PTX + (t - NMETA)) * D; }
        else dst = cx.p->out + O_YS + (size_t)(m - MP) * D;
        const float rs = row_rs(ss, m);
#pragma unroll
        for (int i = 0; i < 4; ++i) {
            const int c = lane * 4 + i * 256;
            const u32x2 xb = *(const u32x2*)(XB + (size_t)m * D + c); const f32x4 g = *(const f32x4*)(cx.p->in[10] + c);
            const f32x4 v = {bf_lo(xb[0]), bf_hi(xb[0]), bf_lo(xb[1]), bf_hi(xb[1])};
            *(f32x4*)(dst + c) = v * rs * g;
        }
    }
}

struct ScanBufs { const bf16_t* R; const bf16_t* K; const bf16_t* V; const bf16_t* LW; const bf16_t* A; bf16_t* YP; bf16_t* YS; float* CB; };
__device__ __forceinline__ void scan_item_info(int item, int& m0, int& T, int& h, int& half, int& sb) {
    if (item < 256) { const int b = item >> 5; h = (item >> 1) & 15; half = item & 1; m0 = b * PT; T = PT; sb = -1 - b; }
    else { const int q = item - 256; sb = q >> 5; h = (q >> 1) & 15; half = q & 1; m0 = MP + sb * STN; T = STN; }
}
__device__ __forceinline__ void phase_scan(LAS float* lds, const Ctx& cx, const ScanBufs B) {
    const int tid = cx.tid, G = cx.G;
    const int nitems = 256 + 4096;
    const bool consumer = tid < 256;
    const int rp = (tid >> 4) & 15, seg = tid & 15;
    const int ptid = tid - 256, tl = ptid >> 3, cs = ptid & 7;
    int ci = cx.bid, ct0 = 0, k = 0;
    f32x2 sA0 = {0.f, 0.f}, sA1 = {0.f, 0.f}, sB0 = {0.f, 0.f}, sB1 = {0.f, 0.f};
    f32x4 pf[4][2]; bool pf_valid = false;
#pragma unroll
    for (int q = 0; q < 4; ++q) { pf[q][0] = (f32x4){0.f, 0.f, 0.f, 0.f}; pf[q][1] = pf[q][0]; }

    auto prep = [&](int pi, int pt0, int buf) __attribute__((always_inline)) {
        LAS float* ob = lds + buf * 11264;
        int item, t;
        if (pi < 256) { item = pi; t = pt0 + tl; } else { item = pi + (tl >> 3) * G; t = tl & 7; }
        if (item < nitems) {
            int pm0, pT, ph, phalf, psb; scan_item_info(item, pm0, pT, ph, phalf, psb);
            if (t < pT) {
                const size_t o = (size_t)(pm0 + t) * D + ph * 64 + cs * 8;
                float kf[8], rf[8], af[8], wf[8];
                ld8b(B.K + o, kf); ld8b(B.R + o, rf); ld8b(B.A + o, af); ld8b(B.LW + o, wf);
                const u32x2 vv = *(const u32x2*)(B.V + (size_t)(pm0 + t) * D + ph * 64 + phalf * 32 + cs * 4);
                float kkc[8], kac[8];
                ld8f(cx.p->in[21] + ph * 64 + cs * 8, kkc); ld8f(cx.p->in[22] + ph * 64 + cs * 8, kac);
                float kk[8]; float n2 = 0.f;
#pragma unroll
                for (int j = 0; j < 8; ++j) { kk[j] = kf[j] * kkc[j]; n2 += kk[j] * kk[j]; }
                n2 = allreduce8(n2);
                const float inv = 1.f / fmaxf(sqrtf(n2), 1e-12f);
                float vd[8], vb[8], vk[8];
#pragma unroll
                for (int j = 0; j < 8; ++j) { kk[j] *= inv; vb[j] = kk[j] * af[j]; vk[j] = kf[j] * (1.f + (af[j] - 1.f) * kac[j]); vd[j] = __expf(wf[j]); }
                if (phalf == 0) {
                    float rkc[8]; ld8f(cx.p->in[23] + ph * 64 + cs * 8, rkc);
                    float cbv = 0.f;
#pragma unroll
                    for (int j = 0; j < 8; ++j) cbv += rf[j] * vk[j] * rkc[j];
                    cbv = allreduce8(cbv);
                    if (cs == 0) B.CB[(size_t)(pm0 + t) * NH + ph] = cbv;
                }
                LAS float* q = ob + tl * 64 + cs * 8;
                *(LAS f32x4*)(q) = (f32x4){vd[0], vd[1], vd[2], vd[3]}; *(LAS f32x4*)(q + 4) = (f32x4){vd[4], vd[5], vd[6], vd[7]};
                *(LAS f32x4*)(q + 2048) = (f32x4){kk[0], kk[1], kk[2], kk[3]}; *(LAS f32x4*)(q + 2048 + 4) = (f32x4){kk[4], kk[5], kk[6], kk[7]};
                *(LAS f32x4*)(q + 4096) = (f32x4){vb[0], vb[1], vb[2], vb[3]}; *(LAS f32x4*)(q + 4096 + 4) = (f32x4){vb[4], vb[5], vb[6], vb[7]};
                *(LAS f32x4*)(q + 6144) = (f32x4){vk[0], vk[1], vk[2], vk[3]}; *(LAS f32x4*)(q + 6144 + 4) = (f32x4){vk[4], vk[5], vk[6], vk[7]};
                *(LAS f32x4*)(q + 8192) = (f32x4){rf[0], rf[1], rf[2], rf[3]}; *(LAS f32x4*)(q + 8192 + 4) = (f32x4){rf[4], rf[5], rf[6], rf[7]};
                *(LAS f32x4*)(ob + 10240 + tl * 32 + cs * 4) = (f32x4){bf_lo(vv[0]), bf_hi(vv[0]), bf_lo(vv[1]), bf_hi(vv[1])};
            }
        }
    };
    auto yout = [&](int pi, int pt0, int ybuf) __attribute__((always_inline)) {
        int item, t;
        if (pi < 256) { item = pi; t = pt0 + tl; } else { item = pi + (tl >> 3) * G; t = tl & 7; }
        if (item < nitems) {
            int pm0, pT, ph, phalf, psb; scan_item_info(item, pm0, pT, ph, phalf, psb);
            if (t < pT) {
                const f32x4 y = *(const LAS f32x4*)(lds + 22528 + ybuf * 1024 + tl * 32 + cs * 4);
                u32x2 pk; pk[0] = cvt_pk_bf16(y[0], y[1]); pk[1] = cvt_pk_bf16(y[2], y[3]);
                bf16_t* yb = (pm0 < MP) ? B.YP + (size_t)pm0 * D : B.YS + (size_t)(pm0 - MP) * D;
                *(u32x2*)(yb + (size_t)t * D + ph * 64 + phalf * 32 + cs * 4) = pk;
            }
        }
    };
    auto run_steps = [&](int slot0, int ns) __attribute__((always_inline)) {
        const LAS float* ob = lds + (k & 1) * 11264 + seg * 4 + slot0 * 64;
        const LAS float* vbp = lds + (k & 1) * 11264 + 10240 + 2 * rp + slot0 * 32;
        LAS float* yb = lds + 22528 + (k & 1) * 1024 + 2 * rp + slot0 * 32;
#define SCAN_LOAD(P, tt) do { const int o_ = (tt) * 64; P##d = *(const LAS f32x4*)(ob + o_); P##kk = *(const LAS f32x4*)(ob + 2048 + o_); P##b = *(const LAS f32x4*)(ob + 4096 + o_); \
            P##k = *(const LAS f32x4*)(ob + 6144 + o_); P##r = *(const LAS f32x4*)(ob + 8192 + o_); P##v = *(const LAS f32x2*)(vbp + (tt) * 32); } while (0)
#define SCAN_STEP(P, q0, q1) do { \
            const f32x2 dl = {P##d[0], P##d[1]}, dh = {P##d[2], P##d[3]}, kkl = {P##kk[0], P##kk[1]}, kkh = {P##kk[2], P##kk[3]}, bl = {P##b[0], P##b[1]}, bh = {P##b[2], P##b[3]}; \
            const f32x2 kl = {P##k[0], P##k[1]}, kh = {P##k[2], P##k[3]}, rl = {P##r[0], P##r[1]}, rh = {P##r[2], P##r[3]}; \
            f32x2 pa = sA0 * kkl; pa = sA1 * kkh + pa; f32x2 pb = sB0 * kkl; pb = sB1 * kkh + pb; \
            float p0 = pa[0] + pa[1], p1 = pb[0] + pb[1]; \
            const f32x2 sdA0 = sA0 * dl + kl * P##v[0], sdA1 = sA1 * dh + kh * P##v[0], sdB0 = sB0 * dl + kl * P##v[1], sdB1 = sB1 * dh + kh * P##v[1]; \
            p0 += dpp_f<0xB1>(p0); p1 += dpp_f<0xB1>(p1); p0 += dpp_f<0x4E>(p0); p1 += dpp_f<0x4E>(p1); p0 += dpp_f<0x124>(p0); p1 += dpp_f<0x124>(p1); p0 += dpp_f<0x128>(p0); p1 += dpp_f<0x128>(p1); \
            sA0 = sdA0 - bl * p0; sA1 = sdA1 - bh * p0; sB0 = sdB0 - bl * p1; sB1 = sdB1 - bh * p1; \
            f32x2 qa = sA0 * rl; qa = sA1 * rh + qa; f32x2 qb = sB0 * rl; qb = sB1 * rh + qb; \
            q0 = qa[0] + qa[1]; q1 = qb[0] + qb[1]; } while (0)
        f32x4 Xd, Xkk, Xb, Xk, Xr, Yd, Ykk, Yb, Yk, Yr, Zd, Zkk, Zb, Zk, Zr, Wd, Wkk, Wb, Wk, Wr; f32x2 Xv, Yv, Zv, Wv;
        const bool l0 = (seg & 1) != 0, l1 = (seg & 2) != 0;
#define SCAN_YRED(a0, a1, a2, a3, tt, ok) do { \
            const float s0 = l0 ? a0 : a1, s1 = l0 ? a2 : a3, k0 = l0 ? a1 : a0, k1 = l0 ? a3 : a2; \
            const float w0 = k0 + dpp_f<0xB1>(s0), w1 = k1 + dpp_f<0xB1>(s1); \
            const float s2 = l1 ? w0 : w1, k2 = l1 ? w1 : w0; \
            float z = k2 + dpp_f<0x4E>(s2); \
            z += dpp_f<0x124>(z); z += dpp_f<0x128>(z); \
            if (seg < 4 && (ok)) yb[((tt) + (seg >> 1)) * 32 + (seg & 1)] = z; } while (0)
        __builtin_amdgcn_s_setprio(3);
        SCAN_LOAD(X, 0); SCAN_LOAD(Y, 1);
        float pv0 = 0.f, pv1 = 0.f, pv2 = 0.f, pv3 = 0.f;
        for (int t = 0; t < ns; t += 4) {
            SCAN_LOAD(Z, t + 2); SCAN_LOAD(W, t + 3);
            __builtin_amdgcn_sched_barrier(0);
            { float v0, v1, v2, v3; SCAN_STEP(X, v0, v1); SCAN_YRED(pv0, pv1, pv2, pv3, t - 2, t > 0); SCAN_STEP(Y, v2, v3); pv0 = v0; pv1 = v1; pv2 = v2; pv3 = v3; }
            __builtin_amdgcn_sched_barrier(0);
            { const int tn = (t + 4 < ns) ? t + 4 : t; SCAN_LOAD(X, tn); SCAN_LOAD(Y, tn + 1); }
            __builtin_amdgcn_sched_barrier(0);
            { float v0, v1, v2, v3; SCAN_STEP(Z, v0, v1); SCAN_YRED(pv0, pv1, pv2, pv3, t, true); SCAN_STEP(W, v2, v3); pv0 = v0; pv1 = v1; pv2 = v2; pv3 = v3; }
            __builtin_amdgcn_sched_barrier(0);
        }
        SCAN_YRED(pv0, pv1, pv2, pv3, ns - 2, true);
        __builtin_amdgcn_s_setprio(0);
#undef SCAN_YRED
#undef SCAN_LOAD
#undef SCAN_STEP
    };
    auto state_ptr = [&](int item, bool out) __attribute__((always_inline)) -> float* {
        int pm0, pT, ph, phalf, psb; scan_item_info(item, pm0, pT, ph, phalf, psb);
        const size_t o = (((size_t)psb * NH + ph) * 64 + phalf * 32 + 2 * rp) * 64 + seg * 4;
        return out ? cx.p->out + O_WKVS + o : const_cast<float*>(cx.p->in[2]) + o;
    };

    if (ci < nitems && !consumer) prep(ci, 0, 0);
    __syncthreads();
    int pci = 0, pct0 = 0; bool have_prev = false;
    while (ci < nitems) {
        int ni, nt0 = 0;
        if (ci < 256) { ni = ci; nt0 = ct0 + 32; if (nt0 >= PT) { ni = ci + G; nt0 = 0; } } else ni = ci + 4 * G;
        if (consumer) {
            const bool next_is_group = (ni >= 256) && (ni < nitems) && (ni != ci);
            if (ci < 256) {
                if (ct0 == 0) { sA0 = (f32x2){0.f, 0.f}; sA1 = sA0; sB0 = sA0; sB1 = sA0; }
                if (next_is_group) {
#pragma unroll
                    for (int q = 0; q < 4; ++q) if (ni + q * G < nitems) { const float* sp = state_ptr(ni + q * G, false); pf[q][0] = *(const f32x4*)sp; pf[q][1] = *(const f32x4*)(sp + 64); }
                    pf_valid = true;
                }
                const int ns = (PT - ct0) < 32 ? (PT - ct0) : 32;
                run_steps(0, ns);
                if (ct0 + 32 >= PT) {
                    int pm0, pT, ph, phalf, psb; scan_item_info(ci, pm0, pT, ph, phalf, psb);
                    float* sp = cx.p->out + O_WKVP + (((size_t)(-1 - psb) * NH + ph) * 64 + phalf * 32 + 2 * rp) * 64 + seg * 4;
                    *(f32x4*)sp = (f32x4){sA0[0], sA0[1], sA1[0], sA1[1]}; *(f32x4*)(sp + 64) = (f32x4){sB0[0], sB0[1], sB1[0], sB1[1]};
                }
            } else {
                f32x4 st[4][2];
#pragma unroll
                for (int q = 0; q < 4; ++q) {
                    if (pf_valid) { st[q][0] = pf[q][0]; st[q][1] = pf[q][1]; }
                    else if (ci + q * G < nitems) { const float* sp = state_ptr(ci + q * G, false); st[q][0] = *(const f32x4*)sp; st[q][1] = *(const f32x4*)(sp + 64); }
                    else { st[q][0] = (f32x4){0.f, 0.f, 0.f, 0.f}; st[q][1] = st[q][0]; }
                }
                pf_valid = false;
                if (next_is_group) {
#pragma unroll
                    for (int q = 0; q < 4; ++q) if (ni + q * G < nitems) { const float* sp = state_ptr(ni + q * G, false); pf[q][0] = *(const f32x4*)sp; pf[q][1] = *(const f32x4*)(sp + 64); }
                    pf_valid = true;
                }
#pragma unroll
                for (int q = 0; q < 4; ++q) {
                    if (ci + q * G < nitems) {
                        sA0 = (f32x2){st[q][0][0], st[q][0][1]}; sA1 = (f32x2){st[q][0][2], st[q][0][3]}; sB0 = (f32x2){st[q][1][0], st[q][1][1]}; sB1 = (f32x2){st[q][1][2], st[q][1][3]};
                        asm volatile("" :: "v"(sA0[0]), "v"(sA1[0]), "v"(sB0[0]), "v"(sB1[0]));
                        run_steps(8 * q, 8);
                        float* sp = state_ptr(ci + q * G, true);
                        *(f32x4*)sp = (f32x4){sA0[0], sA0[1], sA1[0], sA1[1]}; *(f32x4*)(sp + 64) = (f32x4){sB0[0], sB0[1], sB1[0], sB1[1]};
                    }
                }
            }
        } else {
            if (ni < nitems) prep(ni, nt0, (k + 1) & 1);
            if (have_prev) yout(pci, pct0, (k - 1) & 1);
        }
        __syncthreads();
        pci = ci; pct0 = ct0; have_prev = true;
        ci = ni; ct0 = nt0; ++k;
    }
    if (have_prev && !consumer) yout(pci, pct0, (k - 1) & 1);
    __syncthreads();
}

#define XB_TMO      128
#define XB_XCNT(j)  (256  + 64 * (j))
#define XB_XSUB(j)  (1280 + 64 * (j))
#define XB_XGEN(j)  (2304 + 64 * (j))
#define XB_TOP      3328
#define XB_TOPGEN   3392
#define XCD_BAR_WORDS 3456
#define XB_SPIN_CAP (1u << 18)
__device__ __forceinline__ unsigned xb_ld(unsigned* p)              { return __hip_atomic_load(p, __ATOMIC_RELAXED, __HIP_MEMORY_SCOPE_AGENT); }
__device__ __forceinline__ unsigned xb_add(unsigned* p, unsigned v) { return __hip_atomic_fetch_add(p, v, __ATOMIC_RELAXED, __HIP_MEMORY_SCOPE_AGENT); }
__device__ __forceinline__ unsigned xb_xcc_id() { return (unsigned)__builtin_amdgcn_s_getreg((3 << 11) | 20) & 0xFu; }
#define XB_SPIN(cond, bar) do { unsigned _sp = 0; while (cond) { __builtin_amdgcn_s_sleep(1); \
    if ((++_sp & 255u) == 0u) { if (xb_ld(&(bar)[XB_TMO])) break; if (_sp > XB_SPIN_CAP) { atomicAdd(&(bar)[XB_TMO], 1u); break; } } } } while (0)
__device__ __forceinline__ void xcd_barrier_complete(unsigned* bar, unsigned x, unsigned G, unsigned& nloc, unsigned& nx) {
    unsigned sum, cnt, mine, sp = 0u;
    for (;;) {
        sum = 0u; cnt = 0u; mine = 0u;
#pragma unroll
        for (unsigned j = 0; j < 16; ++j) { const unsigned c = xb_ld(&bar[XB_XCNT(j)]); sum += c; cnt += (c > 0u) ? 1u : 0u; mine = (j == x) ? c : mine; }
        if (sum == G) break;
        __builtin_amdgcn_s_sleep(1);
        if ((++sp & 255u) == 0u) { if (xb_ld(&bar[XB_TMO])) break; if (sp > XB_SPIN_CAP) { atomicAdd(&bar[XB_TMO], 1u); break; } }
    }
    nloc = mine > 0u ? mine : 1u; nx = cnt > 0u ? cnt : 1u;
}
__device__ __forceinline__ void xcd_barrier(unsigned* bar, volatile LAS unsigned* st, int tid, unsigned G) {
    asm volatile("s_waitcnt vmcnt(0)" ::: "memory");
    __syncthreads();
    if (tid == 0) {
        const unsigned x = xb_xcc_id();
        __builtin_amdgcn_s_waitcnt(0);
        unsigned nloc = st[0], nx = st[1];
        if (nloc == 0u) { xcd_barrier_complete(bar, x, G, nloc, nx); st[0] = nloc; st[1] = nx; }
        const unsigned old = xb_add(&bar[XB_XSUB(x)], 1u);
        const unsigned gen = old / nloc;
        if (old + 1u == (gen + 1u) * nloc) {
            __builtin_amdgcn_fence(__ATOMIC_RELEASE, "agent");
            asm volatile("s_waitcnt vmcnt(0)" ::: "memory");
            const unsigned og = xb_add(&bar[XB_TOP], 1u);
            const unsigned tg = og / nx;
            if (og + 1u == (tg + 1u) * nx) xb_add(&bar[XB_TOPGEN], 1u);
            else XB_SPIN(xb_ld(&bar[XB_TOPGEN]) == tg, bar);
            __builtin_amdgcn_fence(__ATOMIC_ACQUIRE, "agent");
            xb_add(&bar[XB_XGEN(x)], 1u);
            asm volatile("s_waitcnt vmcnt(0)" ::: "memory");
        } else {
            XB_SPIN(xb_ld(&bar[XB_XGEN(x)]) == gen, bar);
            __builtin_amdgcn_fence(__ATOMIC_ACQUIRE, "agent");
            asm volatile("s_waitcnt vmcnt(0)" ::: "memory");
        }
    }
    __syncthreads();
}

#define X_ ((float*)(ws + WS_X))
#define SS_(i) ((float*)(ws + WS_SS))
#define XB_ ((bf16_t*)(ws + WS_X))
__global__ void __launch_bounds__(NTHREADS, 2) mega(Params p) {
    extern __shared__ __attribute__((aligned(16))) unsigned char shm[];
    LAS unsigned char* lds = (LAS unsigned char*)shm;
    LAS float* ldsf = (LAS float*)shm;
    volatile LAS unsigned* bst = (volatile LAS unsigned*)(shm + 131072);
    if (threadIdx.x == 0) { bst[0] = 0u; bst[1] = 0u; (void)xb_add((unsigned*)(p.ws + WS_BAR) + XB_XCNT(xb_xcc_id()), 1u); }
    __syncthreads();
    const int wv_ = __builtin_amdgcn_readfirstlane(threadIdx.x >> 6);
    for (int ph = 0; ph < 19; ++ph) {
#ifdef REP_MASK
        for (int rep = 0; rep < 1 + ((REP_MASK >> ph) & 1); ++rep) {
#else
        { const int rep = 0;
#endif
        Ctx cx;
        { KP kp = (KP)__builtin_amdgcn_kernarg_segment_ptr(); int t_ = wv_ * 64 + (int)__builtin_amdgcn_mbcnt_hi(~0u, __builtin_amdgcn_mbcnt_lo(~0u, 0u)), b_ = blockIdx.x, g_ = gridDim.x;
          asm volatile("" : "+s"(kp), "+v"(t_), "+s"(b_), "+s"(g_));
          cx.p = kp; cx.tid = t_; cx.bid = b_; cx.G = g_; }
        unsigned char* ws = cx.p->ws;
        unsigned char* dob = (unsigned char*)cx.p->out;
        const int G = cx.G, c = cx.bid;
        int kind, f = 0;
        switch (ph) {
            case 0: kind = 0; break;
            case 1: kind = 1; f = 0; break;  case 2: kind = 2; f = 0; break;
            case 3: kind = 3; break; case 4: kind = 4; break; case 5: kind = 5; break; case 6: kind = 6; break; case 7: kind = 7; break;
            case 8: kind = 2; f = 4; break;
            case 9: kind = 1; f = 1; break;  case 10: kind = 2; f = 1; break;
            case 11: kind = 1; f = 2; break; case 12: kind = 2; f = 2; break;
            case 13: kind = 8; break; case 14: kind = 9; break;
            case 15: kind = 2; f = 5; break;
            case 16: kind = 1; f = 3; break; case 17: kind = 2; f = 3; break;
            default: kind = 10; break;
        }
        if (kind == 0) {
            phase_x0(cx, XB_, SS_(0));
            convert(ldsf, cx, T_GU, 0, (bf16_t*)(ws + WS_SLOTA), c, G);
            convert(ldsf, cx, T_DN, 0, (bf16_t*)(ws + WS_SLOTA + SZ_GU), c, G);
            convert(ldsf, cx, T_RKV, 0, (bf16_t*)(ws + WS_WRKV), c, G);
            convert(ldsf, cx, T_L2, 0, (bf16_t*)(ws + WS_WL2), c, G);
            convert(ldsf, cx, T_PLAIN, 26, (bf16_t*)(ws + WS_WO), c, G);
        } else if (kind == 1) {
            const int ssi = f == 0 ? 0 : (f == 1 ? 2 : (f == 2 ? 3 : 5));
            const unsigned char* slot = ws + ((f & 1) ? WS_SLOTB : WS_SLOTA);
            pg8::Gemm g; g.A = XB_; g.Bt = (const bf16_t*)slot; g.K = D;
            pg8::StaticOrder S; S.init(MPAD / 256, 22, G, c, g.K);
            EpiGU E; E.ss = SS_(ssi); E.act = (bf16_t*)(ws + B_ACT);
            pg8::gemm_phase(lds, g, S, E, cx.tid);
        } else if (kind == 2) {
            pg8::Gemm g; EpiRes E; E.XB = XB_;
            if (f < 4) { g.A = (const bf16_t*)(ws + B_ACT); g.Bt = (const bf16_t*)(ws + ((f & 1) ? WS_SLOTB : WS_SLOTA) + SZ_GU); g.K = FF; E.scale = 0.5f;
                         E.ssout = SS_(f == 0 ? 1 : (f == 1 ? 3 : (f == 2 ? 4 : 6))); }
            else if (f == 4) { g.A = (const bf16_t*)(ws + B_O); g.Bt = (const bf16_t*)(ws + WS_WO); g.K = D; E.scale = 1.f; E.ssout = SS_(2); }
            else { g.A = (const bf16_t*)(ws + B_CV); g.Bt = (const bf16_t*)(ws + WS_WOUT); g.K = D; E.scale = 1.f; E.ssout = SS_(5); }
            if (rep) E.scale = 0.f;
            if (f < 4 && G == 256) {
                f32x4* slab = (f32x4*)(ws + WS_BIG + SZ_ACT);
                pg8::SplitOrder S; S.init(MPAD / 256, 4, G, c, g.K);
                pg8::gemm_phase(lds, g, S, E, cx.tid, slab);
                if (rep == 0 && f == 2 && c >= 140) {
                    convert(ldsf, cx, T_GU, 3, (bf16_t*)(ws + WS_SLOTB), c - 140, G - 140);
                    convert(ldsf, cx, T_DN, 3, (bf16_t*)(ws + WS_SLOTB + SZ_GU), c - 140, G - 140);
                }
                xcd_barrier((unsigned*)(ws + WS_BAR), bst, cx.tid, (unsigned)G);
                if (c < 160) {
                    const int lt = c >> 3;
                    pg8::Unit u; S.tile(256 + lt, u);
                    int t_ = cx.tid; asm volatile("" : "+v"(t_));
                    const int wid = t_ >> 6, lane = t_ & 63, wr = wid >> 2, wc = wid & 3, fr = lane & 15, fq = lane >> 4;
                    const f32x4* sp = slab + (size_t)(lt * 7) * 32 * 512 + t_;
                    const int row0 = u.pm * 256 + wr * 64 + fr, col0 = u.pn * 256 + wc * 32 + 8 * fq;
                    {
                        const int am = c & 7;
                        const int ai = am >> 2, m = am & 3, r = row0 + ai * 128 + m * 16;
                        f32x4 a[2][2];
#pragma unroll
                        for (int bj = 0; bj < 2; ++bj)
#pragma unroll
                            for (int n = 0; n < 2; ++n) {
                                const int idx = ((ai * 2 + bj) * 4 + m) * 2 + n;
                                f32x4 t = sp[(size_t)idx * 512];
#pragma unroll
                                for (int part = 1; part < 7; ++part) t += sp[(size_t)(part * 32 + idx) * 512];
                                a[bj][n] = t;
                            }
                        float ssum = 0.f;
#pragma unroll
                        for (int bj = 0; bj < 2; ++bj) {
                            bf16_t* xp = E.XB + (size_t)r * D + col0 + bj * 128;
                            float o[8]; unpack8(*(const u32x4*)xp, o);
#pragma unroll
                            for (int jj = 0; jj < 4; ++jj) { o[jj] += a[bj][0][jj] * E.scale; o[4 + jj] += a[bj][1][jj] * E.scale; }
                            *(u32x4*)xp = pack8(o);
#pragma unroll
                            for (int jj = 0; jj < 8; ++jj) ssum += o[jj] * o[jj];
                        }
                        ssum += __shfl_xor(ssum, 16); ssum += __shfl_xor(ssum, 32);
                        if (fq == 0) E.ssout[(size_t)r * 16 + u.pn * 4 + wc] = ssum;
                    }
                }
            } else {
            pg8::StaticOrder S; S.init(MPAD / 256, 4, G, c, g.K);
            pg8::gemm_phase(lds, g, S, E, cx.tid);
            if (rep == 0) {
            const int nbusy = (MPAD / 256) * 4 - G;
            if (G > 2 * nbusy && nbusy >= 0) {
                if (c >= nbusy) {
                    const int wg = c - nbusy, nwg = G - nbusy;
                    if (f == 4) {
                        convert(ldsf, cx, T_GU, 1, (bf16_t*)(ws + WS_SLOTB), wg, nwg);
                        convert(ldsf, cx, T_DN, 1, (bf16_t*)(ws + WS_SLOTB + SZ_GU), wg, nwg);
                        convert(ldsf, cx, T_GU, 2, (bf16_t*)(ws + WS_SLOTA), wg, nwg);
                        convert(ldsf, cx, T_DN, 2, (bf16_t*)(ws + WS_SLOTA + SZ_GU), wg, nwg);
                        convert(ldsf, cx, T_WIN, 0, (bf16_t*)(ws + WS_WIN), wg, nwg);
                        convert(ldsf, cx, T_PLAIN, 29, (bf16_t*)(ws + WS_WOUT), wg, nwg);
                    } else if (f == 2) {
                        convert(ldsf, cx, T_GU, 3, (bf16_t*)(ws + WS_SLOTB), wg, nwg);
                        convert(ldsf, cx, T_DN, 3, (bf16_t*)(ws + WS_SLOTB + SZ_GU), wg, nwg);
                    }
                }
            } else {
                if (f == 4) {
                    convert(ldsf, cx, T_GU, 1, (bf16_t*)(ws + WS_SLOTB), c, G);
                    convert(ldsf, cx, T_DN, 1, (bf16_t*)(ws + WS_SLOTB + SZ_GU), c, G);
                    convert(ldsf, cx, T_GU, 2, (bf16_t*)(ws + WS_SLOTA), c, G);
                    convert(ldsf, cx, T_DN, 2, (bf16_t*)(ws + WS_SLOTA + SZ_GU), c, G);
                    convert(ldsf, cx, T_WIN, 0, (bf16_t*)(ws + WS_WIN), c, G);
                    convert(ldsf, cx, T_PLAIN, 29, (bf16_t*)(ws + WS_WOUT), c, G);
                } else if (f == 2) {
                    convert(ldsf, cx, T_GU, 3, (bf16_t*)(ws + WS_SLOTB), c, G);
                    convert(ldsf, cx, T_DN, 3, (bf16_t*)(ws + WS_SLOTB + SZ_GU), c, G);
                }
            }
            }
            }
        } else if (kind == 3) {
            phase_mix(cx, XB_, SS_(1), (bf16_t*)(ws + B_HH));
        } else if (kind == 4) {
            pg8::Gemm g; g.A = (const bf16_t*)(ws + B_HH); g.Bt = (const bf16_t*)(ws + WS_WRKV); g.K = 2048;
            pg8::StaticOrder S; S.init(MPAD / 256, 14, G, c, g.K);
            EpiRKV E; E.ws = ws; E.dob = dob;
            pg8::gemm_phase(lds, g, S, E, cx.tid);
        } else if (kind == 5) {
            pg8::Gemm g; g.A = (const bf16_t*)(dob + DO_L1); g.Bt = (const bf16_t*)(ws + WS_WL2); g.K = 384;
            pg8::L2Order S; S.init(MPAD / 256, 12, G, c, g.K);
            EpiL2 E; E.ws = ws; E.w0 = cx.p->in[13]; E.a0 = cx.p->in[16];
            pg8::gemm_phase(lds, g, S, E, cx.tid);
        } else if (kind == 6) {
            ScanBufs sbf; sbf.R = (const bf16_t*)(ws + B_R); sbf.K = (const bf16_t*)(ws + B_K); sbf.V = (const bf16_t*)(dob + DO_XB); sbf.LW = (const bf16_t*)(ws + B_LW);
            sbf.A = (const bf16_t*)(ws + B_A); sbf.YP = (bf16_t*)(dob + DO_YPR); sbf.YS = (bf16_t*)(ws + L_YS); sbf.CB = (float*)(ws + WS_X + ROWB);
            phase_scan(ldsf, cx, sbf);
        } else if (kind == 7) {
            phase_post(cx, (const bf16_t*)(dob + DO_YPR), (const bf16_t*)(ws + L_YS), (const float*)(ws + WS_X + ROWB), (const bf16_t*)(dob + DO_XB),
                       (const bf16_t*)(ws + L_G), (bf16_t*)(ws + B_O));
        } else if (kind == 8) {
            pg8::Gemm g; g.A = XB_; g.Bt = (const bf16_t*)(ws + WS_WIN); g.K = D;
            pg8::StaticOrder S; S.init(MPAD / 256, 12, G, c, g.K);
            EpiCI E; E.ss = SS_(4); E.U = (bf16_t*)(ws + B_U); E.GB = (bf16_t*)(ws + B_GB); E.out = cx.p->out;
            pg8::gemm_phase(lds, g, S, E, cx.tid);
        } else if (kind == 9) {
            phase_conv(cx, (const bf16_t*)(ws + B_U), (const bf16_t*)(ws + B_GB), (bf16_t*)(ws + B_CV));
        } else {
            phase_final(cx, XB_, SS_(6));
        }
        if (ph < 18) xcd_barrier((unsigned*)(ws + WS_BAR), bst, cx.tid, (unsigned)G);
        }
    }
}

extern "C" void kernel_launch(void* const* d_in, const int* in_sizes, int n_in, void* d_out, int out_size, void* d_ws, size_t ws_size, hipStream_t stream) {
    static int grid_blocks = 0;
    if (grid_blocks == 0) {
        if (n_in != 30 || (size_t)out_size != O_END || ws_size < WS_END) {
            fprintf(stderr, "kernel_launch: unexpected shapes: n_in %d out_size %d ws_size %zu (need %zu)\n", n_in, out_size, ws_size, (size_t)WS_END);
            grid_blocks = -1; return;
        }
        int dev = 0, cus = 0, per_cu = 0;
        (void)hipGetDevice(&dev);
        (void)hipDeviceGetAttribute(&cus, hipDeviceAttributeMultiprocessorCount, dev);
        (void)hipFuncSetAttribute((const void*)mega, hipFuncAttributeMaxDynamicSharedMemorySize, LDS_BYTES);
        (void)hipOccupancyMaxActiveBlocksPerMultiprocessor(&per_cu, (const void*)mega, NTHREADS, LDS_BYTES);
        if (per_cu < 1) per_cu = 1;
        grid_blocks = cus * per_cu;
        if (grid_blocks > 256) grid_blocks = 256;
    }
    if (grid_blocks < 0) return;
    (void)hipMemsetAsync((char*)d_ws, 0, WS_CTL_END, stream);
    Params p{};
    for (int i = 0; i < 30; ++i) p.in[i] = (const float*)d_in[i];
    p.out = (float*)d_out; p.ws = (unsigned char*)d_ws;
    void* args[] = {&p};
    hipError_t e = hipLaunchCooperativeKernel((const void*)mega, dim3(grid_blocks), dim3(NTHREADS), args, LDS_BYTES, stream);
    if (e != hipSuccess) fprintf(stderr, "cooperative launch failed: %s (grid %d)\n", hipGetErrorString(e), grid_blocks);
}
```

```cpp
#include <hip/hip_runtime.h>
#include <hip/hip_cooperative_groups.h>
#include <cstdio>
#include <cstdint>
namespace cg = cooperative_groups;

#define LAS __attribute__((address_space(3)))
typedef unsigned short bf16_t;
typedef short bf16x8 __attribute__((ext_vector_type(8)));
typedef float f32x4 __attribute__((ext_vector_type(4)));
typedef float f32x2 __attribute__((ext_vector_type(2)));
typedef unsigned u32x4 __attribute__((ext_vector_type(4)));
typedef unsigned u32x2 __attribute__((ext_vector_type(2)));

constexpr int D = 1024, FF = 2816, NH = 16;
constexpr int PB = 8, PT = 2064, NMETA = 16, PTX = 2048, SBN = 128, STN = 8;
constexpr int MP = PB * PT;
constexpr int MS = SBN * STN;
constexpr int M = MP + MS;
constexpr int MPAD = 17664;
constexpr int NTHREADS = 512;
constexpr int LDS_BYTES = 131072 + 16;

constexpr size_t O_YP = 0;
constexpr size_t O_YS = O_YP + (size_t)PB * PTX * D;
constexpr size_t O_WKVP = O_YS + (size_t)MS * D;
constexpr size_t O_SHP = O_WKVP + (size_t)PB * NH * 64 * 64;
constexpr size_t O_CVP = O_SHP + (size_t)PB * D;
constexpr size_t O_WKVS = O_CVP + (size_t)PB * 2 * D;
constexpr size_t O_SHS = O_WKVS + (size_t)SBN * NH * 64 * 64;
constexpr size_t O_CVS = O_SHS + (size_t)SBN * D;
constexpr size_t O_END = O_CVS + (size_t)SBN * 2 * D;

constexpr size_t AL(size_t x) { return (x + 255) & ~(size_t)255; }
constexpr size_t ROWB = (size_t)MPAD * D * 2;
constexpr size_t WS_BAR = 0;
constexpr size_t WS_CTL_END = 16384;
constexpr size_t WS_SS = 16384;
constexpr size_t WS_SS_END = AL(WS_SS + (size_t)MPAD * 16 * 4);
constexpr size_t WS_X = WS_SS_END;
constexpr size_t WS_MISC = AL(WS_X + (size_t)MPAD * D * 4);
constexpr size_t SZ_WRKV = (size_t)3584 * 2048 * 2;
constexpr size_t SZ_WL2 = (size_t)3072 * 384 * 2;
constexpr size_t SZ_W1K = (size_t)1024 * 1024 * 2;
constexpr size_t WS_WRKV = WS_MISC;
constexpr size_t WS_WL2 = AL(WS_WRKV + SZ_WRKV);
constexpr size_t WS_WO = AL(WS_WL2 + SZ_WL2);
constexpr size_t WS_BIG = AL(WS_WO + SZ_W1K);
constexpr size_t SZ_BIG = (size_t)MPAD * 2048 * 2 * 2 + 4096;
constexpr size_t WS_LAZY = AL(WS_BIG + SZ_BIG);
constexpr size_t SZ_GU = (size_t)5632 * 1024 * 2;
constexpr size_t SZ_DN = (size_t)1024 * 2816 * 2;
constexpr size_t SZ_SLOT = SZ_GU + SZ_DN;
constexpr size_t WS_SLOTA = WS_LAZY;
constexpr size_t WS_SLOTB = WS_SLOTA + SZ_SLOT;
constexpr size_t WS_WIN = WS_SLOTB + SZ_SLOT;
constexpr size_t WS_WOUT = WS_WIN + (size_t)3072 * 1024 * 2;
constexpr size_t WS_END = WS_WOUT + SZ_W1K;
constexpr size_t B_ACT = WS_BIG;
constexpr size_t B_HH = WS_BIG;
constexpr size_t B_R = WS_BIG + 2 * ROWB;
constexpr size_t B_K = WS_BIG + 3 * ROWB;
constexpr size_t B_LW = WS_BIG;
constexpr size_t B_A = WS_BIG + ROWB;
constexpr size_t B_O = WS_BIG;
constexpr size_t B_U = WS_BIG;
constexpr size_t B_GB = WS_BIG + ROWB;
constexpr size_t B_CV = WS_BIG + 2 * ROWB;
constexpr size_t DO_XB = 0;
constexpr size_t DO_L1 = ROWB;
constexpr size_t DO_YPR = ROWB;
static_assert(DO_YPR + (size_t)MP * D * 2 <= O_WKVP * 4, "y-region overflow");
static_assert(DO_L1 + (size_t)MPAD * 384 * 2 <= O_WKVP * 4, "l1 overflow");
constexpr size_t L_G = WS_LAZY;
constexpr size_t L_YS = WS_LAZY + ROWB;
static_assert(L_YS + (size_t)MS * D * 2 <= WS_END, "lazy overflow");
constexpr size_t SZ_ACT = (size_t)MPAD * 2816 * 2;
static_assert(SZ_BIG >= SZ_ACT + (size_t)140 * 32 * 512 * 16, "ACT + split-K slab do not fit");

struct Params {
    const float* in[30];
    float* out;
    unsigned char* ws;
};
typedef const __attribute__((address_space(4))) Params* KP;
struct Ctx { KP p; int tid, bid, G; };

__device__ __forceinline__ unsigned cvt_pk_bf16(float lo, float hi) { unsigned r; asm volatile("v_cvt_pk_bf16_f32 %0, %1, %2" : "=v"(r) : "v"(lo), "v"(hi)); return r; }
__device__ __forceinline__ float bf_lo(unsigned v) { return __uint_as_float(v << 16); }
__device__ __forceinline__ float bf_hi(unsigned v) { return __uint_as_float(v & 0xffff0000u); }
__device__ __forceinline__ float frcp(float x) { return __builtin_amdgcn_rcpf(x); }
__device__ __forceinline__ float fsigmoid(float x) { return frcp(1.f + __expf(-x)); }
__device__ __forceinline__ void unpack8(u32x4 v, float* o) {
    o[0] = bf_lo(v[0]); o[1] = bf_hi(v[0]); o[2] = bf_lo(v[1]); o[3] = bf_hi(v[1]);
    o[4] = bf_lo(v[2]); o[5] = bf_hi(v[2]); o[6] = bf_lo(v[3]); o[7] = bf_hi(v[3]);
}
__device__ __forceinline__ u32x4 pack8(const float* o) {
    u32x4 r; r[0] = cvt_pk_bf16(o[0], o[1]); r[1] = cvt_pk_bf16(o[2], o[3]); r[2] = cvt_pk_bf16(o[4], o[5]); r[3] = cvt_pk_bf16(o[6], o[7]); return r;
}
template <int CTRL> __device__ __forceinline__ float dpp_f(float x) {
    return __int_as_float(__builtin_amdgcn_update_dpp(0, __float_as_int(x), CTRL, 0xF, 0xF, false));
}
__device__ __forceinline__ float allreduce16(float p) {
    p += dpp_f<0xB1>(p); p += dpp_f<0x4E>(p); p += dpp_f<0x124>(p); p += dpp_f<0x128>(p); return p;
}
__device__ __forceinline__ float allreduce8(float p) {
    p += dpp_f<0xB1>(p); p += dpp_f<0x4E>(p); p += __shfl_xor(p, 4); return p;
}
__device__ __forceinline__ float wave_sum(float p) {
#pragma unroll
    for (int o = 32; o >= 1; o >>= 1) p += __shfl_xor(p, o);
    return p;
}
__device__ __forceinline__ float row_rs(const float* ssp, int r) {
    const f32x4 a = *(const f32x4*)(ssp + (size_t)r * 16), b = *(const f32x4*)(ssp + (size_t)r * 16 + 4), c = *(const f32x4*)(ssp + (size_t)r * 16 + 8), d = *(const f32x4*)(ssp + (size_t)r * 16 + 12);
    const float s = ((a[0] + a[1]) + (a[2] + a[3])) + ((b[0] + b[1]) + (b[2] + b[3])) + ((c[0] + c[1]) + (c[2] + c[3])) + ((d[0] + d[1]) + (d[2] + d[3]));
    return rsqrtf(s * (1.f / 1024.f) + 1e-6f);
}
__device__ __forceinline__ void row_info(int m, int& t, int& T, int& seq) {
    if (m < MP) { seq = m / PT; t = m - seq * PT; T = PT; }
    else { const int q = m - MP; seq = 8 + (q >> 3); t = q & 7; T = STN; }
}

namespace pg8 {
constexpr int BM = 256, BK = 64, HALF = 128, HTB = HALF * BK * 2, STAGE_BYTES = 8 * HTB, NXCD = 8, WGM = 4;
__host__ __device__ __forceinline__ int lds_byte(int r, int c) { const int st = (r >> 4) * 2 + (c >> 5), rr = r & 15, cc = c & 31, ob = rr * 64 + cc * 2; return st * 1024 + (ob ^ (((ob >> 9) & 1) << 5)); }
__host__ __device__ __forceinline__ void stage_rc(int b, int& R, int& C) { const int st = b / 1024, sb = b % 1024, swz = sb ^ (((sb >> 9) & 1) << 5); R = (st >> 1) * 16 + swz / 64; C = (st & 1) * 32 + (swz % 64) / 2; }
__host__ __device__ __forceinline__ int perm32(int rho) { const int n = rho >> 4, i = rho & 15; return 8 * (i >> 2) + 4 * n + (i & 3); }

struct Unit { int pm, pn, k0, nt, sub; };
struct Gemm { const bf16_t* A; const bf16_t* Bt; int K; };
struct StaticOrder {
    int nM, nN, nwg, G, c;
    int ntK; int wgm;
    __device__ __forceinline__ void init(int nM_, int nN_, int G_, int c_, int K_) { nM = nM_; nN = nN_; nwg = nM * nN; G = G_; c = c_; ntK = K_ / BK; wgm = (nN_ == 22) ? 8 : 4; }
    __device__ __forceinline__ void tile(int L, Unit& u) const {
        int wgid = L; { const int q = nwg / NXCD, r = nwg % NXCD, xcd = wgid % NXCD, off = wgid / NXCD; wgid = (xcd < r ? xcd * (q + 1) : r * (q + 1) + (xcd - r) * q) + off; }
        const int nig = wgm * nN, gid = wgid / nig, fm = gid * wgm, gsz = (nM - fm) < wgm ? (nM - fm) : wgm;
        u.pm = fm + ((wgid % nig) % gsz); u.pn = (wgid % nig) / gsz; u.k0 = 0; u.nt = ntK; u.sub = -1;
    }
    __device__ __forceinline__ bool next(int i, Unit& u) const {
        const long L = (long)i * G + c; if (L >= nwg) return false;
        u.k0 = 0; u.nt = ntK; u.sub = -1;
        int wgid = (int)L; { const int q = nwg / NXCD, r = nwg % NXCD, xcd = wgid % NXCD, off = wgid / NXCD; wgid = (xcd < r ? xcd * (q + 1) : r * (q + 1) + (xcd - r) * q) + off; }
        const int nig = wgm * nN, gid = wgid / nig, fm = gid * wgm, gsz = (nM - fm) < wgm ? (nM - fm) : wgm;
        u.pm = fm + ((wgid % nig) % gsz); u.pn = (wgid % nig) / gsz; return true;
    }
};

struct SplitOrder : StaticOrder {
    __device__ __forceinline__ bool next(int i, Unit& u) const {
        if (i == 0) { tile(c, u); return true; }
        if (i == 1 && c < 140) { tile(256 + c / 7, u); const int part = c % 7; u.k0 = part * 6; u.nt = part == 6 ? 8 : 6; u.sub = c; return true; }
        return false;
    }
};
struct L2Order : StaticOrder {
    __device__ __forceinline__ bool next(int i, Unit& u) const {
        if (!StaticOrder::next(i, u)) return false;
        if (u.pn < 8) { u.k0 = 0; u.nt = 2; } else { u.k0 = 2; u.nt = 4; }
        return true;
    }
};
template <class Epi, class Sched>
__device__ __forceinline__ void gemm_phase(LAS unsigned char* lds, const Gemm g, const Sched& S, const Epi& E, const int tid_, f32x4* slab = nullptr) {
    const int tid = tid_, wid = __builtin_amdgcn_readfirstlane(tid >> 6), lane = tid & 63, wr = wid >> 2, wc = wid & 3, fr = lane & 15, fq = lane >> 4;
    const int K = g.K;
    unsigned voffA[2], voffB[2];
#pragma unroll
    for (int i = 0; i < 2; ++i) { int R, C; stage_rc(tid * 16 + i * 8192, R, C); const int Rb = (R & ~31) + perm32(R & 31);
        voffA[i] = (unsigned)(R * K + C) * 2u; voffB[i] = (unsigned)(Rb * K + C) * 2u; }
    const size_t kstep = (size_t)(BK * 2);
    const size_t hstep = (size_t)HALF * K * 2;
    const size_t tstep = 2 * hstep;
    const unsigned ldsw = (unsigned)wid * 1024u;
    const int aoff = lds_byte(wr * 64 + fr, fq * 8), boff = lds_byte(wc * 32 + fr, fq * 8);
#define PG8_SA(b, h) (((b) * 2 + (h)) * HTB)
#define PG8_SB(b, h) ((4 + (b) * 2 + (h)) * HTB)
#define PG8_STAGE(bufoff, gbase, voff) do { _Pragma("unroll") for (int _i = 0; _i < 2; ++_i) \
        __builtin_amdgcn_global_load_lds((const unsigned*)((const char*)(gbase) + (voff)[_i]), (LAS unsigned*)(lds + (bufoff) + ldsw + _i * 8192), 16, 0, 0); } while (0)
#define PG8_LDA(dst, b, h) do { _Pragma("unroll") for (int m = 0; m < 4; ++m) _Pragma("unroll") for (int k = 0; k < 2; ++k) dst[m][k] = *(const LAS bf16x8*)(lds + PG8_SA(b, h) + aoff + m * 2048 + k * 1024); } while (0)
#define PG8_LDB(dst, b, h) do { _Pragma("unroll") for (int n = 0; n < 2; ++n) _Pragma("unroll") for (int k = 0; k < 2; ++k) dst[n][k] = *(const LAS bf16x8*)(lds + PG8_SB(b, h) + boff + n * 2048 + k * 1024); } while (0)
#define PG8_MMA(ai, bj, At, Bt) do { __builtin_amdgcn_s_setprio(1); _Pragma("unroll") for (int m = 0; m < 4; ++m) _Pragma("unroll") for (int n = 0; n < 2; ++n) _Pragma("unroll") for (int k = 0; k < 2; ++k) \
        acc[ai][bj][m][n] = __builtin_amdgcn_mfma_f32_16x16x32_bf16(Bt[n][k], At[m][k], acc[ai][bj][m][n], 0, 0, 0); __builtin_amdgcn_s_setprio(0); } while (0)
#define PG8_WAIT_V(n) asm volatile("s_waitcnt vmcnt(" #n ")" ::: "memory")
#define PG8_WAIT_L(n) asm volatile("s_waitcnt lgkmcnt(" #n ")" ::: "memory")
#define PG8_BAR __builtin_amdgcn_s_barrier()
#define PG8_SCHED __builtin_amdgcn_sched_barrier(0)
    Unit cur, nxt; int ui = 0;
    if (!S.next(0, cur)) return;
    f32x4 acc[2][2][4][2];
#pragma unroll
    for (int a = 0; a < 2; ++a)
#pragma unroll
        for (int b = 0; b < 2; ++b)
#pragma unroll
            for (int m = 0; m < 4; ++m)
#pragma unroll
                for (int n = 0; n < 2; ++n) acc[a][b][m][n] = (f32x4){0.f, 0.f, 0.f, 0.f};
    bf16x8 At[4][2], B0[2][2], B1[2][2];
    const char* cA = (const char*)g.A + (size_t)cur.pm * tstep + (size_t)cur.k0 * kstep; const char* cB = (const char*)g.Bt + (size_t)cur.pn * tstep + (size_t)cur.k0 * kstep;
    PG8_STAGE(PG8_SB(0, 0), cB, voffB); PG8_STAGE(PG8_SA(0, 0), cA, voffA); PG8_STAGE(PG8_SB(0, 1), cB + hstep, voffB); PG8_STAGE(PG8_SA(0, 1), cA + hstep, voffA);
    if (wr == 1) PG8_BAR;
    PG8_WAIT_V(4); PG8_BAR;
    PG8_STAGE(PG8_SB(1, 0), cB + kstep, voffB); PG8_STAGE(PG8_SA(1, 0), cA + kstep, voffA); PG8_STAGE(PG8_SB(1, 1), cB + hstep + kstep, voffB);
    PG8_WAIT_V(6); PG8_BAR;
    for (;;) {
        const bool has_next = S.next(ui + 1, nxt);
        const char* nA = has_next ? (const char*)g.A + (size_t)nxt.pm * tstep + (size_t)nxt.k0 * kstep : cA; const char* nB = has_next ? (const char*)g.Bt + (size_t)nxt.pn * tstep + (size_t)nxt.k0 * kstep : cB;
        const int nt = cur.nt;
        for (int t = 0; t < nt; t += 2) {
            const bool last = (t == nt - 2);
            const char* a1 = cA + (size_t)(t + 1) * kstep;
            const char* a2 = last ? nA : cA + (size_t)(t + 2) * kstep; const char* b2 = last ? nB : cB + (size_t)(t + 2) * kstep;
            const char* a3 = a2 + kstep; const char* b3 = b2 + kstep;
            PG8_LDB(B0, 0, 0); PG8_SCHED; PG8_LDA(At, 0, 0); PG8_STAGE(PG8_SA(1, 1), a1 + hstep, voffA);
            PG8_WAIT_L(8); PG8_BAR; PG8_WAIT_L(0); PG8_MMA(0, 0, At, B0); PG8_BAR; PG8_SCHED;
            PG8_LDB(B1, 0, 1); PG8_STAGE(PG8_SB(0, 0), b2, voffB);
            PG8_BAR; PG8_WAIT_L(0); PG8_MMA(0, 1, At, B1); PG8_BAR;
            PG8_LDA(At, 0, 1); PG8_STAGE(PG8_SA(0, 0), a2, voffA);
            PG8_BAR; PG8_WAIT_L(0); PG8_MMA(1, 0, At, B0); PG8_BAR; PG8_SCHED;
            PG8_STAGE(PG8_SB(0, 1), b2 + hstep, voffB);
            PG8_WAIT_V(6); PG8_BAR; PG8_MMA(1, 1, At, B1); PG8_BAR;
            PG8_LDB(B0, 1, 0); PG8_SCHED; PG8_LDA(At, 1, 0); PG8_STAGE(PG8_SA(0, 1), a2 + hstep, voffA);
            PG8_WAIT_L(8); PG8_BAR; PG8_WAIT_L(0); PG8_MMA(0, 0, At, B0); PG8_BAR; PG8_SCHED;
            PG8_LDB(B1, 1, 1); PG8_STAGE(PG8_SB(1, 0), b3, voffB);
            PG8_BAR; PG8_WAIT_L(0); PG8_MMA(0, 1, At, B1); PG8_BAR;
            PG8_LDA(At, 1, 1); PG8_STAGE(PG8_SA(1, 0), a3, voffA);
            PG8_BAR; PG8_WAIT_L(0); PG8_MMA(1, 0, At, B0); PG8_BAR; PG8_SCHED;
            PG8_STAGE(PG8_SB(1, 1), b3 + hstep, voffB);
            PG8_WAIT_V(6); PG8_BAR; PG8_MMA(1, 1, At, B1); PG8_BAR;
        }
        if (cur.sub < 0) { int fr_ = fr, fq_ = fq; asm volatile("" : "+v"(fr_), "+v"(fq_)); E(acc, cur, wr, wc, fr_, fq_); }
        else {
            int t_ = tid; asm volatile("" : "+v"(t_));
            f32x4* sp = slab + (size_t)cur.sub * 32 * 512 + t_;
#pragma unroll
            for (int a = 0; a < 2; ++a)
#pragma unroll
                for (int b = 0; b < 2; ++b)
#pragma unroll
                    for (int m = 0; m < 4; ++m)
#pragma unroll
                        for (int n = 0; n < 2; ++n) sp[(size_t)(((a * 2 + b) * 4 + m) * 2 + n) * 512] = acc[a][b][m][n];
        }
        if (!has_next) break;
#pragma unroll
        for (int a = 0; a < 2; ++a)
#pragma unroll
            for (int b = 0; b < 2; ++b)
#pragma unroll
                for (int m = 0; m < 4; ++m)
#pragma unroll
                    for (int n = 0; n < 2; ++n) acc[a][b][m][n] = (f32x4){0.f, 0.f, 0.f, 0.f};
        cur = nxt; cA = nA; cB = nB; ++ui;
    }
    PG8_WAIT_V(0);
    if (wr == 0) PG8_BAR;
    PG8_BAR;
#undef PG8_SA
#undef PG8_SB
#undef PG8_STAGE
#undef PG8_LDA
#undef PG8_LDB
#undef PG8_MMA
#undef PG8_WAIT_V
#undef PG8_WAIT_L
#undef PG8_BAR
#undef PG8_SCHED
}
}
using pg8::Unit;

__device__ __forceinline__ void rows_rs8(const float* ss, int row0  , int fq, float (&rsv)[8]) {
    f32x4 part[8];
#pragma unroll
    for (int i = 0; i < 8; ++i) part[i] = *(const f32x4*)(ss + (size_t)(row0 + (i >> 2) * 128 + (i & 3) * 16) * 16 + 4 * fq);
#pragma unroll
    for (int i = 0; i < 8; ++i) {
        float t = (part[i][0] + part[i][1]) + (part[i][2] + part[i][3]);
        t += __shfl_xor(t, 16); t += __shfl_xor(t, 32);
        rsv[i] = rsqrtf(t * (1.f / 1024.f) + 1e-6f);
    }
}
struct EpiGU {
    const float* ss; bf16_t* act;
    __device__ __forceinline__ void operator()(const f32x4 (&acc)[2][2][4][2], const Unit& u, int wr, int wc, int fr, int fq) const {
        const int col = u.pn * 128 + wc * 32 + 8 * fq;
        const int row0 = u.pm * 256 + wr * 64 + fr;
        float rsv[8]; rows_rs8(ss, row0, fq, rsv);
#pragma unroll
        for (int ai = 0; ai < 2; ++ai)
#pragma unroll
            for (int m = 0; m < 4; ++m) {
                const int r = row0 + ai * 128 + m * 16;
                const float rs = rsv[ai * 4 + m];
                float o[8];
#pragma unroll
                for (int n = 0; n < 2; ++n) {
                    const f32x4 gt = acc[ai][0][m][n] * rs, gu = gt * (acc[ai][1][m][n] * rs), ex = gt * (-1.44269504089f);
                    f32x4 den; den[0] = __builtin_amdgcn_exp2f(ex[0]); den[1] = __builtin_amdgcn_exp2f(ex[1]); den[2] = __builtin_amdgcn_exp2f(ex[2]); den[3] = __builtin_amdgcn_exp2f(ex[3]);
                    den = den + 1.0f;
                    f32x4 rc; rc[0] = frcp(den[0]); rc[1] = frcp(den[1]); rc[2] = frcp(den[2]); rc[3] = frcp(den[3]);
                    const f32x4 res = gu * rc;
                    o[n * 4 + 0] = res[0]; o[n * 4 + 1] = res[1]; o[n * 4 + 2] = res[2]; o[n * 4 + 3] = res[3];
                }
                *(u32x4*)(act + (size_t)r * FF + col) = pack8(o);
            }
    }
};
struct EpiRes {
    bf16_t* XB; float* ssout; float scale;
    __device__ __forceinline__ void operator()(const f32x4 (&acc)[2][2][4][2], const Unit& u, int wr, int wc, int fr, int fq) const {
        const int row0 = u.pm * 256 + wr * 64 + fr, col0 = u.pn * 256 + wc * 32 + 8 * fq;
#pragma unroll
        for (int ai = 0; ai < 2; ++ai) {
            u32x4 xv[4][2];
#pragma unroll
            for (int m = 0; m < 4; ++m)
#pragma unroll
                for (int bj = 0; bj < 2; ++bj) xv[m][bj] = *(const u32x4*)(XB + (size_t)(row0 + ai * 128 + m * 16) * D + col0 + bj * 128);
#pragma unroll
            for (int m = 0; m < 4; ++m) {
                const int r = row0 + ai * 128 + m * 16;
                float ssum = 0.f;
#pragma unroll
                for (int bj = 0; bj < 2; ++bj) {
                    float o[8]; unpack8(xv[m][bj], o);
#pragma unroll
                    for (int j = 0; j < 4; ++j) { o[j] += acc[ai][bj][m][0][j] * scale; o[4 + j] += acc[ai][bj][m][1][j] * scale; }
                    *(u32x4*)(XB + (size_t)r * D + col0 + bj * 128) = pack8(o);
#pragma unroll
                    for (int j = 0; j < 8; ++j) ssum += o[j] * o[j];
                }
                ssum += __shfl_xor(ssum, 16); ssum += __shfl_xor(ssum, 32);
                if (fq == 0) ssout[(size_t)r * 16 + u.pn * 4 + wc] = ssum;
            }
        }
    }
};
struct EpiRKV {
    unsigned char* ws; unsigned char* dob;
    __device__ __forceinline__ void operator()(const f32x4 (&acc)[2][2][4][2], const Unit& u, int wr, int wc, int fr, int fq) const {
        if (u.pn < 12) {
            bf16_t* base = (u.pn < 8) ? (bf16_t*)(ws + B_R + (size_t)(u.pn >> 2) * ROWB) : (bf16_t*)(dob + DO_XB);
#pragma unroll
            for (int ai = 0; ai < 2; ++ai)
#pragma unroll
                for (int m = 0; m < 4; ++m) {
                    const int row = u.pm * 256 + ai * 128 + wr * 64 + m * 16 + fr;
#pragma unroll
                    for (int bj = 0; bj < 2; ++bj) {
                        const int c = (u.pn & 3) * 256 + bj * 128 + wc * 32 + 8 * fq;
                        float o[8] = {acc[ai][bj][m][0][0], acc[ai][bj][m][0][1], acc[ai][bj][m][0][2], acc[ai][bj][m][0][3], acc[ai][bj][m][1][0], acc[ai][bj][m][1][1], acc[ai][bj][m][1][2], acc[ai][bj][m][1][3]};
                        *(u32x4*)(base + (size_t)row * D + c) = pack8(o);
                    }
                }
        } else {
#pragma unroll
            for (int ai = 0; ai < 2; ++ai)
#pragma unroll
                for (int m = 0; m < 4; ++m) {
                    const int row = u.pm * 256 + ai * 128 + wr * 64 + m * 16 + fr;
#pragma unroll
                    for (int bj = 0; bj < 2; ++bj) {
                        const int c = (u.pn - 12) * 256 + bj * 128 + wc * 32 + 8 * fq;
                        if (c >= 384) continue;
                        float o[8];
#pragma unroll
                        for (int n = 0; n < 2; ++n)
#pragma unroll
                            for (int j = 0; j < 4; ++j) {
                                const float a = acc[ai][bj][m][n][j]; float val;
                                if (c < 64) val = 1.f - 2.f * frcp(1.f + __expf(2.f * a));
                                else if (c < 128) val = a;
                                else if (c < 288) val = fsigmoid(a);
                                else val = 0.f;
                                o[n * 4 + j] = val;
                            }
                        *(u32x4*)((bf16_t*)(dob + DO_L1) + (size_t)row * 384 + c) = pack8(o);
                    }
                }
        }
    }
};
struct EpiL2 {
    unsigned char* ws; const float* w0; const float* a0;
    __device__ __forceinline__ void operator()(const f32x4 (&acc)[2][2][4][2], const Unit& u, int wr, int wc, int fr, int fq) const {
        const int kind = u.pn >> 2;
        bf16_t* base = (bf16_t*)(ws + (kind == 2 ? L_G : B_LW + (size_t)kind * ROWB));
        const float* bsrc = kind == 0 ? w0 : a0;
        const float bmul = kind == 2 ? 0.f : 1.f;
        f32x4 bvv[2][2];
#pragma unroll
        for (int bj = 0; bj < 2; ++bj)
#pragma unroll
            for (int n = 0; n < 2; ++n) bvv[bj][n] = *(const f32x4*)(bsrc + (u.pn & 3) * 256 + bj * 128 + wc * 32 + 8 * fq + 4 * n) * bmul;
#pragma unroll
        for (int ai = 0; ai < 2; ++ai)
#pragma unroll
            for (int m = 0; m < 4; ++m) {
                const int row = u.pm * 256 + ai * 128 + wr * 64 + m * 16 + fr;
#pragma unroll
                for (int bj = 0; bj < 2; ++bj) {
                    const int c = (u.pn & 3) * 256 + bj * 128 + wc * 32 + 8 * fq;
                    float o[8];
#pragma unroll
                    for (int n = 0; n < 2; ++n) {
                        const f32x4 bv = bvv[bj][n];
#pragma unroll
                        for (int j = 0; j < 4; ++j) {
                            const float z = acc[ai][bj][m][n][j] + bv[j];
                            const float sg = fsigmoid(z);
                            o[n * 4 + j] = kind == 0 ? -0.60653065971f * sg : (kind == 1 ? sg : z);
                        }
                    }
                    *(u32x4*)(base + (size_t)row * D + c) = pack8(o);
                }
            }
    }
};
struct EpiCI {
    const float* ss; bf16_t* U; bf16_t* GB; float* out;
    __device__ __forceinline__ void operator()(const f32x4 (&acc)[2][2][4][2], const Unit& u, int wr, int wc, int fr, int fq) const {
        float rsv[8]; rows_rs8(ss, u.pm * 256 + wr * 64 + fr, fq, rsv);
#pragma unroll
        for (int ai = 0; ai < 2; ++ai)
#pragma unroll
            for (int m = 0; m < 4; ++m) {
                const int row = u.pm * 256 + ai * 128 + wr * 64 + m * 16 + fr;
                const float rs = rsv[ai * 4 + m];
                if (u.pn < 8) {
                    const int c = u.pn * 128 + wc * 32 + 8 * fq;
                    float o[8];
#pragma unroll
                    for (int n = 0; n < 2; ++n)
#pragma unroll
                        for (int j = 0; j < 4; ++j) o[n * 4 + j] = (acc[ai][0][m][n][j] * rs) * (acc[ai][1][m][n][j] * rs);
                    *(u32x4*)(U + (size_t)row * D + c) = pack8(o);
                    if (row < M) {
                        int t, T, seq; row_info(row, t, T, seq);
                        if (t >= T - 2) {
                            float* op = (seq < 8) ? out + O_CVP + ((size_t)seq * 2 + (t - (T - 2))) * D + c : out + O_CVS + ((size_t)(seq - 8) * 2 + (t - (T - 2))) * D + c;
                            *(f32x4*)op = (f32x4){o[0], o[1], o[2], o[3]}; *(f32x4*)(op + 4) = (f32x4){o[4], o[5], o[6], o[7]};
                        }
                    }
                } else {
#pragma unroll
                    for (int bj = 0; bj < 2; ++bj) {
                        const int c = (u.pn - 8) * 256 + bj * 128 + wc * 32 + 8 * fq;
                        float o[8];
#pragma unroll
                        for (int n = 0; n < 2; ++n)
#pragma unroll
                            for (int j = 0; j < 4; ++j) o[n * 4 + j] = acc[ai][bj][m][n][j] * rs;
                        *(u32x4*)(GB + (size_t)row * D + c) = pack8(o);
                    }
                }
            }
    }
};

struct TSrc { const float* p; int ld; int vk; int vc; const float* scale; int smode; };
__device__ __forceinline__ void tblock(LAS float* tile, const TSrc s, bf16_t* dst  , int kdst, const int tid) {
    const int kr = tid >> 4, c4 = (tid & 15) * 4;
    __syncthreads();
#pragma unroll
    for (int hf = 0; hf < 2; ++hf) {
        const int k = kr + 32 * hf;
        f32x4 v = (f32x4){0.f, 0.f, 0.f, 0.f};
        if (k < s.vk && c4 < s.vc) {
            v = *(const f32x4*)(s.p + (size_t)k * s.ld + c4);
            if (s.smode) { float sc = s.scale[k]; if (s.smode == 2) sc = 1.f - sc; v *= sc; }
        }
        tile[k * 65 + c4 + 0] = v[0]; tile[k * 65 + c4 + 1] = v[1]; tile[k * 65 + c4 + 2] = v[2]; tile[k * 65 + c4 + 3] = v[3];
    }
    __syncthreads();
    const int n = tid >> 3, k8 = (tid & 7) * 8;
    float o[8];
#pragma unroll
    for (int j = 0; j < 8; ++j) o[j] = tile[(k8 + j) * 65 + n];
    *(u32x4*)(dst + (size_t)n * kdst + k8) = pack8(o);
}
enum { T_GU = 0, T_DN, T_RKV, T_L2, T_PLAIN, T_WIN };
__device__ __forceinline__ void convert(LAS float* tile, const Ctx& cx, int type, int f, bf16_t* dst, int wg, int nwg) {
    int Nd, Kd;
    switch (type) { case T_GU: Nd = 5632; Kd = 1024; break; case T_DN: Nd = 1024; Kd = 2816; break; case T_RKV: Nd = 3584; Kd = 2048; break;
                    case T_L2: Nd = 3072; Kd = 384; break; case T_WIN: Nd = 3072; Kd = 1024; break; default: Nd = 1024; Kd = 1024; break; }
    const int nkb = Kd / 64, nblk = (Nd / 64) * nkb;
    for (int blk = wg; blk < nblk; blk += nwg) {
        const int nb = blk / nkb, kb = blk - nb * nkb, n0 = nb * 64, kd0 = kb * 64;
        TSrc s; s.p = nullptr; s.ld = 0; s.vk = 0; s.vc = 0; s.scale = nullptr; s.smode = 0;
        if (type == T_GU) {
            const int pn = n0 >> 8, bj = (n0 >> 7) & 1, i0 = n0 & 127, c0 = bj * FF + 128 * pn + i0;
            s.p = cx.p->in[7] + (size_t)f * D * 2 * FF + (size_t)kd0 * (2 * FF) + c0; s.ld = 2 * FF; s.vk = 64; s.vc = 64; s.scale = cx.p->in[6] + f * D + kd0; s.smode = 1;
        } else if (type == T_DN) {
            s.p = cx.p->in[8] + (size_t)f * FF * D + (size_t)kd0 * D + n0; s.ld = D; s.vk = 64; s.vc = 64;
        } else if (type == T_RKV) {
            const int hf = kd0 >= 1024, ks = kd0 & 1023; s.smode = hf ? 1 : 2; s.vk = 64;
            if (n0 < 3072) { const int pj = n0 >> 10, c0 = n0 & 1023, mi = pj == 0 ? 0 : (pj == 1 ? 2 : 3);
                s.p = cx.p->in[12] + (size_t)pj * D * D + (size_t)ks * D + c0; s.ld = D; s.vc = 64; s.scale = cx.p->in[11] + mi * D + ks; }
            else { const int j0 = n0 - 3072;
                if (j0 < 64) { s.p = cx.p->in[14] + (size_t)ks * 64 + j0; s.ld = 64; s.vc = 64; s.scale = cx.p->in[11] + 1 * D + ks; }
                else if (j0 < 128) { s.p = cx.p->in[17] + (size_t)ks * 64 + (j0 - 64); s.ld = 64; s.vc = 64; s.scale = cx.p->in[11] + 4 * D + ks; }
                else if (j0 < 288) { const int c0 = j0 - 128; s.p = cx.p->in[19] + (size_t)ks * 160 + c0; s.ld = 160; s.vc = (160 - c0) < 64 ? (160 - c0) : 64; s.scale = cx.p->in[11] + 5 * D + ks; }
                else { s.vk = 0; s.vc = 0; s.smode = 0; s.p = cx.p->in[14]; } }
        } else if (type == T_L2) {
            s.p = cx.p->in[15];
            if (n0 < 1024) { if (kd0 == 0) { s.p = cx.p->in[15] + n0; s.ld = D; s.vk = 64; s.vc = 64; } }
            else if (n0 < 2048) { if (kd0 == 64) { s.p = cx.p->in[18] + (n0 - 1024); s.ld = D; s.vk = 64; s.vc = 64; } }
            else { if (kd0 >= 128 && kd0 < 288) { const int k0 = kd0 - 128; s.p = cx.p->in[20] + (size_t)k0 * D + (n0 - 2048); s.ld = D; s.vk = (160 - k0) < 64 ? (160 - k0) : 64; s.vc = 64; } }
        } else if (type == T_WIN) {
            int c0;
            if (n0 < 2048) { const int pn = n0 >> 8, bj = (n0 >> 7) & 1, i0 = n0 & 127; c0 = (bj == 0 ? 1024 : 2048) + 128 * pn + i0; } else c0 = n0 - 2048;
            s.p = cx.p->in[27] + (size_t)kd0 * 3072 + c0; s.ld = 3072; s.vk = 64; s.vc = 64; s.scale = cx.p->in[9] + D + kd0; s.smode = 1;
        } else {
            s.p = cx.p->in[f] + (size_t)kd0 * D + n0; s.ld = D; s.vk = 64; s.vc = 64;
        }
        tblock(tile, s, dst + (size_t)n0 * Kd + kd0, Kd, cx.tid);
    }
}

__device__ __forceinline__ void ld8f(const float* p, float* o) { const f32x4 a = *(const f32x4*)p, b = *(const f32x4*)(p + 4); o[0] = a[0]; o[1] = a[1]; o[2] = a[2]; o[3] = a[3]; o[4] = b[0]; o[5] = b[1]; o[6] = b[2]; o[7] = b[3]; }
__device__ __forceinline__ void ld8b(const bf16_t* p, float* o) { unpack8(*(const u32x4*)p, o); }
__device__ __forceinline__ void phase_x0(const Ctx& cx, bf16_t* XB, float* ss0) {
    const int wave = cx.tid >> 6, lane = cx.tid & 63;
    for (int m = cx.bid * 8 + wave; m < MPAD; m += cx.G * 8) {
        const float* src = nullptr;
        if (m < MP) { const int b = m / PT, t = m - b * PT; src = t < NMETA ? cx.p->in[5] + (size_t)t * D : cx.p->in[0] + ((size_t)b * PTX + (t - NMETA)) * D; }
        else if (m < M) src = cx.p->in[1] + (size_t)(m - MP) * D;
        float s = 0.f;
#pragma unroll
        for (int i = 0; i < 4; ++i) {
            const int c = lane * 4 + i * 256;
            f32x4 v = src ? *(const f32x4*)(src + c) : (f32x4){0.f, 0.f, 0.f, 0.f};
            u32x2 pk; pk[0] = cvt_pk_bf16(v[0], v[1]); pk[1] = cvt_pk_bf16(v[2], v[3]);
            *(u32x2*)(XB + (size_t)m * D + c) = pk;
            s += v[0] * v[0] + v[1] * v[1] + v[2] * v[2] + v[3] * v[3];
        }
        s = wave_sum(s);
        if (lane < 16) ss0[(size_t)m * 16 + lane] = lane == 0 ? s : 0.f;
    }
}
__device__ __forceinline__ void phase_mix(const Ctx& cx, const bf16_t* XB, const float* ss, bf16_t* HH) {
    const int c = (cx.tid & 127) * 8, sub = cx.tid >> 7;
    float g[8];
    { const f32x4 g0 = *(const f32x4*)(cx.p->in[9] + c), g1 = *(const f32x4*)(cx.p->in[9] + c + 4); g[0] = g0[0]; g[1] = g0[1]; g[2] = g0[2]; g[3] = g0[3]; g[4] = g1[0]; g[5] = g1[1]; g[6] = g1[2]; g[7] = g1[3]; }
    for (int m = cx.bid * 4 + sub; m < MPAD; m += cx.G * 4) {
        float hn[8], hp[8];
        if (m < M) {
            int t, T, seq; row_info(m, t, T, seq);
            const float rs = row_rs(ss, m);
            float xc[8]; ld8b(XB + (size_t)m * D + c, xc);
#pragma unroll
            for (int j = 0; j < 8; ++j) hn[j] = xc[j] * rs * g[j];
            if (t > 0) {
                const float rp = row_rs(ss, m - 1);
                float xp[8]; ld8b(XB + (size_t)(m - 1) * D + c, xp);
#pragma unroll
                for (int j = 0; j < 8; ++j) hp[j] = xp[j] * rp * g[j];
            } else if (seq >= 8) {
                const float* sp = cx.p->in[3] + (size_t)(seq - 8) * D + c;
                const f32x4 y0 = *(const f32x4*)sp, y1 = *(const f32x4*)(sp + 4);
#pragma unroll
                for (int j = 0; j < 4; ++j) { hp[j] = y0[j]; hp[4 + j] = y1[j]; }
            } else {
#pragma unroll
                for (int j = 0; j < 8; ++j) hp[j] = 0.f;
            }
            if (t == T - 1) {
                float* op = (seq < 8) ? cx.p->out + O_SHP + (size_t)seq * D + c : cx.p->out + O_SHS + (size_t)(seq - 8) * D + c;
                *(f32x4*)op = (f32x4){hn[0], hn[1], hn[2], hn[3]}; *(f32x4*)(op + 4) = (f32x4){hn[4], hn[5], hn[6], hn[7]};
            }
        } else {
#pragma unroll
            for (int j = 0; j < 8; ++j) { hn[j] = 0.f; hp[j] = 0.f; }
        }
        *(u32x4*)(HH + (size_t)m * 2048 + c) = pack8(hn);
        *(u32x4*)(HH + (size_t)m * 2048 + 1024 + c) = pack8(hp);
    }
}
__device__ __forceinline__ void phase_post(const Ctx& cx, const bf16_t* YP, const bf16_t* YS, const float* CB, const bf16_t* V, const bf16_t* G, bf16_t* O) {
    const int c = (cx.tid & 127) * 8, sub = cx.tid >> 7;
    float lnw[8], lnb[8];
    ld8f(cx.p->in[24] + c, lnw); ld8f(cx.p->in[25] + c, lnb);
    for (int m = cx.bid * 4 + sub; m < MPAD; m += cx.G * 4) {
        float o[8];
        if (m < M) {
            float y[8], v[8], g[8];
            ld8b((m < MP ? YP + (size_t)m * D : YS + (size_t)(m - MP) * D) + c, y);
            ld8b(V + (size_t)m * D + c, v); ld8b(G + (size_t)m * D + c, g);
            const float cb = CB[(size_t)m * NH + (c >> 6)];
            float s = 0.f;
#pragma unroll
            for (int j = 0; j < 8; ++j) s += y[j];
            s = allreduce8(s);
            const float mean = s * (1.f / 64.f);
            float vs = 0.f;
#pragma unroll
            for (int j = 0; j < 8; ++j) { y[j] -= mean; vs += y[j] * y[j]; }
            vs = allreduce8(vs);
            const float rstd = rsqrtf(vs * (1.f / 64.f) + 64e-5f);
#pragma unroll
            for (int j = 0; j < 8; ++j) o[j] = (y[j] * rstd * lnw[j] + lnb[j] + cb * v[j]) * g[j];
        } else {
#pragma unroll
            for (int j = 0; j < 8; ++j) o[j] = 0.f;
        }
        *(u32x4*)(O + (size_t)m * D + c) = pack8(o);
    }
}
__device__ __forceinline__ void phase_conv(const Ctx& cx, const bf16_t* U, const bf16_t* GB, bf16_t* CV) {
    const int c = (cx.tid & 127) * 8, sub = cx.tid >> 7;
    float w0[8], w1[8], w2[8];
    ld8f(cx.p->in[28] + c, w0); ld8f(cx.p->in[28] + D + c, w1); ld8f(cx.p->in[28] + 2 * D + c, w2);
    for (int m = cx.bid * 4 + sub; m < MPAD; m += cx.G * 4) {
        float o[8];
        if (m < M) {
            int t, T, seq; row_info(m, t, T, seq);
            float u2[8], u1[8], u0[8], gb[8];
            ld8b(U + (size_t)m * D + c, u2); ld8b(GB + (size_t)m * D + c, gb);
            if (t >= 1) ld8b(U + (size_t)(m - 1) * D + c, u1);
            else if (seq >= 8) ld8f(cx.p->in[4] + ((size_t)(seq - 8) * 2 + 1) * D + c, u1);
            else {
#pragma unroll
                for (int j = 0; j < 8; ++j) u1[j] = 0.f; }
            if (t >= 2) ld8b(U + (size_t)(m - 2) * D + c, u0);
            else if (seq >= 8) ld8f(cx.p->in[4] + ((size_t)(seq - 8) * 2 + t) * D + c, u0);
            else {
#pragma unroll
                for (int j = 0; j < 8; ++j) u0[j] = 0.f; }
#pragma unroll
            for (int j = 0; j < 8; ++j) o[j] = gb[j] * (w0[j] * u0[j] + w1[j] * u1[j] + w2[j] * u2[j]);
        } else {
#pragma unroll
            for (int j = 0; j < 8; ++j) o[j] = 0.f;
        }
        *(u32x4*)(CV + (size_t)m * D + c) = pack8(o);
    }
}
__device__ __forceinline__ void phase_final(const Ctx& cx, const bf16_t* XB, const float* ss) {
    const int wave = cx.tid >> 6, lane = cx.tid & 63;
    for (int m = cx.bid * 8 + wave; m < M; m += cx.G * 8) {
        float* dst;
        if (m < MP) { const int b = m / PT, t = m - b * PT; if (t < NMETA) continue; dst = cx.p->out + O_YP + ((size_t)b * PTX + (t - NMETA)) * D; }
        else dst = cx.p->out + O_YS + (size_t)(m - MP) * D;
        const float rs = row_rs(ss, m);
#pragma unroll
        for (int i = 0; i < 4; ++i) {
            const int c = lane * 4 + i * 256;
            const u32x2 xb = *(const u32x2*)(XB + (size_t)m * D + c); const f32x4 g = *(const f32x4*)(cx.p->in[10] + c);
            const f32x4 v = {bf_lo(xb[0]), bf_hi(xb[0]), bf_lo(xb[1]), bf_hi(xb[1])};
            *(f32x4*)(dst + c) = v * rs * g;
        }
    }
}

struct ScanBufs { const bf16_t* R; const bf16_t* K; const bf16_t* V; const bf16_t* LW; const bf16_t* A; bf16_t* YP; bf16_t* YS; float* CB; };
__device__ __forceinline__ void scan_item_info(int item, int& m0, int& T, int& h, int& half, int& sb) {
    if (item < 256) { const int b = item >> 5; h = (item >> 1) & 15; half = item & 1; m0 = b * PT; T = PT; sb = -1 - b; }
    else { const int q = item - 256; sb = q >> 5; h = (q >> 1) & 15; half = q & 1; m0 = MP + sb * STN; T = STN; }
}
__device__ __forceinline__ void phase_scan(LAS float* lds, const Ctx& cx, const ScanBufs B) {
    const int tid = cx.tid, G = cx.G;
    const int nitems = 256 + 4096;
    const bool consumer = tid < 256;
    const int rp = (tid >> 4) & 15, seg = tid & 15;
    const int ptid = tid - 256, tl = ptid >> 3, cs = ptid & 7;
    int ci = cx.bid, ct0 = 0, k = 0;
    f32x2 sA0 = {0.f, 0.f}, sA1 = {0.f, 0.f}, sB0 = {0.f, 0.f}, sB1 = {0.f, 0.f};
    f32x4 pf[4][2]; bool pf_valid = false;
#pragma unroll
    for (int q = 0; q < 4; ++q) { pf[q][0] = (f32x4){0.f, 0.f, 0.f, 0.f}; pf[q][1] = pf[q][0]; }

    auto prep = [&](int pi, int pt0, int buf) __attribute__((always_inline)) {
        LAS float* ob = lds + buf * 11264;
        int item, t;
        if (pi < 256) { item = pi; t = pt0 + tl; } else { item = pi + (tl >> 3) * G; t = tl & 7; }
        if (item < nitems) {
            int pm0, pT, ph, phalf, psb; scan_item_info(item, pm0, pT, ph, phalf, psb);
            if (t < pT) {
                const size_t o = (size_t)(pm0 + t) * D + ph * 64 + cs * 8;
                float kf[8], rf[8], af[8], wf[8];
                ld8b(B.K + o, kf); ld8b(B.R + o, rf); ld8b(B.A + o, af); ld8b(B.LW + o, wf);
                const u32x2 vv = *(const u32x2*)(B.V + (size_t)(pm0 + t) * D + ph * 64 + phalf * 32 + cs * 4);
                float kkc[8], kac[8];
                ld8f(cx.p->in[21] + ph * 64 + cs * 8, kkc); ld8f(cx.p->in[22] + ph * 64 + cs * 8, kac);
                float kk[8]; float n2 = 0.f;
#pragma unroll
                for (int j = 0; j < 8; ++j) { kk[j] = kf[j] * kkc[j]; n2 += kk[j] * kk[j]; }
                n2 = allreduce8(n2);
                const float inv = 1.f / fmaxf(sqrtf(n2), 1e-12f);
                float vd[8], vb[8], vk[8];
#pragma unroll
                for (int j = 0; j < 8; ++j) { kk[j] *= inv; vb[j] = kk[j] * af[j]; vk[j] = kf[j] * (1.f + (af[j] - 1.f) * kac[j]); vd[j] = __expf(wf[j]); }
                if (phalf == 0) {
                    float rkc[8]; ld8f(cx.p->in[23] + ph * 64 + cs * 8, rkc);
                    float cbv = 0.f;
#pragma unroll
                    for (int j = 0; j < 8; ++j) cbv += rf[j] * vk[j] * rkc[j];
                    cbv = allreduce8(cbv);
                    if (cs == 0) B.CB[(size_t)(pm0 + t) * NH + ph] = cbv;
                }
                LAS float* q = ob + tl * 64 + cs * 8;
                *(LAS f32x4*)(q) = (f32x4){vd[0], vd[1], vd[2], vd[3]}; *(LAS f32x4*)(q + 4) = (f32x4){vd[4], vd[5], vd[6], vd[7]};
                *(LAS f32x4*)(q + 2048) = (f32x4){kk[0], kk[1], kk[2], kk[3]}; *(LAS f32x4*)(q + 2048 + 4) = (f32x4){kk[4], kk[5], kk[6], kk[7]};
                *(LAS f32x4*)(q + 4096) = (f32x4){vb[0], vb[1], vb[2], vb[3]}; *(LAS f32x4*)(q + 4096 + 4) = (f32x4){vb[4], vb[5], vb[6], vb[7]};
                *(LAS f32x4*)(q + 6144) = (f32x4){vk[0], vk[1], vk[2], vk[3]}; *(LAS f32x4*)(q + 6144 + 4) = (f32x4){vk[4], vk[5], vk[6], vk[7]};
                *(LAS f32x4*)(q + 8192) = (f32x4){rf[0], rf[1], rf[2], rf[3]}; *(LAS f32x4*)(q + 8192 + 4) = (f32x4){rf[4], rf[5], rf[6], rf[7]};
                *(LAS f32x4*)(ob + 10240 + tl * 32 + cs * 4) = (f32x4){bf_lo(vv[0]), bf_hi(vv[0]), bf_lo(vv[1]), bf_hi(vv[1])};
            }
        }
    };
    auto yout = [&](int pi, int pt0, int ybuf) __attribute__((always_inline)) {
        int item, t;
        if (pi < 256) { item = pi; t = pt0 + tl; } else { item = pi + (tl >> 3) * G; t = tl & 7; }
        if (item < nitems) {
            int pm0, pT, ph, phalf, psb; scan_item_info(item, pm0, pT, ph, phalf, psb);
            if (t < pT) {
                const f32x4 y = *(const LAS f32x4*)(lds + 22528 + ybuf * 1024 + tl * 32 + cs * 4);
                u32x2 pk; pk[0] = cvt_pk_bf16(y[0], y[1]); pk[1] = cvt_pk_bf16(y[2], y[3]);
                bf16_t* yb = (pm0 < MP) ? B.YP + (size_t)pm0 * D : B.YS + (size_t)(pm0 - MP) * D;
                *(u32x2*)(yb + (size_t)t * D + ph * 64 + phalf * 32 + cs * 4) = pk;
            }
        }
    };
    auto run_steps = [&](int slot0, int ns) __attribute__((always_inline)) {
        const LAS float* ob = lds + (k & 1) * 11264 + seg * 4 + slot0 * 64;
        const LAS float* vbp = lds + (k & 1) * 11264 + 10240 + 2 * rp + slot0 * 32;
        LAS float* yb = lds + 22528 + (k & 1) * 1024 + 2 * rp + slot0 * 32;
#define SCAN_LOAD(P, tt) do { const int o_ = (tt) * 64; P##d = *(const LAS f32x4*)(ob + o_); P##kk = *(const LAS f32x4*)(ob + 2048 + o_); P##b = *(const LAS f32x4*)(ob + 4096 + o_); \
            P##k = *(const LAS f32x4*)(ob + 6144 + o_); P##r = *(const LAS f32x4*)(ob + 8192 + o_); P##v = *(const LAS f32x2*)(vbp + (tt) * 32); } while (0)
#define SCAN_STEP(P, q0, q1) do { \
            const f32x2 dl = {P##d[0], P##d[1]}, dh = {P##d[2], P##d[3]}, kkl = {P##kk[0], P##kk[1]}, kkh = {P##kk[2], P##kk[3]}, bl = {P##b[0], P##b[1]}, bh = {P##b[2], P##b[3]}; \
            const f32x2 kl = {P##k[0], P##k[1]}, kh = {P##k[2], P##k[3]}, rl = {P##r[0], P##r[1]}, rh = {P##r[2], P##r[3]}; \
            f32x2 pa = sA0 * kkl; pa = sA1 * kkh + pa; f32x2 pb = sB0 * kkl; pb = sB1 * kkh + pb; \
            float p0 = pa[0] + pa[1], p1 = pb[0] + pb[1]; \
            const f32x2 sdA0 = sA0 * dl + kl * P##v[0], sdA1 = sA1 * dh + kh * P##v[0], sdB0 = sB0 * dl + kl * P##v[1], sdB1 = sB1 * dh + kh * P##v[1]; \
            p0 += dpp_f<0xB1>(p0); p1 += dpp_f<0xB1>(p1); p0 += dpp_f<0x4E>(p0); p1 += dpp_f<0x4E>(p1); p0 += dpp_f<0x124>(p0); p1 += dpp_f<0x124>(p1); p0 += dpp_f<0x128>(p0); p1 += dpp_f<0x128>(p1); \
            sA0 = sdA0 - bl * p0; sA1 = sdA1 - bh * p0; sB0 = sdB0 - bl * p1; sB1 = sdB1 - bh * p1; \
            f32x2 qa = sA0 * rl; qa = sA1 * rh + qa; f32x2 qb = sB0 * rl; qb = sB1 * rh + qb; \
            q0 = qa[0] + qa[1]; q1 = qb[0] + qb[1]; } while (0)
        f32x4 Xd, Xkk, Xb, Xk, Xr, Yd, Ykk, Yb, Yk, Yr, Zd, Zkk, Zb, Zk, Zr, Wd, Wkk, Wb, Wk, Wr; f32x2 Xv, Yv, Zv, Wv;
        const bool l0 = (seg & 1) != 0, l1 = (seg & 2) != 0;
#define SCAN_YRED(a0, a1, a2, a3, tt, ok) do { \
            const float s0 = l0 ? a0 : a1, s1 = l0 ? a2 : a3, k0 = l0 ? a1 : a0, k1 = l0 ? a3 : a2; \
            const float w0 = k0 + dpp_f<0xB1>(s0), w1 = k1 + dpp_f<0xB1>(s1); \
            const float s2 = l1 ? w0 : w1, k2 = l1 ? w1 : w0; \
            float z = k2 + dpp_f<0x4E>(s2); \
            z += dpp_f<0x124>(z); z += dpp_f<0x128>(z); \
            if (seg < 4 && (ok)) yb[((tt) + (seg >> 1)) * 32 + (seg & 1)] = z; } while (0)
        __builtin_amdgcn_s_setprio(3);
        SCAN_LOAD(X, 0); SCAN_LOAD(Y, 1);
        float pv0 = 0.f, pv1 = 0.f, pv2 = 0.f, pv3 = 0.f;
        for (int t = 0; t < ns; t += 4) {
            SCAN_LOAD(Z, t + 2); SCAN_LOAD(W, t + 3);
            __builtin_amdgcn_sched_barrier(0);
            { float v0, v1, v2, v3; SCAN_STEP(X, v0, v1); SCAN_YRED(pv0, pv1, pv2, pv3, t - 2, t > 0); SCAN_STEP(Y, v2, v3); pv0 = v0; pv1 = v1; pv2 = v2; pv3 = v3; }
            __builtin_amdgcn_sched_barrier(0);
            { const int tn = (t + 4 < ns) ? t + 4 : t; SCAN_LOAD(X, tn); SCAN_LOAD(Y, tn + 1); }
            __builtin_amdgcn_sched_barrier(0);
            { float v0, v1, v2, v3; SCAN_STEP(Z, v0, v1); SCAN_YRED(pv0, pv1, pv2, pv3, t, true); SCAN_STEP(W, v2, v3); pv0 = v0; pv1 = v1; pv2 = v2; pv3 = v3; }
            __builtin_amdgcn_sched_barrier(0);
        }
        SCAN_YRED(pv0, pv1, pv2, pv3, ns - 2, true);
        __builtin_amdgcn_s_setprio(0);
#undef SCAN_YRED
#undef SCAN_LOAD
#undef SCAN_STEP
    };
    auto state_ptr = [&](int item, bool out) __attribute__((always_inline)) -> float* {
        int pm0, pT, ph, phalf, psb; scan_item_info(item, pm0, pT, ph, phalf, psb);
        const size_t o = (((size_t)psb * NH + ph) * 64 + phalf * 32 + 2 * rp) * 64 + seg * 4;
        return out ? cx.p->out + O_WKVS + o : const_cast<float*>(cx.p->in[2]) + o;
    };

    if (ci < nitems && !consumer) prep(ci, 0, 0);
    __syncthreads();
    int pci = 0, pct0 = 0; bool have_prev = false;
    while (ci < nitems) {
        int ni, nt0 = 0;
        if (ci < 256) { ni = ci; nt0 = ct0 + 32; if (nt0 >= PT) { ni = ci + G; nt0 = 0; } } else ni = ci + 4 * G;
        if (consumer) {
            const bool next_is_group = (ni >= 256) && (ni < nitems) && (ni != ci);
            if (ci < 256) {
                if (ct0 == 0) { sA0 = (f32x2){0.f, 0.f}; sA1 = sA0; sB0 = sA0; sB1 = sA0; }
                if (next_is_group) {
#pragma unroll
                    for (int q = 0; q < 4; ++q) if (ni + q * G < nitems) { const float* sp = state_ptr(ni + q * G, false); pf[q][0] = *(const f32x4*)sp; pf[q][1] = *(const f32x4*)(sp + 64); }
                    pf_valid = true;
                }
                const int ns = (PT - ct0) < 32 ? (PT - ct0) : 32;
                run_steps(0, ns);
                if (ct0 + 32 >= PT) {
                    int pm0, pT, ph, phalf, psb; scan_item_info(ci, pm0, pT, ph, phalf, psb);
                    float* sp = cx.p->out + O_WKVP + (((size_t)(-1 - psb) * NH + ph) * 64 + phalf * 32 + 2 * rp) * 64 + seg * 4;
                    *(f32x4*)sp = (f32x4){sA0[0], sA0[1], sA1[0], sA1[1]}; *(f32x4*)(sp + 64) = (f32x4){sB0[0], sB0[1], sB1[0], sB1[1]};
                }
            } else {
                f32x4 st[4][2];
#pragma unroll
                for (int q = 0; q < 4; ++q) {
                    if (pf_valid) { st[q][0] = pf[q][0]; st[q][1] = pf[q][1]; }
                    else if (ci + q * G < nitems) { const float* sp = state_ptr(ci + q * G, false); st[q][0] = *(const f32x4*)sp; st[q][1] = *(const f32x4*)(sp + 64); }
                    else { st[q][0] = (f32x4){0.f, 0.f, 0.f, 0.f}; st[q][1] = st[q][0]; }
                }
                pf_valid = false;
                if (next_is_group) {
#pragma unroll
                    for (int q = 0; q < 4; ++q) if (ni + q * G < nitems) { const float* sp = state_ptr(ni + q * G, false); pf[q][0] = *(const f32x4*)sp; pf[q][1] = *(const f32x4*)(sp + 64); }
                    pf_valid = true;
                }
#pragma unroll
                for (int q = 0; q < 4; ++q) {
                    if (ci + q * G < nitems) {
                        sA0 = (f32x2){st[q][0][0], st[q][0][1]}; sA1 = (f32x2){st[q][0][2], st[q][0][3]}; sB0 = (f32x2){st[q][1][0], st[q][1][1]}; sB1 = (f32x2){st[q][1][2], st[q][1][3]};
                        asm volatile("" :: "v"(sA0[0]), "v"(sA1[0]), "v"(sB0[0]), "v"(sB1[0]));
                        run_steps(8 * q, 8);
                        float* sp = state_ptr(ci + q * G, true);
                        *(f32x4*)sp = (f32x4){sA0[0], sA0[1], sA1[0], sA1[1]}; *(f32x4*)(sp + 64) = (f32x4){sB0[0], sB0[1], sB1[0], sB1[1]};
                    }
                }
            }
        } else {
            if (ni < nitems) prep(ni, nt0, (k + 1) & 1);
            if (have_prev) yout(pci, pct0, (k - 1) & 1);
        }
        __syncthreads();
        pci = ci; pct0 = ct0; have_prev = true;
        ci = ni; ct0 = nt0; ++k;
    }
    if (have_prev && !consumer) yout(pci, pct0, (k - 1) & 1);
    __syncthreads();
}

#define XB_TMO      128
#define XB_XCNT(j)  (256  + 64 * (j))
#define XB_XSUB(j)  (1280 + 64 * (j))
#define XB_XGEN(j)  (2304 + 64 * (j))
#define XB_TOP      3328
#define XB_TOPGEN   3392
#define XCD_BAR_WORDS 3456
#define XB_SPIN_CAP (1u << 18)
__device__ __forceinline__ unsigned xb_ld(unsigned* p)              { return __hip_atomic_load(p, __ATOMIC_RELAXED, __HIP_MEMORY_SCOPE_AGENT); }
__device__ __forceinline__ unsigned xb_add(unsigned* p, unsigned v) { return __hip_atomic_fetch_add(p, v, __ATOMIC_RELAXED, __HIP_MEMORY_SCOPE_AGENT); }
__device__ __forceinline__ unsigned xb_xcc_id() { return (unsigned)__builtin_amdgcn_s_getreg((3 << 11) | 20) & 0xFu; }
#define XB_SPIN(cond, bar) do { unsigned _sp = 0; while (cond) { __builtin_amdgcn_s_sleep(1); \
    if ((++_sp & 255u) == 0u) { if (xb_ld(&(bar)[XB_TMO])) break; if (_sp > XB_SPIN_CAP) { atomicAdd(&(bar)[XB_TMO], 1u); break; } } } } while (0)
__device__ __forceinline__ void xcd_barrier_complete(unsigned* bar, unsigned x, unsigned G, unsigned& nloc, unsigned& nx) {
    unsigned sum, cnt, mine, sp = 0u;
    for (;;) {
        sum = 0u; cnt = 0u; mine = 0u;
#pragma unroll
        for (unsigned j = 0; j < 16; ++j) { const unsigned c = xb_ld(&bar[XB_XCNT(j)]); sum += c; cnt += (c > 0u) ? 1u : 0u; mine = (j == x) ? c : mine; }
        if (sum == G) break;
        __builtin_amdgcn_s_sleep(1);
        if ((++sp & 255u) == 0u) { if (xb_ld(&bar[XB_TMO])) break; if (sp > XB_SPIN_CAP) { atomicAdd(&bar[XB_TMO], 1u); break; } }
    }
    nloc = mine > 0u ? mine : 1u; nx = cnt > 0u ? cnt : 1u;
}
__device__ __forceinline__ void xcd_barrier(unsigned* bar, volatile LAS unsigned* st, int tid, unsigned G) {
    asm volatile("s_waitcnt vmcnt(0)" ::: "memory");
    __syncthreads();
    if (tid == 0) {
        const unsigned x = xb_xcc_id();
        __builtin_amdgcn_s_waitcnt(0);
        unsigned nloc = st[0], nx = st[1];
        if (nloc == 0u) { xcd_barrier_complete(bar, x, G, nloc, nx); st[0] = nloc; st[1] = nx; }
        const unsigned old = xb_add(&bar[XB_XSUB(x)], 1u);
        const unsigned gen = old / nloc;
        if (old + 1u == (gen + 1u) * nloc) {
            __builtin_amdgcn_fence(__ATOMIC_RELEASE, "agent");
            asm volatile("s_waitcnt vmcnt(0)" ::: "memory");
            const unsigned og = xb_add(&bar[XB_TOP], 1u);
            const unsigned tg = og / nx;
            if (og + 1u == (tg + 1u) * nx) xb_add(&bar[XB_TOPGEN], 1u);
            else XB_SPIN(xb_ld(&bar[XB_TOPGEN]) == tg, bar);
            __builtin_amdgcn_fence(__ATOMIC_ACQUIRE, "agent");
            xb_add(&bar[XB_XGEN(x)], 1u);
            asm volatile("s_waitcnt vmcnt(0)" ::: "memory");
        } else {
            XB_SPIN(xb_ld(&bar[XB_XGEN(x)]) == gen, bar);
            __builtin_amdgcn_fence(__ATOMIC_ACQUIRE, "agent");
            asm volatile("s_waitcnt vmcnt(0)" ::: "memory");
        }
    }
    __syncthreads();
}

#define X_ ((float*)(ws + WS_X))
#define SS_(i) ((float*)(ws + WS_SS))
#define XB_ ((bf16_t*)(ws + WS_X))
__global__ void __launch_bounds__(NTHREADS, 2) mega(Params p) {
    extern __shared__ __attribute__((aligned(16))) unsigned char shm[];
    LAS unsigned char* lds = (LAS unsigned char*)shm;
    LAS float* ldsf = (LAS float*)shm;
    volatile LAS unsigned* bst = (volatile LAS unsigned*)(shm + 131072);
    if (threadIdx.x == 0) { bst[0] = 0u; bst[1] = 0u; (void)xb_add((unsigned*)(p.ws + WS_BAR) + XB_XCNT(xb_xcc_id()), 1u); }
    __syncthreads();
    const int wv_ = __builtin_amdgcn_readfirstlane(threadIdx.x >> 6);
    for (int ph = 0; ph < 19; ++ph) {
#ifdef REP_MASK
        for (int rep = 0; rep < 1 + ((REP_MASK >> ph) & 1); ++rep) {
#else
        { const int rep = 0;
#endif
        Ctx cx;
        { KP kp = (KP)__builtin_amdgcn_kernarg_segment_ptr(); int t_ = wv_ * 64 + (int)__builtin_amdgcn_mbcnt_hi(~0u, __builtin_amdgcn_mbcnt_lo(~0u, 0u)), b_ = blockIdx.x, g_ = gridDim.x;
          asm volatile("" : "+s"(kp), "+v"(t_), "+s"(b_), "+s"(g_));
          cx.p = kp; cx.tid = t_; cx.bid = b_; cx.G = g_; }
        unsigned char* ws = cx.p->ws;
        unsigned char* dob = (unsigned char*)cx.p->out;
        const int G = cx.G, c = cx.bid;
        int kind, f = 0;
        switch (ph) {
            case 0: kind = 0; break;
            case 1: kind = 1; f = 0; break;  case 2: kind = 2; f = 0; break;
            case 3: kind = 3; break; case 4: kind = 4; break; case 5: kind = 5; break; case 6: kind = 6; break; case 7: kind = 7; break;
            case 8: kind = 2; f = 4; break;
            case 9: kind = 1; f = 1; break;  case 10: kind = 2; f = 1; break;
            case 11: kind = 1; f = 2; break; case 12: kind = 2; f = 2; break;
            case 13: kind = 8; break; case 14: kind = 9; break;
            case 15: kind = 2; f = 5; break;
            case 16: kind = 1; f = 3; break; case 17: kind = 2; f = 3; break;
            default: kind = 10; break;
        }
        if (kind == 0) {
            phase_x0(cx, XB_, SS_(0));
            convert(ldsf, cx, T_GU, 0, (bf16_t*)(ws + WS_SLOTA), c, G);
            convert(ldsf, cx, T_DN, 0, (bf16_t*)(ws + WS_SLOTA + SZ_GU), c, G);
            if (G != 256) {
                convert(ldsf, cx, T_RKV, 0, (bf16_t*)(ws + WS_WRKV), c, G);
                convert(ldsf, cx, T_L2, 0, (bf16_t*)(ws + WS_WL2), c, G);
                convert(ldsf, cx, T_PLAIN, 26, (bf16_t*)(ws + WS_WO), c, G);
            }
        } else if (kind == 1) {
            const int ssi = f == 0 ? 0 : (f == 1 ? 2 : (f == 2 ? 3 : 5));
            const unsigned char* slot = ws + ((f & 1) ? WS_SLOTB : WS_SLOTA);
            pg8::Gemm g; g.A = XB_; g.Bt = (const bf16_t*)slot; g.K = D;
            pg8::StaticOrder S; S.init(MPAD / 256, 22, G, c, g.K);
            EpiGU E; E.ss = SS_(ssi); E.act = (bf16_t*)(ws + B_ACT);
            pg8::gemm_phase(lds, g, S, E, cx.tid);
        } else if (kind == 2) {
            pg8::Gemm g; EpiRes E; E.XB = XB_;
            if (f < 4) { g.A = (const bf16_t*)(ws + B_ACT); g.Bt = (const bf16_t*)(ws + ((f & 1) ? WS_SLOTB : WS_SLOTA) + SZ_GU); g.K = FF; E.scale = 0.5f;
                         E.ssout = SS_(f == 0 ? 1 : (f == 1 ? 3 : (f == 2 ? 4 : 6))); }
            else if (f == 4) { g.A = (const bf16_t*)(ws + B_O); g.Bt = (const bf16_t*)(ws + WS_WO); g.K = D; E.scale = 1.f; E.ssout = SS_(2); }
            else { g.A = (const bf16_t*)(ws + B_CV); g.Bt = (const bf16_t*)(ws + WS_WOUT); g.K = D; E.scale = 1.f; E.ssout = SS_(5); }
            if (rep) E.scale = 0.f;
            if (f < 4 && G == 256) {
                f32x4* slab = (f32x4*)(ws + WS_BIG + SZ_ACT);
                pg8::SplitOrder S; S.init(MPAD / 256, 4, G, c, g.K);
                pg8::gemm_phase(lds, g, S, E, cx.tid, slab);
                if (rep == 0 && f == 0 && c >= 140) {
                    convert(ldsf, cx, T_RKV, 0, (bf16_t*)(ws + WS_WRKV), c - 140, G - 140);
                    convert(ldsf, cx, T_L2, 0, (bf16_t*)(ws + WS_WL2), c - 140, G - 140);
                    convert(ldsf, cx, T_PLAIN, 26, (bf16_t*)(ws + WS_WO), c - 140, G - 140);
                }
                xcd_barrier((unsigned*)(ws + WS_BAR), bst, cx.tid, (unsigned)G);
                if (c < 160) {
                    const int lt = c >> 3;
                    pg8::Unit u; S.tile(256 + lt, u);
                    int t_ = cx.tid; asm volatile("" : "+v"(t_));
                    const int wid = t_ >> 6, lane = t_ & 63, wr = wid >> 2, wc = wid & 3, fr = lane & 15, fq = lane >> 4;
                    const f32x4* sp = slab + (size_t)(lt * 7) * 32 * 512 + t_;
                    const int row0 = u.pm * 256 + wr * 64 + fr, col0 = u.pn * 256 + wc * 32 + 8 * fq;
                    {
                        const int am = c & 7;
                        const int ai = am >> 2, m = am & 3, r = row0 + ai * 128 + m * 16;
                        f32x4 a[2][2];
#pragma unroll
                        for (int bj = 0; bj < 2; ++bj)
#pragma unroll
                            for (int n = 0; n < 2; ++n) {
                                const int idx = ((ai * 2 + bj) * 4 + m) * 2 + n;
                                f32x4 t = sp[(size_t)idx * 512];
#pragma unroll
                                for (int part = 1; part < 7; ++part) t += sp[(size_t)(part * 32 + idx) * 512];
                                a[bj][n] = t;
                            }
                        float ssum = 0.f;
#pragma unroll
                        for (int bj = 0; bj < 2; ++bj) {
                            bf16_t* xp = E.XB + (size_t)r * D + col0 + bj * 128;
                            float o[8]; unpack8(*(const u32x4*)xp, o);
#pragma unroll
                            for (int jj = 0; jj < 4; ++jj) { o[jj] += a[bj][0][jj] * E.scale; o[4 + jj] += a[bj][1][jj] * E.scale; }
                            *(u32x4*)xp = pack8(o);
#pragma unroll
                            for (int jj = 0; jj < 8; ++jj) ssum += o[jj] * o[jj];
                        }
                        ssum += __shfl_xor(ssum, 16); ssum += __shfl_xor(ssum, 32);
                        if (fq == 0) E.ssout[(size_t)r * 16 + u.pn * 4 + wc] = ssum;
                    }
                }
            } else {
            pg8::StaticOrder S; S.init(MPAD / 256, 4, G, c, g.K);
            pg8::gemm_phase(lds, g, S, E, cx.tid);
            if (rep == 0) {
            const int nbusy = (MPAD / 256) * 4 - G;
            if (G > 2 * nbusy && nbusy >= 0) {
                if (c >= nbusy) {
                    const int wg = c - nbusy, nwg = G - nbusy;
                    if (f == 4) {
                        convert(ldsf, cx, T_GU, 1, (bf16_t*)(ws + WS_SLOTB), wg, nwg);
                        convert(ldsf, cx, T_DN, 1, (bf16_t*)(ws + WS_SLOTB + SZ_GU), wg, nwg);
                        convert(ldsf, cx, T_GU, 2, (bf16_t*)(ws + WS_SLOTA), wg, nwg);
                        convert(ldsf, cx, T_DN, 2, (bf16_t*)(ws + WS_SLOTA + SZ_GU), wg, nwg);
                        convert(ldsf, cx, T_WIN, 0, (bf16_t*)(ws + WS_WIN), wg, nwg);
                        convert(ldsf, cx, T_PLAIN, 29, (bf16_t*)(ws + WS_WOUT), wg, nwg);
                    } else if (f == 2 || (f == 5 && G == 256)) {
                        convert(ldsf, cx, T_GU, 3, (bf16_t*)(ws + WS_SLOTB), wg, nwg);
                        convert(ldsf, cx, T_DN, 3, (bf16_t*)(ws + WS_SLOTB + SZ_GU), wg, nwg);
                    }
                }
            } else {
                if (f == 4) {
                    convert(ldsf, cx, T_GU, 1, (bf16_t*)(ws + WS_SLOTB), c, G);
                    convert(ldsf, cx, T_DN, 1, (bf16_t*)(ws + WS_SLOTB + SZ_GU), c, G);
                    convert(ldsf, cx, T_GU, 2, (bf16_t*)(ws + WS_SLOTA), c, G);
                    convert(ldsf, cx, T_DN, 2, (bf16_t*)(ws + WS_SLOTA + SZ_GU), c, G);
                    convert(ldsf, cx, T_WIN, 0, (bf16_t*)(ws + WS_WIN), c, G);
                    convert(ldsf, cx, T_PLAIN, 29, (bf16_t*)(ws + WS_WOUT), c, G);
                } else if (f == 2) {
                    convert(ldsf, cx, T_GU, 3, (bf16_t*)(ws + WS_SLOTB), c, G);
                    convert(ldsf, cx, T_DN, 3, (bf16_t*)(ws + WS_SLOTB + SZ_GU), c, G);
                }
            }
            }
            }
        } else if (kind == 3) {
            phase_mix(cx, XB_, SS_(1), (bf16_t*)(ws + B_HH));
        } else if (kind == 4) {
            pg8::Gemm g; g.A = (const bf16_t*)(ws + B_HH); g.Bt = (const bf16_t*)(ws + WS_WRKV); g.K = 2048;
            pg8::StaticOrder S; S.init(MPAD / 256, 14, G, c, g.K);
            EpiRKV E; E.ws = ws; E.dob = dob;
            pg8::gemm_phase(lds, g, S, E, cx.tid);
        } else if (kind == 5) {
            pg8::Gemm g; g.A = (const bf16_t*)(dob + DO_L1); g.Bt = (const bf16_t*)(ws + WS_WL2); g.K = 384;
            pg8::L2Order S; S.init(MPAD / 256, 12, G, c, g.K);
            EpiL2 E; E.ws = ws; E.w0 = cx.p->in[13]; E.a0 = cx.p->in[16];
            pg8::gemm_phase(lds, g, S, E, cx.tid);
        } else if (kind == 6) {
            ScanBufs sbf; sbf.R = (const bf16_t*)(ws + B_R); sbf.K = (const bf16_t*)(ws + B_K); sbf.V = (const bf16_t*)(dob + DO_XB); sbf.LW = (const bf16_t*)(ws + B_LW);
            sbf.A = (const bf16_t*)(ws + B_A); sbf.YP = (bf16_t*)(dob + DO_YPR); sbf.YS = (bf16_t*)(ws + L_YS); sbf.CB = (float*)(ws + WS_X + ROWB);
            phase_scan(ldsf, cx, sbf);
        } else if (kind == 7) {
            phase_post(cx, (const bf16_t*)(dob + DO_YPR), (const bf16_t*)(ws + L_YS), (const float*)(ws + WS_X + ROWB), (const bf16_t*)(dob + DO_XB),
                       (const bf16_t*)(ws + L_G), (bf16_t*)(ws + B_O));
        } else if (kind == 8) {
            pg8::Gemm g; g.A = XB_; g.Bt = (const bf16_t*)(ws + WS_WIN); g.K = D;
            pg8::StaticOrder S; S.init(MPAD / 256, 12, G, c, g.K);
            EpiCI E; E.ss = SS_(4); E.U = (bf16_t*)(ws + B_U); E.GB = (bf16_t*)(ws + B_GB); E.out = cx.p->out;
            pg8::gemm_phase(lds, g, S, E, cx.tid);
        } else if (kind == 9) {
            phase_conv(cx, (const bf16_t*)(ws + B_U), (const bf16_t*)(ws + B_GB), (bf16_t*)(ws + B_CV));
        } else {
            phase_final(cx, XB_, SS_(6));
        }
        if (ph < 18) xcd_barrier((unsigned*)(ws + WS_BAR), bst, cx.tid, (unsigned)G);
        }
    }
}

extern "C" void kernel_launch(void* const* d_in, const int* in_sizes, int n_in, void* d_out, int out_size, void* d_ws, size_t ws_size, hipStream_t stream) {
    static int grid_blocks = 0;
    if (grid_blocks == 0) {
        if (n_in != 30 || (size_t)out_size != O_END || ws_size < WS_END) {
            fprintf(stderr, "kernel_launch: unexpected shapes: n_in %d out_size %d ws_size %zu (need %zu)\n", n_in, out_size, ws_size, (size_t)WS_END);
            grid_blocks = -1; return;
        }
        int dev = 0, cus = 0, per_cu = 0;
        (void)hipGetDevice(&dev);
        (void)hipDeviceGetAttribute(&cus, hipDeviceAttributeMultiprocessorCount, dev);
        (void)hipFuncSetAttribute((const void*)mega, hipFuncAttributeMaxDynamicSharedMemorySize, LDS_BYTES);
        (void)hipOccupancyMaxActiveBlocksPerMultiprocessor(&per_cu, (const void*)mega, NTHREADS, LDS_BYTES);
        if (per_cu < 1) per_cu = 1;
        grid_blocks = cus * per_cu;
        if (grid_blocks > 256) grid_blocks = 256;
    }
    if (grid_blocks < 0) return;
    (void)hipMemsetAsync((char*)d_ws, 0, WS_CTL_END, stream);
    Params p{};
    for (int i = 0; i < 30; ++i) p.in[i] = (const float*)d_in[i];
    p.out = (float*)d_out; p.ws = (unsigned char*)d_ws;
    void* args[] = {&p};
    hipError_t e = hipLaunchCooperativeKernel((const void*)mega, dim3(grid_blocks), dim3(NTHREADS), args, LDS_BYTES, stream);
    if (e != hipSuccess) fprintf(stderr, "cooperative launch failed: %s (grid %d)\n", hipGetErrorString(e), grid_blocks);
}
```

```cpp
#include <hip/hip_runtime.h>
#include <hip/hip_cooperative_groups.h>
#include <cstdio>
#include <cstdint>
namespace cg = cooperative_groups;

#define LAS __attribute__((address_space(3)))
typedef unsigned short bf16_t;
typedef short bf16x8 __attribute__((ext_vector_type(8)));
typedef float f32x4 __attribute__((ext_vector_type(4)));
typedef float f32x2 __attribute__((ext_vector_type(2)));
typedef unsigned u32x4 __attribute__((ext_vector_type(4)));
typedef unsigned u32x2 __attribute__((ext_vector_type(2)));

constexpr int D = 1024, FF = 2816, NH = 16;
constexpr int PB = 8, PT = 2064, NMETA = 16, PTX = 2048, SBN = 128, STN = 8;
constexpr int MP = PB * PT;
constexpr int MS = SBN * STN;
constexpr int M = MP + MS;
constexpr int MPAD = 17664;
constexpr int NTHREADS = 512;
constexpr int LDS_BYTES = 131072 + 16;

constexpr size_t O_YP = 0;
constexpr size_t O_YS = O_YP + (size_t)PB * PTX * D;
constexpr size_t O_WKVP = O_YS + (size_t)MS * D;
constexpr size_t O_SHP = O_WKVP + (size_t)PB * NH * 64 * 64;
constexpr size_t O_CVP = O_SHP + (size_t)PB * D;
constexpr size_t O_WKVS = O_CVP + (size_t)PB * 2 * D;
constexpr size_t O_SHS = O_WKVS + (size_t)SBN * NH * 64 * 64;
constexpr size_t O_CVS = O_SHS + (size_t)SBN * D;
constexpr size_t O_END = O_CVS + (size_t)SBN * 2 * D;

constexpr size_t AL(size_t x) { return (x + 255) & ~(size_t)255; }
constexpr size_t ROWB = (size_t)MPAD * D * 2;
constexpr size_t WS_BAR = 0;
constexpr size_t WS_CTL_END = 16384;
constexpr size_t WS_SS = 16384;
constexpr size_t WS_SS_END = AL(WS_SS + (size_t)MPAD * 16 * 4);
constexpr size_t WS_X = WS_SS_END;
constexpr size_t WS_MISC = AL(WS_X + (size_t)MPAD * D * 4);
constexpr size_t SZ_WRKV = (size_t)3584 * 2048 * 2;
constexpr size_t SZ_WL2 = (size_t)3072 * 384 * 2;
constexpr size_t SZ_W1K = (size_t)1024 * 1024 * 2;
constexpr size_t WS_WRKV = WS_MISC;
constexpr size_t WS_WL2 = AL(WS_WRKV + SZ_WRKV);
constexpr size_t WS_WO = AL(WS_WL2 + SZ_WL2);
constexpr size_t WS_BIG = AL(WS_WO + SZ_W1K);
constexpr size_t SZ_BIG = (size_t)MPAD * 2048 * 2 * 2 + 4096;
constexpr size_t WS_LAZY = AL(WS_BIG + SZ_BIG);
constexpr size_t SZ_GU = (size_t)5632 * 1024 * 2;
constexpr size_t SZ_DN = (size_t)1024 * 2816 * 2;
constexpr size_t SZ_SLOT = SZ_GU + SZ_DN;
constexpr size_t WS_SLOTA = WS_LAZY;
constexpr size_t WS_SLOTB = WS_SLOTA + SZ_SLOT;
constexpr size_t WS_WIN = WS_SLOTB + SZ_SLOT;
constexpr size_t WS_WOUT = WS_WIN + (size_t)3072 * 1024 * 2;
constexpr size_t WS_END = WS_WOUT + SZ_W1K;
constexpr size_t B_ACT = WS_BIG;
constexpr size_t B_HH = WS_BIG;
constexpr size_t B_R = WS_BIG + 2 * ROWB;
constexpr size_t B_K = WS_BIG + 3 * ROWB;
constexpr size_t B_LW = WS_BIG;
constexpr size_t B_A = WS_BIG + ROWB;
constexpr size_t B_O = WS_BIG;
constexpr size_t B_U = WS_BIG;
constexpr size_t B_GB = WS_BIG + ROWB;
constexpr size_t B_CV = WS_BIG + 2 * ROWB;
constexpr size_t DO_XB = 0;
constexpr size_t DO_L1 = ROWB;
constexpr size_t DO_YPR = ROWB;
static_assert(DO_YPR + (size_t)MP * D * 2 <= O_WKVP * 4, "y-region overflow");
static_assert(DO_L1 + (size_t)MPAD * 384 * 2 <= O_WKVP * 4, "l1 overflow");
constexpr size_t L_G = WS_LAZY;
constexpr size_t L_YS = WS_LAZY + ROWB;
static_assert(L_YS + (size_t)MS * D * 2 <= WS_END, "lazy overflow");
constexpr size_t SZ_ACT = (size_t)MPAD * 2816 * 2;
static_assert(SZ_BIG >= SZ_ACT + (size_t)140 * 32 * 512 * 16, "ACT + split-K slab do not fit");

struct Params {
    const float* in[30];
    float* out;
    unsigned char* ws;
};
typedef const __attribute__((address_space(4))) Params* KP;
struct Ctx { KP p; int tid, bid, G; };

__device__ __forceinline__ unsigned cvt_pk_bf16(float lo, float hi) { unsigned r; asm volatile("v_cvt_pk_bf16_f32 %0, %1, %2" : "=v"(r) : "v"(lo), "v"(hi)); return r; }
__device__ __forceinline__ float bf_lo(unsigned v) { return __uint_as_float(v << 16); }
__device__ __forceinline__ float bf_hi(unsigned v) { return __uint_as_float(v & 0xffff0000u); }
__device__ __forceinline__ float frcp(float x) { return __builtin_amdgcn_rcpf(x); }
__device__ __forceinline__ float fsigmoid(float x) { return frcp(1.f + __expf(-x)); }
__device__ __forceinline__ void unpack8(u32x4 v, float* o) {
    o[0] = bf_lo(v[0]); o[1] = bf_hi(v[0]); o[2] = bf_lo(v[1]); o[3] = bf_hi(v[1]);
    o[4] = bf_lo(v[2]); o[5] = bf_hi(v[2]); o[6] = bf_lo(v[3]); o[7] = bf_hi(v[3]);
}
__device__ __forceinline__ u32x4 pack8(const float* o) {
    u32x4 r; r[0] = cvt_pk_bf16(o[0], o[1]); r[1] = cvt_pk_bf16(o[2], o[3]); r[2] = cvt_pk_bf16(o[4], o[5]); r[3] = cvt_pk_bf16(o[6], o[7]); return r;
}
template <int CTRL> __device__ __forceinline__ float dpp_f(float x) {
    return __int_as_float(__builtin_amdgcn_update_dpp(0, __float_as_int(x), CTRL, 0xF, 0xF, false));
}
__device__ __forceinline__ float allreduce16(float p) {
    p += dpp_f<0xB1>(p); p += dpp_f<0x4E>(p); p += dpp_f<0x124>(p); p += dpp_f<0x128>(p); return p;
}
__device__ __forceinline__ float allreduce8(float p) {
    p += dpp_f<0xB1>(p); p += dpp_f<0x4E>(p); p += __shfl_xor(p, 4); return p;
}
__device__ __forceinline__ float wave_sum(float p) {
#pragma unroll
    for (int o = 32; o >= 1; o >>= 1) p += __shfl_xor(p, o);
    return p;
}
__device__ __forceinline__ float row_rs(const float* ssp, int r) {
    const f32x4 a = *(const f32x4*)(ssp + (size_t)r * 16), b = *(const f32x4*)(ssp + (size_t)r * 16 + 4), c = *(const f32x4*)(ssp + (size_t)r * 16 + 8), d = *(const f32x4*)(ssp + (size_t)r * 16 + 12);
    const float s = ((a[0] + a[1]) + (a[2] + a[3])) + ((b[0] + b[1]) + (b[2] + b[3])) + ((c[0] + c[1]) + (c[2] + c[3])) + ((d[0] + d[1]) + (d[2] + d[3]));
    return rsqrtf(s * (1.f / 1024.f) + 1e-6f);
}
__device__ __forceinline__ void row_info(int m, int& t, int& T, int& seq) {
    if (m < MP) { seq = m / PT; t = m - seq * PT; T = PT; }
    else { const int q = m - MP; seq = 8 + (q >> 3); t = q & 7; T = STN; }
}

namespace pg8 {
constexpr int BM = 256, BK = 64, HALF = 128, HTB = HALF * BK * 2, STAGE_BYTES = 8 * HTB, NXCD = 8, WGM = 4;
__host__ __device__ __forceinline__ int lds_byte(int r, int c) { const int st = (r >> 4) * 2 + (c >> 5), rr = r & 15, cc = c & 31, ob = rr * 64 + cc * 2; return st * 1024 + (ob ^ (((ob >> 9) & 1) << 5)); }
__host__ __device__ __forceinline__ void stage_rc(int b, int& R, int& C) { const int st = b / 1024, sb = b % 1024, swz = sb ^ (((sb >> 9) & 1) << 5); R = (st >> 1) * 16 + swz / 64; C = (st & 1) * 32 + (swz % 64) / 2; }
__host__ __device__ __forceinline__ int perm32(int rho) { const int n = rho >> 4, i = rho & 15; return 8 * (i >> 2) + 4 * n + (i & 3); }

struct Unit { int pm, pn, k0, nt, sub; };
struct Gemm { const bf16_t* A; const bf16_t* Bt; int K; };
struct StaticOrder {
    int nM, nN, nwg, G, c;
    int ntK; int wgm;
    __device__ __forceinline__ void init(int nM_, int nN_, int G_, int c_, int K_) { nM = nM_; nN = nN_; nwg = nM * nN; G = G_; c = c_; ntK = K_ / BK; wgm = (nN_ == 22) ? 8 : 4; }
    __device__ __forceinline__ void tile(int L, Unit& u) const {
        int wgid = L; { const int q = nwg / NXCD, r = nwg % NXCD, xcd = wgid % NXCD, off = wgid / NXCD; wgid = (xcd < r ? xcd * (q + 1) : r * (q + 1) + (xcd - r) * q) + off; }
        const int nig = wgm * nN, gid = wgid / nig, fm = gid * wgm, gsz = (nM - fm) < wgm ? (nM - fm) : wgm;
        u.pm = fm + ((wgid % nig) % gsz); u.pn = (wgid % nig) / gsz; u.k0 = 0; u.nt = ntK; u.sub = -1;
    }
    __device__ __forceinline__ bool next(int i, Unit& u) const {
        const long L = (long)i * G + c; if (L >= nwg) return false;
        u.k0 = 0; u.nt = ntK; u.sub = -1;
        int wgid = (int)L; { const int q = nwg / NXCD, r = nwg % NXCD, xcd = wgid % NXCD, off = wgid / NXCD; wgid = (xcd < r ? xcd * (q + 1) : r * (q + 1) + (xcd - r) * q) + off; }
        const int nig = wgm * nN, gid = wgid / nig, fm = gid * wgm, gsz = (nM - fm) < wgm ? (nM - fm) : wgm;
        u.pm = fm + ((wgid % nig) % gsz); u.pn = (wgid % nig) / gsz; return true;
    }
};

struct SplitOrder : StaticOrder {
    __device__ __forceinline__ bool next(int i, Unit& u) const {
        if (i == 0) { tile(c, u); return true; }
        if (i == 1 && c < 140) { tile(256 + c / 7, u); const int part = c % 7; u.k0 = part * 6; u.nt = part == 6 ? 8 : 6; u.sub = c; return true; }
        return false;
    }
};
struct L2Order : StaticOrder {
    __device__ __forceinline__ bool next(int i, Unit& u) const {
        if (!StaticOrder::next(i, u)) return false;
        if (u.pn < 8) { u.k0 = 0; u.nt = 2; } else { u.k0 = 2; u.nt = 4; }
        return true;
    }
};
template <class Epi, class Sched>
__device__ __forceinline__ void gemm_phase(LAS unsigned char* lds, const Gemm g, const Sched& S, const Epi& E, const int tid_, f32x4* slab = nullptr) {
    const int tid = tid_, wid = __builtin_amdgcn_readfirstlane(tid >> 6), lane = tid & 63, wr = wid >> 2, wc = wid & 3, fr = lane & 15, fq = lane >> 4;
    const int K = g.K;
    unsigned voffA[2], voffB[2];
#pragma unroll
    for (int i = 0; i < 2; ++i) { int R, C; stage_rc(tid * 16 + i * 8192, R, C); const int Rb = (R & ~31) + perm32(R & 31);
        voffA[i] = (unsigned)(R * K + C) * 2u; voffB[i] = (unsigned)(Rb * K + C) * 2u; }
    const size_t kstep = (size_t)(BK * 2);
    const size_t hstep = (size_t)HALF * K * 2;
    const size_t tstep = 2 * hstep;
    const unsigned ldsw = (unsigned)wid * 1024u;
    const int aoff = lds_byte(wr * 64 + fr, fq * 8), boff = lds_byte(wc * 32 + fr, fq * 8);
#define PG8_SA(b, h) (((b) * 2 + (h)) * HTB)
#define PG8_SB(b, h) ((4 + (b) * 2 + (h)) * HTB)
#define PG8_STAGE(bufoff, gbase, voff) do { _Pragma("unroll") for (int _i = 0; _i < 2; ++_i) \
        __builtin_amdgcn_global_load_lds((const unsigned*)((const char*)(gbase) + (voff)[_i]), (LAS unsigned*)(lds + (bufoff) + ldsw + _i * 8192), 16, 0, 0); } while (0)
#define PG8_LDA(dst, b, h) do { _Pragma("unroll") for (int m = 0; m < 4; ++m) _Pragma("unroll") for (int k = 0; k < 2; ++k) dst[m][k] = *(const LAS bf16x8*)(lds + PG8_SA(b, h) + aoff + m * 2048 + k * 1024); } while (0)
#define PG8_LDB(dst, b, h) do { _Pragma("unroll") for (int n = 0; n < 2; ++n) _Pragma("unroll") for (int k = 0; k < 2; ++k) dst[n][k] = *(const LAS bf16x8*)(lds + PG8_SB(b, h) + boff + n * 2048 + k * 1024); } while (0)
#define PG8_MMA(ai, bj, At, Bt) do { __builtin_amdgcn_s_setprio(1); _Pragma("unroll") for (int m = 0; m < 4; ++m) _Pragma("unroll") for (int n = 0; n < 2; ++n) _Pragma("unroll") for (int k = 0; k < 2; ++k) \
        acc[ai][bj][m][n] = __builtin_amdgcn_mfma_f32_16x16x32_bf16(Bt[n][k], At[m][k], acc[ai][bj][m][n], 0, 0, 0); __builtin_amdgcn_s_setprio(0); } while (0)
#define PG8_WAIT_V(n) asm volatile("s_waitcnt vmcnt(" #n ")" ::: "memory")
#define PG8_WAIT_L(n) asm volatile("s_waitcnt lgkmcnt(" #n ")" ::: "memory")
#define PG8_BAR __builtin_amdgcn_s_barrier()
#define PG8_SCHED __builtin_amdgcn_sched_barrier(0)
    Unit cur, nxt; int ui = 0;
    if (!S.next(0, cur)) return;
    f32x4 acc[2][2][4][2];
#pragma unroll
    for (int a = 0; a < 2; ++a)
#pragma unroll
        for (int b = 0; b < 2; ++b)
#pragma unroll
            for (int m = 0; m < 4; ++m)
#pragma unroll
                for (int n = 0; n < 2; ++n) acc[a][b][m][n] = (f32x4){0.f, 0.f, 0.f, 0.f};
    bf16x8 At[4][2], B0[2][2], B1[2][2];
    const char* cA = (const char*)g.A + (size_t)cur.pm * tstep + (size_t)cur.k0 * kstep; const char* cB = (const char*)g.Bt + (size_t)cur.pn * tstep + (size_t)cur.k0 * kstep;
    PG8_STAGE(PG8_SB(0, 0), cB, voffB); PG8_STAGE(PG8_SA(0, 0), cA, voffA); PG8_STAGE(PG8_SB(0, 1), cB + hstep, voffB); PG8_STAGE(PG8_SA(0, 1), cA + hstep, voffA);
    if (wr == 1) PG8_BAR;
    PG8_WAIT_V(4); PG8_BAR;
    PG8_STAGE(PG8_SB(1, 0), cB + kstep, voffB); PG8_STAGE(PG8_SA(1, 0), cA + kstep, voffA); PG8_STAGE(PG8_SB(1, 1), cB + hstep + kstep, voffB);
    PG8_WAIT_V(6); PG8_BAR;
    for (;;) {
        const bool has_next = S.next(ui + 1, nxt);
        const char* nA = has_next ? (const char*)g.A + (size_t)nxt.pm * tstep + (size_t)nxt.k0 * kstep : cA; const char* nB = has_next ? (const char*)g.Bt + (size_t)nxt.pn * tstep + (size_t)nxt.k0 * kstep : cB;
        const int nt = cur.nt;
        for (int t = 0; t < nt; t += 2) {
            const bool last = (t == nt - 2);
            const char* a1 = cA + (size_t)(t + 1) * kstep;
            const char* a2 = last ? nA : cA + (size_t)(t + 2) * kstep; const char* b2 = last ? nB : cB + (size_t)(t + 2) * kstep;
            const char* a3 = a2 + kstep; const char* b3 = b2 + kstep;
            PG8_LDB(B0, 0, 0); PG8_SCHED; PG8_LDA(At, 0, 0); PG8_STAGE(PG8_SA(1, 1), a1 + hstep, voffA);
            PG8_WAIT_L(8); PG8_BAR; PG8_WAIT_L(0); PG8_MMA(0, 0, At, B0); PG8_BAR; PG8_SCHED;
            PG8_LDB(B1, 0, 1); PG8_STAGE(PG8_SB(0, 0), b2, voffB);
            PG8_BAR; PG8_WAIT_L(0); PG8_MMA(0, 1, At, B1); PG8_BAR;
            PG8_LDA(At, 0, 1); PG8_STAGE(PG8_SA(0, 0), a2, voffA);
            PG8_BAR; PG8_WAIT_L(0); PG8_MMA(1, 0, At, B0); PG8_BAR; PG8_SCHED;
            PG8_STAGE(PG8_SB(0, 1), b2 + hstep, voffB);
            PG8_WAIT_V(6); PG8_BAR; PG8_MMA(1, 1, At, B1); PG8_BAR;
            PG8_LDB(B0, 1, 0); PG8_SCHED; PG8_LDA(At, 1, 0); PG8_STAGE(PG8_SA(0, 1), a2 + hstep, voffA);
            PG8_WAIT_L(8); PG8_BAR; PG8_WAIT_L(0); PG8_MMA(0, 0, At, B0); PG8_BAR; PG8_SCHED;
            PG8_LDB(B1, 1, 1); PG8_STAGE(PG8_SB(1, 0), b3, voffB);
            PG8_BAR; PG8_WAIT_L(0); PG8_MMA(0, 1, At, B1); PG8_BAR;
            PG8_LDA(At, 1, 1); PG8_STAGE(PG8_SA(1, 0), a3, voffA);
            PG8_BAR; PG8_WAIT_L(0); PG8_MMA(1, 0, At, B0); PG8_BAR; PG8_SCHED;
            PG8_STAGE(PG8_SB(1, 1), b3 + hstep, voffB);
            PG8_WAIT_V(6); PG8_BAR; PG8_MMA(1, 1, At, B1); PG8_BAR;
        }
        if (cur.sub < 0) { int fr_ = fr, fq_ = fq; asm volatile("" : "+v"(fr_), "+v"(fq_)); E(acc, cur, wr, wc, fr_, fq_); }
        else {
            int t_ = tid; asm volatile("" : "+v"(t_));
            f32x4* sp = slab + (size_t)cur.sub * 32 * 512 + t_;
#pragma unroll
            for (int a = 0; a < 2; ++a)
#pragma unroll
                for (int b = 0; b < 2; ++b)
#pragma unroll
                    for (int m = 0; m < 4; ++m)
#pragma unroll
                        for (int n = 0; n < 2; ++n) sp[(size_t)(((a * 2 + b) * 4 + m) * 2 + n) * 512] = acc[a][b][m][n];
        }
        if (!has_next) break;
#pragma unroll
        for (int a = 0; a < 2; ++a)
#pragma unroll
            for (int b = 0; b < 2; ++b)
#pragma unroll
                for (int m = 0; m < 4; ++m)
#pragma unroll
                    for (int n = 0; n < 2; ++n) acc[a][b][m][n] = (f32x4){0.f, 0.f, 0.f, 0.f};
        cur = nxt; cA = nA; cB = nB; ++ui;
    }
    PG8_WAIT_V(0);
    if (wr == 0) PG8_BAR;
    PG8_BAR;
#undef PG8_SA
#undef PG8_SB
#undef PG8_STAGE
#undef PG8_LDA
#undef PG8_LDB
#undef PG8_MMA
#undef PG8_WAIT_V
#undef PG8_WAIT_L
#undef PG8_BAR
#undef PG8_SCHED
}
}
using pg8::Unit;

__device__ __forceinline__ void rows_rs8(const float* ss, int row0  , int fq, float (&rsv)[8]) {
    f32x4 part[8];
#pragma unroll
    for (int i = 0; i < 8; ++i) part[i] = *(const f32x4*)(ss + (size_t)(row0 + (i >> 2) * 128 + (i & 3) * 16) * 16 + 4 * fq);
#pragma unroll
    for (int i = 0; i < 8; ++i) {
        float t = (part[i][0] + part[i][1]) + (part[i][2] + part[i][3]);
        t += __shfl_xor(t, 16); t += __shfl_xor(t, 32);
        rsv[i] = rsqrtf(t * (1.f / 1024.f) + 1e-6f);
    }
}
struct EpiGU {
    const float* ss; bf16_t* act;
    __device__ __forceinline__ void operator()(const f32x4 (&acc)[2][2][4][2], const Unit& u, int wr, int wc, int fr, int fq) const {
        const int col = u.pn * 128 + wc * 32 + 8 * fq;
        const int row0 = u.pm * 256 + wr * 64 + fr;
        float rsv[8]; rows_rs8(ss, row0, fq, rsv);
#pragma unroll
        for (int ai = 0; ai < 2; ++ai)
#pragma unroll
            for (int m = 0; m < 4; ++m) {
                const int r = row0 + ai * 128 + m * 16;
                const float rs = rsv[ai * 4 + m];
                float o[8];
#pragma unroll
                for (int n = 0; n < 2; ++n) {
                    const f32x4 gt = acc[ai][0][m][n] * rs, gu = gt * (acc[ai][1][m][n] * rs), ex = gt * (-1.44269504089f);
                    f32x4 den; den[0] = __builtin_amdgcn_exp2f(ex[0]); den[1] = __builtin_amdgcn_exp2f(ex[1]); den[2] = __builtin_amdgcn_exp2f(ex[2]); den[3] = __builtin_amdgcn_exp2f(ex[3]);
                    den = den + 1.0f;
                    f32x4 rc; rc[0] = frcp(den[0]); rc[1] = frcp(den[1]); rc[2] = frcp(den[2]); rc[3] = frcp(den[3]);
                    const f32x4 res = gu * rc;
                    o[n * 4 + 0] = res[0]; o[n * 4 + 1] = res[1]; o[n * 4 + 2] = res[2]; o[n * 4 + 3] = res[3];
                }
                *(u32x4*)(act + (size_t)r * FF + col) = pack8(o);
            }
    }
};
struct EpiRes {
    bf16_t* XB; float* ssout; float scale;
    __device__ __forceinline__ void operator()(const f32x4 (&acc)[2][2][4][2], const Unit& u, int wr, int wc, int fr, int fq) const {
        const int row0 = u.pm * 256 + wr * 64 + fr, col0 = u.pn * 256 + wc * 32 + 8 * fq;
#pragma unroll
        for (int ai = 0; ai < 2; ++ai) {
            u32x4 xv[4][2];
#pragma unroll
            for (int m = 0; m < 4; ++m)
#pragma unroll
                for (int bj = 0; bj < 2; ++bj) xv[m][bj] = *(const u32x4*)(XB + (size_t)(row0 + ai * 128 + m * 16) * D + col0 + bj * 128);
#pragma unroll
            for (int m = 0; m < 4; ++m) {
                const int r = row0 + ai * 128 + m * 16;
                float ssum = 0.f;
#pragma unroll
                for (int bj = 0; bj < 2; ++bj) {
                    float o[8]; unpack8(xv[m][bj], o);
                    const f32x4 n0 = (f32x4){o[0], o[1], o[2], o[3]} + acc[ai][bj][m][0] * scale, n1 = (f32x4){o[4], o[5], o[6], o[7]} + acc[ai][bj][m][1] * scale;
                    o[0] = n0[0]; o[1] = n0[1]; o[2] = n0[2]; o[3] = n0[3]; o[4] = n1[0]; o[5] = n1[1]; o[6] = n1[2]; o[7] = n1[3];
                    *(u32x4*)(XB + (size_t)r * D + col0 + bj * 128) = pack8(o);
                    const f32x4 sq = n0 * n0 + n1 * n1;
                    ssum += (sq[0] + sq[1]) + (sq[2] + sq[3]);
                }
                ssum += __shfl_xor(ssum, 16); ssum += __shfl_xor(ssum, 32);
                if (fq == 0) ssout[(size_t)r * 16 + u.pn * 4 + wc] = ssum;
            }
        }
    }
};
struct EpiRKV {
    unsigned char* ws; unsigned char* dob;
    __device__ __forceinline__ void operator()(const f32x4 (&acc)[2][2][4][2], const Unit& u, int wr, int wc, int fr, int fq) const {
        if (u.pn < 12) {
            bf16_t* base = (u.pn < 8) ? (bf16_t*)(ws + B_R + (size_t)(u.pn >> 2) * ROWB) : (bf16_t*)(dob + DO_XB);
#pragma unroll
            for (int ai = 0; ai < 2; ++ai)
#pragma unroll
                for (int m = 0; m < 4; ++m) {
                    const int row = u.pm * 256 + ai * 128 + wr * 64 + m * 16 + fr;
#pragma unroll
                    for (int bj = 0; bj < 2; ++bj) {
                        const int c = (u.pn & 3) * 256 + bj * 128 + wc * 32 + 8 * fq;
                        float o[8] = {acc[ai][bj][m][0][0], acc[ai][bj][m][0][1], acc[ai][bj][m][0][2], acc[ai][bj][m][0][3], acc[ai][bj][m][1][0], acc[ai][bj][m][1][1], acc[ai][bj][m][1][2], acc[ai][bj][m][1][3]};
                        *(u32x4*)(base + (size_t)row * D + c) = pack8(o);
                    }
                }
        } else {
#pragma unroll
            for (int ai = 0; ai < 2; ++ai)
#pragma unroll
                for (int m = 0; m < 4; ++m) {
                    const int row = u.pm * 256 + ai * 128 + wr * 64 + m * 16 + fr;
#pragma unroll
                    for (int bj = 0; bj < 2; ++bj) {
                        const int c = (u.pn - 12) * 256 + bj * 128 + wc * 32 + 8 * fq;
                        if (c >= 384) continue;
                        float o[8];
#pragma unroll
                        for (int n = 0; n < 2; ++n)
#pragma unroll
                            for (int j = 0; j < 4; ++j) {
                                const float a = acc[ai][bj][m][n][j]; float val;
                                if (c < 64) val = 1.f - 2.f * frcp(1.f + __expf(2.f * a));
                                else if (c < 128) val = a;
                                else if (c < 288) val = fsigmoid(a);
                                else val = 0.f;
                                o[n * 4 + j] = val;
                            }
                        *(u32x4*)((bf16_t*)(dob + DO_L1) + (size_t)row * 384 + c) = pack8(o);
                    }
                }
        }
    }
};
struct EpiL2 {
    unsigned char* ws; const float* w0; const float* a0;
    __device__ __forceinline__ void operator()(const f32x4 (&acc)[2][2][4][2], const Unit& u, int wr, int wc, int fr, int fq) const {
        const int kind = u.pn >> 2;
        bf16_t* base = (bf16_t*)(ws + (kind == 2 ? L_G : B_LW + (size_t)kind * ROWB));
        const float* bsrc = kind == 0 ? w0 : a0;
        const float bmul = kind == 2 ? 0.f : 1.f;
        f32x4 bvv[2][2];
#pragma unroll
        for (int bj = 0; bj < 2; ++bj)
#pragma unroll
            for (int n = 0; n < 2; ++n) bvv[bj][n] = *(const f32x4*)(bsrc + (u.pn & 3) * 256 + bj * 128 + wc * 32 + 8 * fq + 4 * n) * bmul;
#pragma unroll
        for (int ai = 0; ai < 2; ++ai)
#pragma unroll
            for (int m = 0; m < 4; ++m) {
                const int row = u.pm * 256 + ai * 128 + wr * 64 + m * 16 + fr;
#pragma unroll
                for (int bj = 0; bj < 2; ++bj) {
                    const int c = (u.pn & 3) * 256 + bj * 128 + wc * 32 + 8 * fq;
                    float o[8];
#pragma unroll
                    for (int n = 0; n < 2; ++n) {
                        const f32x4 z = acc[ai][bj][m][n] + bvv[bj][n];
                        f32x4 res = z;
                        if (kind < 2) {
                            const f32x4 ex = z * (-1.44269504089f);
                            f32x4 den; den[0] = __builtin_amdgcn_exp2f(ex[0]); den[1] = __builtin_amdgcn_exp2f(ex[1]); den[2] = __builtin_amdgcn_exp2f(ex[2]); den[3] = __builtin_amdgcn_exp2f(ex[3]);
                            den = den + 1.0f;
                            res[0] = frcp(den[0]); res[1] = frcp(den[1]); res[2] = frcp(den[2]); res[3] = frcp(den[3]);
                            res = res * (kind == 0 ? -0.60653065971f : 1.0f);
                        }
                        o[n * 4 + 0] = res[0]; o[n * 4 + 1] = res[1]; o[n * 4 + 2] = res[2]; o[n * 4 + 3] = res[3];
                    }
                    *(u32x4*)(base + (size_t)row * D + c) = pack8(o);
                }
            }
    }
};
struct EpiCI {
    const float* ss; bf16_t* U; bf16_t* GB; float* out;
    __device__ __forceinline__ void operator()(const f32x4 (&acc)[2][2][4][2], const Unit& u, int wr, int wc, int fr, int fq) const {
        float rsv[8]; rows_rs8(ss, u.pm * 256 + wr * 64 + fr, fq, rsv);
#pragma unroll
        for (int ai = 0; ai < 2; ++ai)
#pragma unroll
            for (int m = 0; m < 4; ++m) {
                const int row = u.pm * 256 + ai * 128 + wr * 64 + m * 16 + fr;
                const float rs = rsv[ai * 4 + m];
                if (u.pn < 8) {
                    const int c = u.pn * 128 + wc * 32 + 8 * fq;
                    float o[8];
#pragma unroll
                    for (int n = 0; n < 2; ++n)
#pragma unroll
                        for (int j = 0; j < 4; ++j) o[n * 4 + j] = (acc[ai][0][m][n][j] * rs) * (acc[ai][1][m][n][j] * rs);
                    *(u32x4*)(U + (size_t)row * D + c) = pack8(o);
                    if (row < M) {
                        int t, T, seq; row_info(row, t, T, seq);
                        if (t >= T - 2) {
                            float* op = (seq < 8) ? out + O_CVP + ((size_t)seq * 2 + (t - (T - 2))) * D + c : out + O_CVS + ((size_t)(seq - 8) * 2 + (t - (T - 2))) * D + c;
                            *(f32x4*)op = (f32x4){o[0], o[1], o[2], o[3]}; *(f32x4*)(op + 4) = (f32x4){o[4], o[5], o[6], o[7]};
                        }
                    }
                } else {
#pragma unroll
                    for (int bj = 0; bj < 2; ++bj) {
                        const int c = (u.pn - 8) * 256 + bj * 128 + wc * 32 + 8 * fq;
                        float o[8];
#pragma unroll
                        for (int n = 0; n < 2; ++n)
#pragma unroll
                            for (int j = 0; j < 4; ++j) o[n * 4 + j] = acc[ai][bj][m][n][j] * rs;
                        *(u32x4*)(GB + (size_t)row * D + c) = pack8(o);
                    }
                }
            }
    }
};

struct TSrc { const float* p; int ld; int vk; int vc; const float* scale; int smode; };
__device__ __forceinline__ void tblock(LAS float* tile, const TSrc s, bf16_t* dst  , int kdst, const int tid) {
    const int kr = tid >> 4, c4 = (tid & 15) * 4;
    __syncthreads();
#pragma unroll
    for (int hf = 0; hf < 2; ++hf) {
        const int k = kr + 32 * hf;
        f32x4 v = (f32x4){0.f, 0.f, 0.f, 0.f};
        if (k < s.vk && c4 < s.vc) {
            v = *(const f32x4*)(s.p + (size_t)k * s.ld + c4);
            if (s.smode) { float sc = s.scale[k]; if (s.smode == 2) sc = 1.f - sc; v *= sc; }
        }
        tile[k * 65 + c4 + 0] = v[0]; tile[k * 65 + c4 + 1] = v[1]; tile[k * 65 + c4 + 2] = v[2]; tile[k * 65 + c4 + 3] = v[3];
    }
    __syncthreads();
    const int n = tid >> 3, k8 = (tid & 7) * 8;
    float o[8];
#pragma unroll
    for (int j = 0; j < 8; ++j) o[j] = tile[(k8 + j) * 65 + n];
    *(u32x4*)(dst + (size_t)n * kdst + k8) = pack8(o);
}
enum { T_GU = 0, T_DN, T_RKV, T_L2, T_PLAIN, T_WIN };
__device__ __forceinline__ void convert(LAS float* tile, const Ctx& cx, int type, int f, bf16_t* dst, int wg, int nwg) {
    int Nd, Kd;
    switch (type) { case T_GU: Nd = 5632; Kd = 1024; break; case T_DN: Nd = 1024; Kd = 2816; break; case T_RKV: Nd = 3584; Kd = 2048; break;
                    case T_L2: Nd = 3072; Kd = 384; break; case T_WIN: Nd = 3072; Kd = 1024; break; default: Nd = 1024; Kd = 1024; break; }
    const int nkb = Kd / 64, nblk = (Nd / 64) * nkb;
    for (int blk = wg; blk < nblk; blk += nwg) {
        const int nb = blk / nkb, kb = blk - nb * nkb, n0 = nb * 64, kd0 = kb * 64;
        TSrc s; s.p = nullptr; s.ld = 0; s.vk = 0; s.vc = 0; s.scale = nullptr; s.smode = 0;
        if (type == T_GU) {
            const int pn = n0 >> 8, bj = (n0 >> 7) & 1, i0 = n0 & 127, c0 = bj * FF + 128 * pn + i0;
            s.p = cx.p->in[7] + (size_t)f * D * 2 * FF + (size_t)kd0 * (2 * FF) + c0; s.ld = 2 * FF; s.vk = 64; s.vc = 64; s.scale = cx.p->in[6] + f * D + kd0; s.smode = 1;
        } else if (type == T_DN) {
            s.p = cx.p->in[8] + (size_t)f * FF * D + (size_t)kd0 * D + n0; s.ld = D; s.vk = 64; s.vc = 64;
        } else if (type == T_RKV) {
            const int hf = kd0 >= 1024, ks = kd0 & 1023; s.smode = hf ? 1 : 2; s.vk = 64;
            if (n0 < 3072) { const int pj = n0 >> 10, c0 = n0 & 1023, mi = pj == 0 ? 0 : (pj == 1 ? 2 : 3);
                s.p = cx.p->in[12] + (size_t)pj * D * D + (size_t)ks * D + c0; s.ld = D; s.vc = 64; s.scale = cx.p->in[11] + mi * D + ks; }
            else { const int j0 = n0 - 3072;
                if (j0 < 64) { s.p = cx.p->in[14] + (size_t)ks * 64 + j0; s.ld = 64; s.vc = 64; s.scale = cx.p->in[11] + 1 * D + ks; }
                else if (j0 < 128) { s.p = cx.p->in[17] + (size_t)ks * 64 + (j0 - 64); s.ld = 64; s.vc = 64; s.scale = cx.p->in[11] + 4 * D + ks; }
                else if (j0 < 288) { const int c0 = j0 - 128; s.p = cx.p->in[19] + (size_t)ks * 160 + c0; s.ld = 160; s.vc = (160 - c0) < 64 ? (160 - c0) : 64; s.scale = cx.p->in[11] + 5 * D + ks; }
                else { s.vk = 0; s.vc = 0; s.smode = 0; s.p = cx.p->in[14]; } }
        } else if (type == T_L2) {
            s.p = cx.p->in[15];
            if (n0 < 1024) { if (kd0 == 0) { s.p = cx.p->in[15] + n0; s.ld = D; s.vk = 64; s.vc = 64; } }
            else if (n0 < 2048) { if (kd0 == 64) { s.p = cx.p->in[18] + (n0 - 1024); s.ld = D; s.vk = 64; s.vc = 64; } }
            else { if (kd0 >= 128 && kd0 < 288) { const int k0 = kd0 - 128; s.p = cx.p->in[20] + (size_t)k0 * D + (n0 - 2048); s.ld = D; s.vk = (160 - k0) < 64 ? (160 - k0) : 64; s.vc = 64; } }
        } else if (type == T_WIN) {
            int c0;
            if (n0 < 2048) { const int pn = n0 >> 8, bj = (n0 >> 7) & 1, i0 = n0 & 127; c0 = (bj == 0 ? 1024 : 2048) + 128 * pn + i0; } else c0 = n0 - 2048;
            s.p = cx.p->in[27] + (size_t)kd0 * 3072 + c0; s.ld = 3072; s.vk = 64; s.vc = 64; s.scale = cx.p->in[9] + D + kd0; s.smode = 1;
        } else {
            s.p = cx.p->in[f] + (size_t)kd0 * D + n0; s.ld = D; s.vk = 64; s.vc = 64;
        }
        tblock(tile, s, dst + (size_t)n0 * Kd + kd0, Kd, cx.tid);
    }
}

__device__ __forceinline__ void ld8f(const float* p, float* o) { const f32x4 a = *(const f32x4*)p, b = *(const f32x4*)(p + 4); o[0] = a[0]; o[1] = a[1]; o[2] = a[2]; o[3] = a[3]; o[4] = b[0]; o[5] = b[1]; o[6] = b[2]; o[7] = b[3]; }
__device__ __forceinline__ void ld8b(const bf16_t* p, float* o) { unpack8(*(const u32x4*)p, o); }
__device__ __forceinline__ void phase_x0(const Ctx& cx, bf16_t* XB, float* ss0) {
    const int wave = cx.tid >> 6, lane = cx.tid & 63;
    for (int m = cx.bid * 8 + wave; m < MPAD; m += cx.G * 8) {
        const float* src = nullptr;
        if (m < MP) { const int b = m / PT, t = m - b * PT; src = t < NMETA ? cx.p->in[5] + (size_t)t * D : cx.p->in[0] + ((size_t)b * PTX + (t - NMETA)) * D; }
        else if (m < M) src = cx.p->in[1] + (size_t)(m - MP) * D;
        float s = 0.f;
#pragma unroll
        for (int i = 0; i < 4; ++i) {
            const int c = lane * 4 + i * 256;
            f32x4 v = src ? *(const f32x4*)(src + c) : (f32x4){0.f, 0.f, 0.f, 0.f};
            u32x2 pk; pk[0] = cvt_pk_bf16(v[0], v[1]); pk[1] = cvt_pk_bf16(v[2], v[3]);
            *(u32x2*)(XB + (size_t)m * D + c) = pk;
            s += v[0] * v[0] + v[1] * v[1] + v[2] * v[2] + v[3] * v[3];
        }
        s = wave_sum(s);
        if (lane < 16) ss0[(size_t)m * 16 + lane] = lane == 0 ? s : 0.f;
    }
}
__device__ __forceinline__ void phase_mix(const Ctx& cx, const bf16_t* XB, const float* ss, bf16_t* HH) {
    const int c = (cx.tid & 127) * 8, sub = cx.tid >> 7;
    float g[8];
    { const f32x4 g0 = *(const f32x4*)(cx.p->in[9] + c), g1 = *(const f32x4*)(cx.p->in[9] + c + 4); g[0] = g0[0]; g[1] = g0[1]; g[2] = g0[2]; g[3] = g0[3]; g[4] = g1[0]; g[5] = g1[1]; g[6] = g1[2]; g[7] = g1[3]; }
    for (int m = cx.bid * 4 + sub; m < MPAD; m += cx.G * 4) {
        float hn[8], hp[8];
        if (m < M) {
            int t, T, seq; row_info(m, t, T, seq);
            const float rs = row_rs(ss, m);
            float xc[8]; ld8b(XB + (size_t)m * D + c, xc);
#pragma unroll
            for (int j = 0; j < 8; ++j) hn[j] = xc[j] * rs * g[j];
            if (t > 0) {
                const float rp = row_rs(ss, m - 1);
                float xp[8]; ld8b(XB + (size_t)(m - 1) * D + c, xp);
#pragma unroll
                for (int j = 0; j < 8; ++j) hp[j] = xp[j] * rp * g[j];
            } else if (seq >= 8) {
                const float* sp = cx.p->in[3] + (size_t)(seq - 8) * D + c;
                const f32x4 y0 = *(const f32x4*)sp, y1 = *(const f32x4*)(sp + 4);
#pragma unroll
                for (int j = 0; j < 4; ++j) { hp[j] = y0[j]; hp[4 + j] = y1[j]; }
            } else {
#pragma unroll
                for (int j = 0; j < 8; ++j) hp[j] = 0.f;
            }
            if (t == T - 1) {
                float* op = (seq < 8) ? cx.p->out + O_SHP + (size_t)seq * D + c : cx.p->out + O_SHS + (size_t)(seq - 8) * D + c;
                *(f32x4*)op = (f32x4){hn[0], hn[1], hn[2], hn[3]}; *(f32x4*)(op + 4) = (f32x4){hn[4], hn[5], hn[6], hn[7]};
            }
        } else {
#pragma unroll
            for (int j = 0; j < 8; ++j) { hn[j] = 0.f; hp[j] = 0.f; }
        }
        *(u32x4*)(HH + (size_t)m * 2048 + c) = pack8(hn);
        *(u32x4*)(HH + (size_t)m * 2048 + 1024 + c) = pack8(hp);
    }
}
__device__ __forceinline__ void phase_post(const Ctx& cx, const bf16_t* YP, const bf16_t* YS, const float* CB, const bf16_t* V, const bf16_t* G, bf16_t* O) {
    const int c = (cx.tid & 127) * 8, sub = cx.tid >> 7;
    float lnw[8], lnb[8];
    ld8f(cx.p->in[24] + c, lnw); ld8f(cx.p->in[25] + c, lnb);
    for (int m = cx.bid * 4 + sub; m < MPAD; m += cx.G * 4) {
        float o[8];
        if (m < M) {
            float y[8], v[8], g[8];
            ld8b((m < MP ? YP + (size_t)m * D : YS + (size_t)(m - MP) * D) + c, y);
            ld8b(V + (size_t)m * D + c, v); ld8b(G + (size_t)m * D + c, g);
            const float cb = CB[(size_t)m * NH + (c >> 6)];
            float s = 0.f;
#pragma unroll
            for (int j = 0; j < 8; ++j) s += y[j];
            s = allreduce8(s);
            const float mean = s * (1.f / 64.f);
            float vs = 0.f;
#pragma unroll
            for (int j = 0; j < 8; ++j) { y[j] -= mean; vs += y[j] * y[j]; }
            vs = allreduce8(vs);
            const float rstd = rsqrtf(vs * (1.f / 64.f) + 64e-5f);
#pragma unroll
            for (int j = 0; j < 8; ++j) o[j] = (y[j] * rstd * lnw[j] + lnb[j] + cb * v[j]) * g[j];
        } else {
#pragma unroll
            for (int j = 0; j < 8; ++j) o[j] = 0.f;
        }
        *(u32x4*)(O + (size_t)m * D + c) = pack8(o);
    }
}
__device__ __forceinline__ void phase_conv(const Ctx& cx, const bf16_t* U, const bf16_t* GB, bf16_t* CV) {
    const int c = (cx.tid & 127) * 8, sub = cx.tid >> 7;
    float w0[8], w1[8], w2[8];
    ld8f(cx.p->in[28] + c, w0); ld8f(cx.p->in[28] + D + c, w1); ld8f(cx.p->in[28] + 2 * D + c, w2);
    for (int m = cx.bid * 4 + sub; m < MPAD; m += cx.G * 4) {
        float o[8];
        if (m < M) {
            int t, T, seq; row_info(m, t, T, seq);
            float u2[8], u1[8], u0[8], gb[8];
            ld8b(U + (size_t)m * D + c, u2); ld8b(GB + (size_t)m * D + c, gb);
            if (t >= 1) ld8b(U + (size_t)(m - 1) * D + c, u1);
            else if (seq >= 8) ld8f(cx.p->in[4] + ((size_t)(seq - 8) * 2 + 1) * D + c, u1);
            else {
#pragma unroll
                for (int j = 0; j < 8; ++j) u1[j] = 0.f; }
            if (t >= 2) ld8b(U + (size_t)(m - 2) * D + c, u0);
            else if (seq >= 8) ld8f(cx.p->in[4] + ((size_t)(seq - 8) * 2 + t) * D + c, u0);
            else {
#pragma unroll
                for (int j = 0; j < 8; ++j) u0[j] = 0.f; }
#pragma unroll
            for (int j = 0; j < 8; ++j) o[j] = gb[j] * (w0[j] * u0[j] + w1[j] * u1[j] + w2[j] * u2[j]);
        } else {
#pragma unroll
            for (int j = 0; j < 8; ++j) o[j] = 0.f;
        }
        *(u32x4*)(CV + (size_t)m * D + c) = pack8(o);
    }
}
__device__ __forceinline__ void phase_final(const Ctx& cx, const bf16_t* XB, const float* ss) {
    const int wave = cx.tid >> 6, lane = cx.tid & 63;
    for (int m = cx.bid * 8 + wave; m < M; m += cx.G * 8) {
        float* dst;
        if (m < MP) { const int b = m / PT, t = m - b * PT; if (t < NMETA) continue; dst = cx.p->out + O_YP + ((size_t)b * PTX + (t - NMETA)) * D; }
        else dst = cx.p->out + O_YS + (size_t)(m - MP) * D;
        const float rs = row_rs(ss, m);
#pragma unroll
        for (int i = 0; i < 4; ++i) {
            const int c = lane * 4 + i * 256;
            const u32x2 xb = *(const u32x2*)(XB + (size_t)m * D + c); const f32x4 g = *(const f32x4*)(cx.p->in[10] + c);
            const f32x4 v = {bf_lo(xb[0]), bf_hi(xb[0]), bf_lo(xb[1]), bf_hi(xb[1])};
            *(f32x4*)(dst + c) = v * rs * g;
        }
    }
}

struct ScanBufs { const bf16_t* R; const bf16_t* K; const bf16_t* V; const bf16_t* LW; const bf16_t* A; bf16_t* YP; bf16_t* YS; float* CB; };
__device__ __forceinline__ void scan_item_info(int item, int& m0, int& T, int& h, int& half, int& sb) {
    if (item < 256) { const int b = item >> 5; h = (item >> 1) & 15; half = item & 1; m0 = b * PT; T = PT; sb = -1 - b; }
    else { const int q = item - 256; sb = q >> 5; h = (q >> 1) & 15; half = q & 1; m0 = MP + sb * STN; T = STN; }
}
__device__ __forceinline__ void phase_scan(LAS float* lds, const Ctx& cx, const ScanBufs B) {
    const int tid = cx.tid, G = cx.G;
    const int nitems = 256 + 4096;
    const bool consumer = tid < 256;
    const int rp = (tid >> 4) & 15, seg = tid & 15;
    const int ptid = tid - 256, tl = ptid >> 3, cs = ptid & 7;
    int ci = cx.bid, ct0 = 0, k = 0;
    f32x2 sA0 = {0.f, 0.f}, sA1 = {0.f, 0.f}, sB0 = {0.f, 0.f}, sB1 = {0.f, 0.f};
    f32x4 pf[4][2]; bool pf_valid = false;
#pragma unroll
    for (int q = 0; q < 4; ++q) { pf[q][0] = (f32x4){0.f, 0.f, 0.f, 0.f}; pf[q][1] = pf[q][0]; }

    auto prep = [&](int pi, int pt0, int buf) __attribute__((always_inline)) {
        LAS float* ob = lds + buf * 11264;
        int item, t;
        if (pi < 256) { item = pi; t = pt0 + tl; } else { item = pi + (tl >> 3) * G; t = tl & 7; }
        if (item < nitems) {
            int pm0, pT, ph, phalf, psb; scan_item_info(item, pm0, pT, ph, phalf, psb);
            if (t < pT) {
                const size_t o = (size_t)(pm0 + t) * D + ph * 64 + cs * 8;
                float kf[8], rf[8], af[8], wf[8];
                ld8b(B.K + o, kf); ld8b(B.R + o, rf); ld8b(B.A + o, af); ld8b(B.LW + o, wf);
                const u32x2 vv = *(const u32x2*)(B.V + (size_t)(pm0 + t) * D + ph * 64 + phalf * 32 + cs * 4);
                float kkc[8], kac[8];
                ld8f(cx.p->in[21] + ph * 64 + cs * 8, kkc); ld8f(cx.p->in[22] + ph * 64 + cs * 8, kac);
                float kk[8]; float n2 = 0.f;
#pragma unroll
                for (int j = 0; j < 8; ++j) { kk[j] = kf[j] * kkc[j]; n2 += kk[j] * kk[j]; }
                n2 = allreduce8(n2);
                const float inv = 1.f / fmaxf(sqrtf(n2), 1e-12f);
                float vd[8], vb[8], vk[8];
#pragma unroll
                for (int j = 0; j < 8; ++j) { kk[j] *= inv; vb[j] = kk[j] * af[j]; vk[j] = kf[j] * (1.f + (af[j] - 1.f) * kac[j]); vd[j] = __expf(wf[j]); }
                if (phalf == 0) {
                    float rkc[8]; ld8f(cx.p->in[23] + ph * 64 + cs * 8, rkc);
                    float cbv = 0.f;
#pragma unroll
                    for (int j = 0; j < 8; ++j) cbv += rf[j] * vk[j] * rkc[j];
                    cbv = allreduce8(cbv);
                    if (cs == 0) B.CB[(size_t)(pm0 + t) * NH + ph] = cbv;
                }
                LAS float* q = ob + tl * 64 + cs * 8;
                *(LAS f32x4*)(q) = (f32x4){vd[0], vd[1], vd[2], vd[3]}; *(LAS f32x4*)(q + 4) = (f32x4){vd[4], vd[5], vd[6], vd[7]};
                *(LAS f32x4*)(q + 2048) = (f32x4){kk[0], kk[1], kk[2], kk[3]}; *(LAS f32x4*)(q + 2048 + 4) = (f32x4){kk[4], kk[5], kk[6], kk[7]};
                *(LAS f32x4*)(q + 4096) = (f32x4){vb[0], vb[1], vb[2], vb[3]}; *(LAS f32x4*)(q + 4096 + 4) = (f32x4){vb[4], vb[5], vb[6], vb[7]};
                *(LAS f32x4*)(q + 6144) = (f32x4){vk[0], vk[1], vk[2], vk[3]}; *(LAS f32x4*)(q + 6144 + 4) = (f32x4){vk[4], vk[5], vk[6], vk[7]};
                *(LAS f32x4*)(q + 8192) = (f32x4){rf[0], rf[1], rf[2], rf[3]}; *(LAS f32x4*)(q + 8192 + 4) = (f32x4){rf[4], rf[5], rf[6], rf[7]};
                *(LAS f32x4*)(ob + 10240 + tl * 32 + cs * 4) = (f32x4){bf_lo(vv[0]), bf_hi(vv[0]), bf_lo(vv[1]), bf_hi(vv[1])};
            }
        }
    };
    auto yout = [&](int pi, int pt0, int ybuf) __attribute__((always_inline)) {
        int item, t;
        if (pi < 256) { item = pi; t = pt0 + tl; } else { item = pi + (tl >> 3) * G; t = tl & 7; }
        if (item < nitems) {
            int pm0, pT, ph, phalf, psb; scan_item_info(item, pm0, pT, ph, phalf, psb);
            if (t < pT) {
                const f32x4 y = *(const LAS f32x4*)(lds + 22528 + ybuf * 1024 + tl * 32 + cs * 4);
                u32x2 pk; pk[0] = cvt_pk_bf16(y[0], y[1]); pk[1] = cvt_pk_bf16(y[2], y[3]);
                bf16_t* yb = (pm0 < MP) ? B.YP + (size_t)pm0 * D : B.YS + (size_t)(pm0 - MP) * D;
                *(u32x2*)(yb + (size_t)t * D + ph * 64 + phalf * 32 + cs * 4) = pk;
            }
        }
    };
    auto run_steps = [&](int slot0, int ns) __attribute__((always_inline)) {
        const LAS float* ob = lds + (k & 1) * 11264 + seg * 4 + slot0 * 64;
        const LAS float* vbp = lds + (k & 1) * 11264 + 10240 + 2 * rp + slot0 * 32;
        LAS float* yb = lds + 22528 + (k & 1) * 1024 + 2 * rp + slot0 * 32;
#define SCAN_LOAD(P, tt) do { const int o_ = (tt) * 64; P##d = *(const LAS f32x4*)(ob + o_); P##kk = *(const LAS f32x4*)(ob + 2048 + o_); P##b = *(const LAS f32x4*)(ob + 4096 + o_); \
            P##k = *(const LAS f32x4*)(ob + 6144 + o_); P##r = *(const LAS f32x4*)(ob + 8192 + o_); P##v = *(const LAS f32x2*)(vbp + (tt) * 32); } while (0)
#define SCAN_STEP(P, q0, q1) do { \
            const f32x2 dl = {P##d[0], P##d[1]}, dh = {P##d[2], P##d[3]}, kkl = {P##kk[0], P##kk[1]}, kkh = {P##kk[2], P##kk[3]}, bl = {P##b[0], P##b[1]}, bh = {P##b[2], P##b[3]}; \
            const f32x2 kl = {P##k[0], P##k[1]}, kh = {P##k[2], P##k[3]}, rl = {P##r[0], P##r[1]}, rh = {P##r[2], P##r[3]}; \
            f32x2 pa = sA0 * kkl; pa = sA1 * kkh + pa; f32x2 pb = sB0 * kkl; pb = sB1 * kkh + pb; \
            float p0 = pa[0] + pa[1], p1 = pb[0] + pb[1]; \
            const f32x2 sdA0 = sA0 * dl + kl * P##v[0], sdA1 = sA1 * dh + kh * P##v[0], sdB0 = sB0 * dl + kl * P##v[1], sdB1 = sB1 * dh + kh * P##v[1]; \
            p0 += dpp_f<0xB1>(p0); p1 += dpp_f<0xB1>(p1); p0 += dpp_f<0x4E>(p0); p1 += dpp_f<0x4E>(p1); p0 += dpp_f<0x124>(p0); p1 += dpp_f<0x124>(p1); p0 += dpp_f<0x128>(p0); p1 += dpp_f<0x128>(p1); \
            sA0 = sdA0 - bl * p0; sA1 = sdA1 - bh * p0; sB0 = sdB0 - bl * p1; sB1 = sdB1 - bh * p1; \
            f32x2 qa = sA0 * rl; qa = sA1 * rh + qa; f32x2 qb = sB0 * rl; qb = sB1 * rh + qb; \
            q0 = qa[0] + qa[1]; q1 = qb[0] + qb[1]; } while (0)
        f32x4 Xd, Xkk, Xb, Xk, Xr, Yd, Ykk, Yb, Yk, Yr, Zd, Zkk, Zb, Zk, Zr, Wd, Wkk, Wb, Wk, Wr; f32x2 Xv, Yv, Zv, Wv;
        const bool l0 = (seg & 1) != 0, l1 = (seg & 2) != 0;
#define SCAN_YRED(a0, a1, a2, a3, tt, ok) do { \
            const float s0 = l0 ? a0 : a1, s1 = l0 ? a2 : a3, k0 = l0 ? a1 : a0, k1 = l0 ? a3 : a2; \
            const float w0 = k0 + dpp_f<0xB1>(s0), w1 = k1 + dpp_f<0xB1>(s1); \
            const float s2 = l1 ? w0 : w1, k2 = l1 ? w1 : w0; \
            float z = k2 + dpp_f<0x4E>(s2); \
            z += dpp_f<0x124>(z); z += dpp_f<0x128>(z); \
            if (seg < 4 && (ok)) yb[((tt) + (seg >> 1)) * 32 + (seg & 1)] = z; } while (0)
        __builtin_amdgcn_s_setprio(3);
        SCAN_LOAD(X, 0); SCAN_LOAD(Y, 1);
        float pv0 = 0.f, pv1 = 0.f, pv2 = 0.f, pv3 = 0.f;
        for (int t = 0; t < ns; t += 4) {
            SCAN_LOAD(Z, t + 2); SCAN_LOAD(W, t + 3);
            __builtin_amdgcn_sched_barrier(0);
            { float v0, v1, v2, v3; SCAN_STEP(X, v0, v1); SCAN_YRED(pv0, pv1, pv2, pv3, t - 2, t > 0); SCAN_STEP(Y, v2, v3); pv0 = v0; pv1 = v1; pv2 = v2; pv3 = v3; }
            __builtin_amdgcn_sched_barrier(0);
            { const int tn = (t + 4 < ns) ? t + 4 : t; SCAN_LOAD(X, tn); SCAN_LOAD(Y, tn + 1); }
            __builtin_amdgcn_sched_barrier(0);
            { float v0, v1, v2, v3; SCAN_STEP(Z, v0, v1); SCAN_YRED(pv0, pv1, pv2, pv3, t, true); SCAN_STEP(W, v2, v3); pv0 = v0; pv1 = v1; pv2 = v2; pv3 = v3; }
            __builtin_amdgcn_sched_barrier(0);
        }
        SCAN_YRED(pv0, pv1, pv2, pv3, ns - 2, true);
        __builtin_amdgcn_s_setprio(0);
#undef SCAN_YRED
#undef SCAN_LOAD
#undef SCAN_STEP
    };
    auto state_ptr = [&](int item, bool out) __attribute__((always_inline)) -> float* {
        int pm0, pT, ph, phalf, psb; scan_item_info(item, pm0, pT, ph, phalf, psb);
        const size_t o = (((size_t)psb * NH + ph) * 64 + phalf * 32 + 2 * rp) * 64 + seg * 4;
        return out ? cx.p->out + O_WKVS + o : const_cast<float*>(cx.p->in[2]) + o;
    };

    if (ci < nitems && !consumer) prep(ci, 0, 0);
    __syncthreads();
    int pci = 0, pct0 = 0; bool have_prev = false;
    while (ci < nitems) {
        int ni, nt0 = 0;
        if (ci < 256) { ni = ci; nt0 = ct0 + 32; if (nt0 >= PT) { ni = ci + G; nt0 = 0; } } else ni = ci + 4 * G;
        if (consumer) {
            const bool next_is_group = (ni >= 256) && (ni < nitems) && (ni != ci);
            if (ci < 256) {
                if (ct0 == 0) { sA0 = (f32x2){0.f, 0.f}; sA1 = sA0; sB0 = sA0; sB1 = sA0; }
                if (next_is_group) {
#pragma unroll
                    for (int q = 0; q < 4; ++q) if (ni + q * G < nitems) { const float* sp = state_ptr(ni + q * G, false); pf[q][0] = *(const f32x4*)sp; pf[q][1] = *(const f32x4*)(sp + 64); }
                    pf_valid = true;
                }
                const int ns = (PT - ct0) < 32 ? (PT - ct0) : 32;
                run_steps(0, ns);
                if (ct0 + 32 >= PT) {
                    int pm0, pT, ph, phalf, psb; scan_item_info(ci, pm0, pT, ph, phalf, psb);
                    float* sp = cx.p->out + O_WKVP + (((size_t)(-1 - psb) * NH + ph) * 64 + phalf * 32 + 2 * rp) * 64 + seg * 4;
                    *(f32x4*)sp = (f32x4){sA0[0], sA0[1], sA1[0], sA1[1]}; *(f32x4*)(sp + 64) = (f32x4){sB0[0], sB0[1], sB1[0], sB1[1]};
                }
            } else {
                f32x4 st[4][2];
#pragma unroll
                for (int q = 0; q < 4; ++q) {
                    if (pf_valid) { st[q][0] = pf[q][0]; st[q][1] = pf[q][1]; }
                    else if (ci + q * G < nitems) { const float* sp = state_ptr(ci + q * G, false); st[q][0] = *(const f32x4*)sp; st[q][1] = *(const f32x4*)(sp + 64); }
                    else { st[q][0] = (f32x4){0.f, 0.f, 0.f, 0.f}; st[q][1] = st[q][0]; }
                }
                pf_valid = false;
                if (next_is_group) {
#pragma unroll
                    for (int q = 0; q < 4; ++q) if (ni + q * G < nitems) { const float* sp = state_ptr(ni + q * G, false); pf[q][0] = *(const f32x4*)sp; pf[q][1] = *(const f32x4*)(sp + 64); }
                    pf_valid = true;
                }
#pragma unroll
                for (int q = 0; q < 4; ++q) {
                    if (ci + q * G < nitems) {
                        sA0 = (f32x2){st[q][0][0], st[q][0][1]}; sA1 = (f32x2){st[q][0][2], st[q][0][3]}; sB0 = (f32x2){st[q][1][0], st[q][1][1]}; sB1 = (f32x2){st[q][1][2], st[q][1][3]};
                        asm volatile("" :: "v"(sA0[0]), "v"(sA1[0]), "v"(sB0[0]), "v"(sB1[0]));
                        run_steps(8 * q, 8);
                        float* sp = state_ptr(ci + q * G, true);
                        *(f32x4*)sp = (f32x4){sA0[0], sA0[1], sA1[0], sA1[1]}; *(f32x4*)(sp + 64) = (f32x4){sB0[0], sB0[1], sB1[0], sB1[1]};
                    }
                }
            }
        } else {
            if (ni < nitems) prep(ni, nt0, (k + 1) & 1);
            if (have_prev) yout(pci, pct0, (k - 1) & 1);
        }
        __syncthreads();
        pci = ci; pct0 = ct0; have_prev = true;
        ci = ni; ct0 = nt0; ++k;
    }
    if (have_prev && !consumer) yout(pci, pct0, (k - 1) & 1);
    __syncthreads();
}

#define XB_TMO      128
#define XB_XCNT(j)  (256  + 64 * (j))
#define XB_XSUB(j)  (1280 + 64 * (j))
#define XB_XGEN(j)  (2304 + 64 * (j))
#define XB_TOP      3328
#define XB_TOPGEN   3392
#define XCD_BAR_WORDS 3456
#define XB_SPIN_CAP (1u << 18)
__device__ __forceinline__ unsigned xb_ld(unsigned* p)              { return __hip_atomic_load(p, __ATOMIC_RELAXED, __HIP_MEMORY_SCOPE_AGENT); }
__device__ __forceinline__ unsigned xb_add(unsigned* p, unsigned v) { return __hip_atomic_fetch_add(p, v, __ATOMIC_RELAXED, __HIP_MEMORY_SCOPE_AGENT); }
__device__ __forceinline__ unsigned xb_xcc_id() { return (unsigned)__builtin_amdgcn_s_getreg((3 << 11) | 20) & 0xFu; }
#define XB_SPIN(cond, bar) do { unsigned _sp = 0; while (cond) { __builtin_amdgcn_s_sleep(1); \
    if ((++_sp & 255u) == 0u) { if (xb_ld(&(bar)[XB_TMO])) break; if (_sp > XB_SPIN_CAP) { atomicAdd(&(bar)[XB_TMO], 1u); break; } } } } while (0)
__device__ __forceinline__ void xcd_barrier_complete(unsigned* bar, unsigned x, unsigned G, unsigned& nloc, unsigned& nx) {
    unsigned sum, cnt, mine, sp = 0u;
    for (;;) {
        sum = 0u; cnt = 0u; mine = 0u;
#pragma unroll
        for (unsigned j = 0; j < 16; ++j) { const unsigned c = xb_ld(&bar[XB_XCNT(j)]); sum += c; cnt += (c > 0u) ? 1u : 0u; mine = (j == x) ? c : mine; }
        if (sum == G) break;
        __builtin_amdgcn_s_sleep(1);
        if ((++sp & 255u) == 0u) { if (xb_ld(&bar[XB_TMO])) break; if (sp > XB_SPIN_CAP) { atomicAdd(&bar[XB_TMO], 1u); break; } }
    }
    nloc = mine > 0u ? mine : 1u; nx = cnt > 0u ? cnt : 1u;
}
__device__ __forceinline__ void xcd_barrier(unsigned* bar, volatile LAS unsigned* st, int tid, unsigned G) {
    asm volatile("s_waitcnt vmcnt(0)" ::: "memory");
    __syncthreads();
    if (tid == 0) {
        const unsigned x = xb_xcc_id();
        __builtin_amdgcn_s_waitcnt(0);
        unsigned nloc = st[0], nx = st[1];
        if (nloc == 0u) { xcd_barrier_complete(bar, x, G, nloc, nx); st[0] = nloc; st[1] = nx; }
        const unsigned old = xb_add(&bar[XB_XSUB(x)], 1u);
        const unsigned gen = old / nloc;
        if (old + 1u == (gen + 1u) * nloc) {
            __builtin_amdgcn_fence(__ATOMIC_RELEASE, "agent");
            asm volatile("s_waitcnt vmcnt(0)" ::: "memory");
            const unsigned og = xb_add(&bar[XB_TOP], 1u);
            const unsigned tg = og / nx;
            if (og + 1u == (tg + 1u) * nx) xb_add(&bar[XB_TOPGEN], 1u);
            else XB_SPIN(xb_ld(&bar[XB_TOPGEN]) == tg, bar);
            __builtin_amdgcn_fence(__ATOMIC_ACQUIRE, "agent");
            xb_add(&bar[XB_XGEN(x)], 1u);
            asm volatile("s_waitcnt vmcnt(0)" ::: "memory");
        } else {
            XB_SPIN(xb_ld(&bar[XB_XGEN(x)]) == gen, bar);
            __builtin_amdgcn_fence(__ATOMIC_ACQUIRE, "agent");
            asm volatile("s_waitcnt vmcnt(0)" ::: "memory");
        }
    }
    __syncthreads();
}

#define X_ ((float*)(ws + WS_X))
#define SS_(i) ((float*)(ws + WS_SS))
#define XB_ ((bf16_t*)(ws + WS_X))
__global__ void __launch_bounds__(NTHREADS, 2) mega(Params p) {
    extern __shared__ __attribute__((aligned(16))) unsigned char shm[];
    LAS unsigned char* lds = (LAS unsigned char*)shm;
    LAS float* ldsf = (LAS float*)shm;
    volatile LAS unsigned* bst = (volatile LAS unsigned*)(shm + 131072);
    if (threadIdx.x == 0) { bst[0] = 0u; bst[1] = 0u; (void)xb_add((unsigned*)(p.ws + WS_BAR) + XB_XCNT(xb_xcc_id()), 1u); }
    __syncthreads();
    const int wv_ = __builtin_amdgcn_readfirstlane(threadIdx.x >> 6);
    for (int ph = 0; ph < 19; ++ph) {
#ifdef REP_MASK
        for (int rep = 0; rep < 1 + ((REP_MASK >> ph) & 1); ++rep) {
#else
        { const int rep = 0;
#endif
        Ctx cx;
        { KP kp = (KP)__builtin_amdgcn_kernarg_segment_ptr(); int t_ = wv_ * 64 + (int)__builtin_amdgcn_mbcnt_hi(~0u, __builtin_amdgcn_mbcnt_lo(~0u, 0u)), b_ = blockIdx.x, g_ = gridDim.x;
          asm volatile("" : "+s"(kp), "+v"(t_), "+s"(b_), "+s"(g_));
          cx.p = kp; cx.tid = t_; cx.bid = b_; cx.G = g_; }
        unsigned char* ws = cx.p->ws;
        unsigned char* dob = (unsigned char*)cx.p->out;
        const int G = cx.G, c = cx.bid;
        int kind, f = 0;
        switch (ph) {
            case 0: kind = 0; break;
            case 1: kind = 1; f = 0; break;  case 2: kind = 2; f = 0; break;
            case 3: kind = 3; break; case 4: kind = 4; break; case 5: kind = 5; break; case 6: kind = 6; break; case 7: kind = 7; break;
            case 8: kind = 2; f = 4; break;
            case 9: kind = 1; f = 1; break;  case 10: kind = 2; f = 1; break;
            case 11: kind = 1; f = 2; break; case 12: kind = 2; f = 2; break;
            case 13: kind = 8; break; case 14: kind = 9; break;
            case 15: kind = 2; f = 5; break;
            case 16: kind = 1; f = 3; break; case 17: kind = 2; f = 3; break;
            default: kind = 10; break;
        }
        if (kind == 0) {
            phase_x0(cx, XB_, SS_(0));
            convert(ldsf, cx, T_GU, 0, (bf16_t*)(ws + WS_SLOTA), c, G);
            convert(ldsf, cx, T_DN, 0, (bf16_t*)(ws + WS_SLOTA + SZ_GU), c, G);
            if (G != 256) {
                convert(ldsf, cx, T_RKV, 0, (bf16_t*)(ws + WS_WRKV), c, G);
                convert(ldsf, cx, T_L2, 0, (bf16_t*)(ws + WS_WL2), c, G);
                convert(ldsf, cx, T_PLAIN, 26, (bf16_t*)(ws + WS_WO), c, G);
            }
        } else if (kind == 1) {
            const int ssi = f == 0 ? 0 : (f == 1 ? 2 : (f == 2 ? 3 : 5));
            const unsigned char* slot = ws + ((f & 1) ? WS_SLOTB : WS_SLOTA);
            pg8::Gemm g; g.A = XB_; g.Bt = (const bf16_t*)slot; g.K = D;
            pg8::StaticOrder S; S.init(MPAD / 256, 22, G, c, g.K);
            EpiGU E; E.ss = SS_(ssi); E.act = (bf16_t*)(ws + B_ACT);
            pg8::gemm_phase(lds, g, S, E, cx.tid);
        } else if (kind == 2) {
            pg8::Gemm g; EpiRes E; E.XB = XB_;
            if (f < 4) { g.A = (const bf16_t*)(ws + B_ACT); g.Bt = (const bf16_t*)(ws + ((f & 1) ? WS_SLOTB : WS_SLOTA) + SZ_GU); g.K = FF; E.scale = 0.5f;
                         E.ssout = SS_(f == 0 ? 1 : (f == 1 ? 3 : (f == 2 ? 4 : 6))); }
            else if (f == 4) { g.A = (const bf16_t*)(ws + B_O); g.Bt = (const bf16_t*)(ws + WS_WO); g.K = D; E.scale = 1.f; E.ssout = SS_(2); }
            else { g.A = (const bf16_t*)(ws + B_CV); g.Bt = (const bf16_t*)(ws + WS_WOUT); g.K = D; E.scale = 1.f; E.ssout = SS_(5); }
            if (rep) E.scale = 0.f;
            if (f < 4 && G == 256) {
                f32x4* slab = (f32x4*)(ws + WS_BIG + SZ_ACT);
                pg8::SplitOrder S; S.init(MPAD / 256, 4, G, c, g.K);
                pg8::gemm_phase(lds, g, S, E, cx.tid, slab);
                if (rep == 0 && f == 0 && c >= 140) {
                    convert(ldsf, cx, T_RKV, 0, (bf16_t*)(ws + WS_WRKV), c - 140, G - 140);
                    convert(ldsf, cx, T_L2, 0, (bf16_t*)(ws + WS_WL2), c - 140, G - 140);
                    convert(ldsf, cx, T_PLAIN, 26, (bf16_t*)(ws + WS_WO), c - 140, G - 140);
                }
                xcd_barrier((unsigned*)(ws + WS_BAR), bst, cx.tid, (unsigned)G);
                if (c < 160) {
                    const int lt = c >> 3;
                    pg8::Unit u; S.tile(256 + lt, u);
                    int t_ = cx.tid; asm volatile("" : "+v"(t_));
                    const int wid = t_ >> 6, lane = t_ & 63, wr = wid >> 2, wc = wid & 3, fr = lane & 15, fq = lane >> 4;
                    const f32x4* sp = slab + (size_t)(lt * 7) * 32 * 512 + t_;
                    const int row0 = u.pm * 256 + wr * 64 + fr, col0 = u.pn * 256 + wc * 32 + 8 * fq;
                    {
                        const int am = c & 7;
                        const int ai = am >> 2, m = am & 3, r = row0 + ai * 128 + m * 16;
                        f32x4 a[2][2];
#pragma unroll
                        for (int bj = 0; bj < 2; ++bj)
#pragma unroll
                            for (int n = 0; n < 2; ++n) {
                                const int idx = ((ai * 2 + bj) * 4 + m) * 2 + n;
                                f32x4 t = sp[(size_t)idx * 512];
#pragma unroll
                                for (int part = 1; part < 7; ++part) t += sp[(size_t)(part * 32 + idx) * 512];
                                a[bj][n] = t;
                            }
                        float ssum = 0.f;
#pragma unroll
                        for (int bj = 0; bj < 2; ++bj) {
                            bf16_t* xp = E.XB + (size_t)r * D + col0 + bj * 128;
                            float o[8]; unpack8(*(const u32x4*)xp, o);
#pragma unroll
                            for (int jj = 0; jj < 4; ++jj) { o[jj] += a[bj][0][jj] * E.scale; o[4 + jj] += a[bj][1][jj] * E.scale; }
                            *(u32x4*)xp = pack8(o);
#pragma unroll
                            for (int jj = 0; jj < 8; ++jj) ssum += o[jj] * o[jj];
                        }
                        ssum += __shfl_xor(ssum, 16); ssum += __shfl_xor(ssum, 32);
                        if (fq == 0) E.ssout[(size_t)r * 16 + u.pn * 4 + wc] = ssum;
                    }
                }
            } else {
            pg8::StaticOrder S; S.init(MPAD / 256, 4, G, c, g.K);
            pg8::gemm_phase(lds, g, S, E, cx.tid);
            if (rep == 0) {
            const int nbusy = (MPAD / 256) * 4 - G;
            if (G > 2 * nbusy && nbusy >= 0) {
                if (c >= nbusy) {
                    const int wg = c - nbusy, nwg = G - nbusy;
                    if (f == 4) {
                        convert(ldsf, cx, T_GU, 1, (bf16_t*)(ws + WS_SLOTB), wg, nwg);
                        convert(ldsf, cx, T_DN, 1, (bf16_t*)(ws + WS_SLOTB + SZ_GU), wg, nwg);
                        convert(ldsf, cx, T_GU, 2, (bf16_t*)(ws + WS_SLOTA), wg, nwg);
                        convert(ldsf, cx, T_DN, 2, (bf16_t*)(ws + WS_SLOTA + SZ_GU), wg, nwg);
                        convert(ldsf, cx, T_WIN, 0, (bf16_t*)(ws + WS_WIN), wg, nwg);
                        convert(ldsf, cx, T_PLAIN, 29, (bf16_t*)(ws + WS_WOUT), wg, nwg);
                    } else if (f == 2 || (f == 5 && G == 256)) {
                        convert(ldsf, cx, T_GU, 3, (bf16_t*)(ws + WS_SLOTB), wg, nwg);
                        convert(ldsf, cx, T_DN, 3, (bf16_t*)(ws + WS_SLOTB + SZ_GU), wg, nwg);
                    }
                }
            } else {
                if (f == 4) {
                    convert(ldsf, cx, T_GU, 1, (bf16_t*)(ws + WS_SLOTB), c, G);
                    convert(ldsf, cx, T_DN, 1, (bf16_t*)(ws + WS_SLOTB + SZ_GU), c, G);
                    convert(ldsf, cx, T_GU, 2, (bf16_t*)(ws + WS_SLOTA), c, G);
                    convert(ldsf, cx, T_DN, 2, (bf16_t*)(ws + WS_SLOTA + SZ_GU), c, G);
                    convert(ldsf, cx, T_WIN, 0, (bf16_t*)(ws + WS_WIN), c, G);
                    convert(ldsf, cx, T_PLAIN, 29, (bf16_t*)(ws + WS_WOUT), c, G);
                } else if (f == 2) {
                    convert(ldsf, cx, T_GU, 3, (bf16_t*)(ws + WS_SLOTB), c, G);
                    convert(ldsf, cx, T_DN, 3, (bf16_t*)(ws + WS_SLOTB + SZ_GU), c, G);
                }
            }
            }
            }
        } else if (kind == 3) {
            phase_mix(cx, XB_, SS_(1), (bf16_t*)(ws + B_HH));
        } else if (kind == 4) {
            pg8::Gemm g; g.A = (const bf16_t*)(ws + B_HH); g.Bt = (const bf16_t*)(ws + WS_WRKV); g.K = 2048;
            pg8::StaticOrder S; S.init(MPAD / 256, 14, G, c, g.K);
            EpiRKV E; E.ws = ws; E.dob = dob;
            pg8::gemm_phase(lds, g, S, E, cx.tid);
        } else if (kind == 5) {
            pg8::Gemm g; g.A = (const bf16_t*)(dob + DO_L1); g.Bt = (const bf16_t*)(ws + WS_WL2); g.K = 384;
            pg8::L2Order S; S.init(MPAD / 256, 12, G, c, g.K);
            EpiL2 E; E.ws = ws; E.w0 = cx.p->in[13]; E.a0 = cx.p->in[16];
            pg8::gemm_phase(lds, g, S, E, cx.tid);
        } else if (kind == 6) {
            ScanBufs sbf; sbf.R = (const bf16_t*)(ws + B_R); sbf.K = (const bf16_t*)(ws + B_K); sbf.V = (const bf16_t*)(dob + DO_XB); sbf.LW = (const bf16_t*)(ws + B_LW);
            sbf.A = (const bf16_t*)(ws + B_A); sbf.YP = (bf16_t*)(dob + DO_YPR); sbf.YS = (bf16_t*)(ws + L_YS); sbf.CB = (float*)(ws + WS_X + ROWB);
            phase_scan(ldsf, cx, sbf);
        } else if (kind == 7) {
            phase_post(cx, (const bf16_t*)(dob + DO_YPR), (const bf16_t*)(ws + L_YS), (const float*)(ws + WS_X + ROWB), (const bf16_t*)(dob + DO_XB),
                       (const bf16_t*)(ws + L_G), (bf16_t*)(ws + B_O));
        } else if (kind == 8) {
            pg8::Gemm g; g.A = XB_; g.Bt = (const bf16_t*)(ws + WS_WIN); g.K = D;
            pg8::StaticOrder S; S.init(MPAD / 256, 12, G, c, g.K);
            EpiCI E; E.ss = SS_(4); E.U = (bf16_t*)(ws + B_U); E.GB = (bf16_t*)(ws + B_GB); E.out = cx.p->out;
            pg8::gemm_phase(lds, g, S, E, cx.tid);
        } else if (kind == 9) {
            phase_conv(cx, (const bf16_t*)(ws + B_U), (const bf16_t*)(ws + B_GB), (bf16_t*)(ws + B_CV));
        } else {
            phase_final(cx, XB_, SS_(6));
        }
        if (ph < 18) xcd_barrier((unsigned*)(ws + WS_BAR), bst, cx.tid, (unsigned)G);
        }
    }
}

extern "C" void kernel_launch(void* const* d_in, const int* in_sizes, int n_in, void* d_out, int out_size, void* d_ws, size_t ws_size, hipStream_t stream) {
    static int grid_blocks = 0;
    if (grid_blocks == 0) {
        if (n_in != 30 || (size_t)out_size != O_END || ws_size < WS_END) {
            fprintf(stderr, "kernel_launch: unexpected shapes: n_in %d out_size %d ws_size %zu (need %zu)\n", n_in, out_size, ws_size, (size_t)WS_END);
            grid_blocks = -1; return;
        }
        int dev = 0, cus = 0, per_cu = 0;
        (void)hipGetDevice(&dev);
        (void)hipDeviceGetAttribute(&cus, hipDeviceAttributeMultiprocessorCount, dev);
        (void)hipFuncSetAttribute((const void*)mega, hipFuncAttributeMaxDynamicSharedMemorySize, LDS_BYTES);
        (void)hipOccupancyMaxActiveBlocksPerMultiprocessor(&per_cu, (const void*)mega, NTHREADS, LDS_BYTES);
        if (per_cu < 1) per_cu = 1;
        grid_blocks = cus * per_cu;
        if (grid_blocks > 256) grid_blocks = 256;
    }
    if (grid_blocks < 0) return;
    (void)hipMemsetAsync((char*)d_ws, 0, WS_CTL_END, stream);
    Params p{};
    for (int i = 0; i < 30; ++i) p.in[i] = (const float*)d_in[i];
    p.out = (float*)d_out; p.ws = (unsigned char*)d_ws;
    void* args[] = {&p};
    hipError_t e = hipLaunchCooperativeKernel((const void*)mega, dim3(grid_blocks), dim3(NTHREADS), args, LDS_BYTES, stream);
    if (e != hipSuccess) fprintf(stderr, "cooperative launch failed: %s (grid %d)\n", hipGetErrorString(e), grid_blocks);
}
```

```cpp
#include <hip/hip_runtime.h>
#include <hip/hip_cooperative_groups.h>
#include <cstdio>
#include <cstdint>
namespace cg = cooperative_groups;

#define LAS __attribute__((address_space(3)))
typedef unsigned short bf16_t;
typedef short bf16x8 __attribute__((ext_vector_type(8)));
typedef float f32x4 __attribute__((ext_vector_type(4)));
typedef float f32x2 __attribute__((ext_vector_type(2)));
typedef unsigned u32x4 __attribute__((ext_vector_type(4)));
typedef unsigned u32x2 __attribute__((ext_vector_type(2)));

constexpr int D = 1024, FF = 2816, NH = 16;
constexpr int PB = 8, PT = 2064, NMETA = 16, PTX = 2048, SBN = 128, STN = 8;
constexpr int MP = PB * PT;
constexpr int MS = SBN * STN;
constexpr int M = MP + MS;
constexpr int MPAD = 17664;
constexpr int NTHREADS = 512;
constexpr int LDS_BYTES = 131072 + 16;

constexpr size_t O_YP = 0;
constexpr size_t O_YS = O_YP + (size_t)PB * PTX * D;
constexpr size_t O_WKVP = O_YS + (size_t)MS * D;
constexpr size_t O_SHP = O_WKVP + (size_t)PB * NH * 64 * 64;
constexpr size_t O_CVP = O_SHP + (size_t)PB * D;
constexpr size_t O_WKVS = O_CVP + (size_t)PB * 2 * D;
constexpr size_t O_SHS = O_WKVS + (size_t)SBN * NH * 64 * 64;
constexpr size_t O_CVS = O_SHS + (size_t)SBN * D;
constexpr size_t O_END = O_CVS + (size_t)SBN * 2 * D;

constexpr size_t AL(size_t x) { return (x + 255) & ~(size_t)255; }
constexpr size_t ROWB = (size_t)MPAD * D * 2;
constexpr size_t WS_BAR = 0;
constexpr size_t WS_CTL_END = 16384;
constexpr size_t WS_SS = 16384;
constexpr size_t WS_SS_END = AL(WS_SS + (size_t)MPAD * 16 * 4);
constexpr size_t WS_X = WS_SS_END;
constexpr size_t WS_MISC = AL(WS_X + (size_t)MPAD * D * 4);
constexpr size_t SZ_WRKV = (size_t)3584 * 2048 * 2;
constexpr size_t SZ_WL2 = (size_t)3072 * 384 * 2;
constexpr size_t SZ_W1K = (size_t)1024 * 1024 * 2;
constexpr size_t WS_WRKV = WS_MISC;
constexpr size_t WS_WL2 = AL(WS_WRKV + SZ_WRKV);
constexpr size_t WS_WO = AL(WS_WL2 + SZ_WL2);
constexpr size_t WS_BIG = AL(WS_WO + SZ_W1K);
constexpr size_t SZ_BIG = (size_t)MPAD * 2048 * 2 * 2 + 4096;
constexpr size_t WS_LAZY = AL(WS_BIG + SZ_BIG);
constexpr size_t SZ_GU = (size_t)5632 * 1024 * 2;
constexpr size_t SZ_DN = (size_t)1024 * 2816 * 2;
constexpr size_t SZ_SLOT = SZ_GU + SZ_DN;
constexpr size_t WS_SLOTA = WS_LAZY;
constexpr size_t WS_SLOTB = WS_SLOTA + SZ_SLOT;
constexpr size_t WS_WIN = WS_SLOTB + SZ_SLOT;
constexpr size_t WS_WOUT = WS_WIN + (size_t)3072 * 1024 * 2;
constexpr size_t WS_END = WS_WOUT + SZ_W1K;
constexpr size_t B_ACT = WS_BIG;
constexpr size_t B_HH = WS_BIG;
constexpr size_t B_R = WS_BIG + 2 * ROWB;
constexpr size_t B_K = WS_BIG + 3 * ROWB;
constexpr size_t B_LW = WS_BIG;
constexpr size_t B_A = WS_BIG + ROWB;
constexpr size_t B_O = WS_BIG;
constexpr size_t B_U = WS_BIG;
constexpr size_t B_GB = WS_BIG + ROWB;
constexpr size_t B_CV = WS_BIG + 2 * ROWB;
constexpr size_t DO_XB = 0;
constexpr size_t DO_L1 = ROWB;
constexpr size_t DO_YPR = ROWB;
static_assert(DO_YPR + (size_t)MP * D * 2 <= O_WKVP * 4, "y-region overflow");
static_assert(DO_L1 + (size_t)MPAD * 384 * 2 <= O_WKVP * 4, "l1 overflow");
constexpr size_t L_G = WS_LAZY;
constexpr size_t L_YS = WS_LAZY + ROWB;
static_assert(L_YS + (size_t)MS * D * 2 <= WS_END, "lazy overflow");
constexpr size_t SZ_ACT = (size_t)MPAD * 2816 * 2;
static_assert(SZ_BIG >= SZ_ACT + (size_t)140 * 32 * 512 * 16, "ACT + split-K slab do not fit");

struct Params {
    const float* in[30];
    float* out;
    unsigned char* ws;
};
typedef const __attribute__((address_space(4))) Params* KP;
struct Ctx { KP p; int tid, bid, G; };

__device__ __forceinline__ unsigned cvt_pk_bf16(float lo, float hi) { unsigned r; asm volatile("v_cvt_pk_bf16_f32 %0, %1, %2" : "=v"(r) : "v"(lo), "v"(hi)); return r; }
__device__ __forceinline__ float bf_lo(unsigned v) { return __uint_as_float(v << 16); }
__device__ __forceinline__ float bf_hi(unsigned v) { return __uint_as_float(v & 0xffff0000u); }
__device__ __forceinline__ float frcp(float x) { return __builtin_amdgcn_rcpf(x); }
__device__ __forceinline__ float fsigmoid(float x) { return frcp(1.f + __expf(-x)); }
__device__ __forceinline__ void unpack8(u32x4 v, float* o) {
    o[0] = bf_lo(v[0]); o[1] = bf_hi(v[0]); o[2] = bf_lo(v[1]); o[3] = bf_hi(v[1]);
    o[4] = bf_lo(v[2]); o[5] = bf_hi(v[2]); o[6] = bf_lo(v[3]); o[7] = bf_hi(v[3]);
}
__device__ __forceinline__ u32x4 pack8(const float* o) {
    u32x4 r; r[0] = cvt_pk_bf16(o[0], o[1]); r[1] = cvt_pk_bf16(o[2], o[3]); r[2] = cvt_pk_bf16(o[4], o[5]); r[3] = cvt_pk_bf16(o[6], o[7]); return r;
}
template <int CTRL> __device__ __forceinline__ float dpp_f(float x) {
    return __int_as_float(__builtin_amdgcn_update_dpp(0, __float_as_int(x), CTRL, 0xF, 0xF, false));
}
__device__ __forceinline__ float allreduce16(float p) {
    p += dpp_f<0xB1>(p); p += dpp_f<0x4E>(p); p += dpp_f<0x124>(p); p += dpp_f<0x128>(p); return p;
}
__device__ __forceinline__ float allreduce8(float p) {
    p += dpp_f<0xB1>(p); p += dpp_f<0x4E>(p); p += __shfl_xor(p, 4); return p;
}
__device__ __forceinline__ float wave_sum(float p) {
#pragma unroll
    for (int o = 32; o >= 1; o >>= 1) p += __shfl_xor(p, o);
    return p;
}
__device__ __forceinline__ float row_rs(const float* ssp, int r) {
    const f32x4 a = *(const f32x4*)(ssp + (size_t)r * 16), b = *(const f32x4*)(ssp + (size_t)r * 16 + 4), c = *(const f32x4*)(ssp + (size_t)r * 16 + 8), d = *(const f32x4*)(ssp + (size_t)r * 16 + 12);
    const float s = ((a[0] + a[1]) + (a[2] + a[3])) + ((b[0] + b[1]) + (b[2] + b[3])) + ((c[0] + c[1]) + (c[2] + c[3])) + ((d[0] + d[1]) + (d[2] + d[3]));
    return rsqrtf(s * (1.f / 1024.f) + 1e-6f);
}
__device__ __forceinline__ void row_info(int m, int& t, int& T, int& seq) {
    if (m < MP) { seq = m / PT; t = m - seq * PT; T = PT; }
    else { const int q = m - MP; seq = 8 + (q >> 3); t = q & 7; T = STN; }
}

namespace pg8 {
constexpr int BM = 256, BK = 64, HALF = 128, HTB = HALF * BK * 2, STAGE_BYTES = 8 * HTB, NXCD = 8, WGM = 4;
__host__ __device__ __forceinline__ int lds_byte(int r, int c) { const int st = (r >> 4) * 2 + (c >> 5), rr = r & 15, cc = c & 31, ob = rr * 64 + cc * 2; return st * 1024 + (ob ^ (((ob >> 9) & 1) << 5)); }
__host__ __device__ __forceinline__ void stage_rc(int b, int& R, int& C) { const int st = b / 1024, sb = b % 1024, swz = sb ^ (((sb >> 9) & 1) << 5); R = (st >> 1) * 16 + swz / 64; C = (st & 1) * 32 + (swz % 64) / 2; }
__host__ __device__ __forceinline__ int perm32(int rho) { const int n = rho >> 4, i = rho & 15; return 8 * (i >> 2) + 4 * n + (i & 3); }

struct Unit { int pm, pn, k0, nt, sub; };
struct Gemm { const bf16_t* A; const bf16_t* Bt; int K; };
struct StaticOrder {
    int nM, nN, nwg, G, c;
    int ntK; int wgm;
    __device__ __forceinline__ void init(int nM_, int nN_, int G_, int c_, int K_) { nM = nM_; nN = nN_; nwg = nM * nN; G = G_; c = c_; ntK = K_ / BK; wgm = (nN_ == 22) ? 8 : 4; }
    __device__ __forceinline__ void tile(int L, Unit& u) const {
        int wgid = L; { const int q = nwg / NXCD, r = nwg % NXCD, xcd = wgid % NXCD, off = wgid / NXCD; wgid = (xcd < r ? xcd * (q + 1) : r * (q + 1) + (xcd - r) * q) + off; }
        const int nig = wgm * nN, gid = wgid / nig, fm = gid * wgm, gsz = (nM - fm) < wgm ? (nM - fm) : wgm;
        u.pm = fm + ((wgid % nig) % gsz); u.pn = (wgid % nig) / gsz; u.k0 = 0; u.nt = ntK; u.sub = -1;
    }
    __device__ __forceinline__ bool next(int i, Unit& u) const {
        const long L = (long)i * G + c; if (L >= nwg) return false;
        u.k0 = 0; u.nt = ntK; u.sub = -1;
        int wgid = (int)L; { const int q = nwg / NXCD, r = nwg % NXCD, xcd = wgid % NXCD, off = wgid / NXCD; wgid = (xcd < r ? xcd * (q + 1) : r * (q + 1) + (xcd - r) * q) + off; }
        const int nig = wgm * nN, gid = wgid / nig, fm = gid * wgm, gsz = (nM - fm) < wgm ? (nM - fm) : wgm;
        u.pm = fm + ((wgid % nig) % gsz); u.pn = (wgid % nig) / gsz; return true;
    }
};

struct SplitOrder : StaticOrder {
    __device__ __forceinline__ bool next(int i, Unit& u) const {
        if (i == 0) { tile(c, u); return true; }
        if (i == 1 && c < 140) { tile(256 + c / 7, u); const int part = c % 7; u.k0 = part * 6; u.nt = part == 6 ? 8 : 6; u.sub = c; return true; }
        return false;
    }
};
struct L2Order : StaticOrder {
    __device__ __forceinline__ bool next(int i, Unit& u) const {
        if (!StaticOrder::next(i, u)) return false;
        if (u.pn < 8) { u.k0 = 0; u.nt = 2; } else { u.k0 = 2; u.nt = 4; }
        return true;
    }
};
template <class Epi, class Sched>
__device__ __forceinline__ void gemm_phase(LAS unsigned char* lds, const Gemm g, const Sched& S, const Epi& E, const int tid_, u32x4* slab = nullptr) {
    const int tid = tid_, wid = __builtin_amdgcn_readfirstlane(tid >> 6), lane = tid & 63, wr = wid >> 2, wc = wid & 3, fr = lane & 15, fq = lane >> 4;
    const int K = g.K;
    unsigned voffA[2], voffB[2];
#pragma unroll
    for (int i = 0; i < 2; ++i) { int R, C; stage_rc(tid * 16 + i * 8192, R, C); const int Rb = (R & ~31) + perm32(R & 31);
        voffA[i] = (unsigned)(R * K + C) * 2u; voffB[i] = (unsigned)(Rb * K + C) * 2u; }
    const size_t kstep = (size_t)(BK * 2);
    const size_t hstep = (size_t)HALF * K * 2;
    const size_t tstep = 2 * hstep;
    const unsigned ldsw = (unsigned)wid * 1024u;
    const int aoff = lds_byte(wr * 64 + fr, fq * 8), boff = lds_byte(wc * 32 + fr, fq * 8);
#define PG8_SA(b, h) (((b) * 2 + (h)) * HTB)
#define PG8_SB(b, h) ((4 + (b) * 2 + (h)) * HTB)
#define PG8_STAGE(bufoff, gbase, voff) do { _Pragma("unroll") for (int _i = 0; _i < 2; ++_i) \
        __builtin_amdgcn_global_load_lds((const unsigned*)((const char*)(gbase) + (voff)[_i]), (LAS unsigned*)(lds + (bufoff) + ldsw + _i * 8192), 16, 0, 0); } while (0)
#define PG8_LDA(dst, b, h) do { _Pragma("unroll") for (int m = 0; m < 4; ++m) _Pragma("unroll") for (int k = 0; k < 2; ++k) dst[m][k] = *(const LAS bf16x8*)(lds + PG8_SA(b, h) + aoff + m * 2048 + k * 1024); } while (0)
#define PG8_LDB(dst, b, h) do { _Pragma("unroll") for (int n = 0; n < 2; ++n) _Pragma("unroll") for (int k = 0; k < 2; ++k) dst[n][k] = *(const LAS bf16x8*)(lds + PG8_SB(b, h) + boff + n * 2048 + k * 1024); } while (0)
#define PG8_MMA(ai, bj, At, Bt) do { __builtin_amdgcn_s_setprio(1); _Pragma("unroll") for (int m = 0; m < 4; ++m) _Pragma("unroll") for (int n = 0; n < 2; ++n) _Pragma("unroll") for (int k = 0; k < 2; ++k) \
        acc[ai][bj][m][n] = __builtin_amdgcn_mfma_f32_16x16x32_bf16(Bt[n][k], At[m][k], acc[ai][bj][m][n], 0, 0, 0); __builtin_amdgcn_s_setprio(0); } while (0)
#define PG8_WAIT_V(n) asm volatile("s_waitcnt vmcnt(" #n ")" ::: "memory")
#define PG8_WAIT_L(n) asm volatile("s_waitcnt lgkmcnt(" #n ")" ::: "memory")
#define PG8_BAR __builtin_amdgcn_s_barrier()
#define PG8_SCHED __builtin_amdgcn_sched_barrier(0)
    Unit cur, nxt; int ui = 0;
    if (!S.next(0, cur)) return;
    f32x4 acc[2][2][4][2];
#pragma unroll
    for (int a = 0; a < 2; ++a)
#pragma unroll
        for (int b = 0; b < 2; ++b)
#pragma unroll
            for (int m = 0; m < 4; ++m)
#pragma unroll
                for (int n = 0; n < 2; ++n) acc[a][b][m][n] = (f32x4){0.f, 0.f, 0.f, 0.f};
    bf16x8 At[4][2], B0[2][2], B1[2][2];
    const char* cA = (const char*)g.A + (size_t)cur.pm * tstep + (size_t)cur.k0 * kstep; const char* cB = (const char*)g.Bt + (size_t)cur.pn * tstep + (size_t)cur.k0 * kstep;
    PG8_STAGE(PG8_SB(0, 0), cB, voffB); PG8_STAGE(PG8_SA(0, 0), cA, voffA); PG8_STAGE(PG8_SB(0, 1), cB + hstep, voffB); PG8_STAGE(PG8_SA(0, 1), cA + hstep, voffA);
    if (wr == 1) PG8_BAR;
    PG8_WAIT_V(4); PG8_BAR;
    PG8_STAGE(PG8_SB(1, 0), cB + kstep, voffB); PG8_STAGE(PG8_SA(1, 0), cA + kstep, voffA); PG8_STAGE(PG8_SB(1, 1), cB + hstep + kstep, voffB);
    PG8_WAIT_V(6); PG8_BAR;
    for (;;) {
        const bool has_next = S.next(ui + 1, nxt);
        const char* nA = has_next ? (const char*)g.A + (size_t)nxt.pm * tstep + (size_t)nxt.k0 * kstep : cA; const char* nB = has_next ? (const char*)g.Bt + (size_t)nxt.pn * tstep + (size_t)nxt.k0 * kstep : cB;
        const int nt = cur.nt;
        for (int t = 0; t < nt; t += 2) {
            const bool last = (t == nt - 2);
            const char* a1 = cA + (size_t)(t + 1) * kstep;
            const char* a2 = last ? nA : cA + (size_t)(t + 2) * kstep; const char* b2 = last ? nB : cB + (size_t)(t + 2) * kstep;
            const char* a3 = a2 + kstep; const char* b3 = b2 + kstep;
            PG8_LDB(B0, 0, 0); PG8_SCHED; PG8_LDA(At, 0, 0); PG8_STAGE(PG8_SA(1, 1), a1 + hstep, voffA);
            PG8_WAIT_L(8); PG8_BAR; PG8_WAIT_L(0); PG8_MMA(0, 0, At, B0); PG8_BAR; PG8_SCHED;
            PG8_LDB(B1, 0, 1); PG8_STAGE(PG8_SB(0, 0), b2, voffB);
            PG8_BAR; PG8_WAIT_L(0); PG8_MMA(0, 1, At, B1); PG8_BAR;
            PG8_LDA(At, 0, 1); PG8_STAGE(PG8_SA(0, 0), a2, voffA);
            PG8_BAR; PG8_WAIT_L(0); PG8_MMA(1, 0, At, B0); PG8_BAR; PG8_SCHED;
            PG8_STAGE(PG8_SB(0, 1), b2 + hstep, voffB);
            PG8_WAIT_V(6); PG8_BAR; PG8_MMA(1, 1, At, B1); PG8_BAR;
            PG8_LDB(B0, 1, 0); PG8_SCHED; PG8_LDA(At, 1, 0); PG8_STAGE(PG8_SA(0, 1), a2 + hstep, voffA);
            PG8_WAIT_L(8); PG8_BAR; PG8_WAIT_L(0); PG8_MMA(0, 0, At, B0); PG8_BAR; PG8_SCHED;
            PG8_LDB(B1, 1, 1); PG8_STAGE(PG8_SB(1, 0), b3, voffB);
            PG8_BAR; PG8_WAIT_L(0); PG8_MMA(0, 1, At, B1); PG8_BAR;
            PG8_LDA(At, 1, 1); PG8_STAGE(PG8_SA(1, 0), a3, voffA);
            PG8_BAR; PG8_WAIT_L(0); PG8_MMA(1, 0, At, B0); PG8_BAR; PG8_SCHED;
            PG8_STAGE(PG8_SB(1, 1), b3 + hstep, voffB);
            PG8_WAIT_V(6); PG8_BAR; PG8_MMA(1, 1, At, B1); PG8_BAR;
        }
        if (cur.sub < 0) { int fr_ = fr, fq_ = fq; asm volatile("" : "+v"(fr_), "+v"(fq_)); E(acc, cur, wr, wc, fr_, fq_); }
        else {
            int t_ = tid; asm volatile("" : "+v"(t_));
            u32x4* sp = slab + (size_t)cur.sub * 16 * 512 + t_;
#pragma unroll
            for (int a = 0; a < 2; ++a)
#pragma unroll
                for (int b = 0; b < 2; ++b)
#pragma unroll
                    for (int m = 0; m < 4; ++m) {
                        float o[8] = {acc[a][b][m][0][0], acc[a][b][m][0][1], acc[a][b][m][0][2], acc[a][b][m][0][3], acc[a][b][m][1][0], acc[a][b][m][1][1], acc[a][b][m][1][2], acc[a][b][m][1][3]};
                        sp[(size_t)((a * 2 + b) * 4 + m) * 512] = pack8(o);
                    }
        }
        if (!has_next) break;
#pragma unroll
        for (int a = 0; a < 2; ++a)
#pragma unroll
            for (int b = 0; b < 2; ++b)
#pragma unroll
                for (int m = 0; m < 4; ++m)
#pragma unroll
                    for (int n = 0; n < 2; ++n) acc[a][b][m][n] = (f32x4){0.f, 0.f, 0.f, 0.f};
        cur = nxt; cA = nA; cB = nB; ++ui;
    }
    PG8_WAIT_V(0);
    if (wr == 0) PG8_BAR;
    PG8_BAR;
#undef PG8_SA
#undef PG8_SB
#undef PG8_STAGE
#undef PG8_LDA
#undef PG8_LDB
#undef PG8_MMA
#undef PG8_WAIT_V
#undef PG8_WAIT_L
#undef PG8_BAR
#undef PG8_SCHED
}
}
using pg8::Unit;

__device__ __forceinline__ void rows_rs8(const float* ss, int row0  , int fq, float (&rsv)[8]) {
    f32x4 part[8];
#pragma unroll
    for (int i = 0; i < 8; ++i) part[i] = *(const f32x4*)(ss + (size_t)(row0 + (i >> 2) * 128 + (i & 3) * 16) * 16 + 4 * fq);
#pragma unroll
    for (int i = 0; i < 8; ++i) {
        float t = (part[i][0] + part[i][1]) + (part[i][2] + part[i][3]);
        t += __shfl_xor(t, 16); t += __shfl_xor(t, 32);
        rsv[i] = rsqrtf(t * (1.f / 1024.f) + 1e-6f);
    }
}
struct EpiGU {
    const float* ss; bf16_t* act;
    __device__ __forceinline__ void operator()(const f32x4 (&acc)[2][2][4][2], const Unit& u, int wr, int wc, int fr, int fq) const {
        const int col = u.pn * 128 + wc * 32 + 8 * fq;
        const int row0 = u.pm * 256 + wr * 64 + fr;
        float rsv[8]; rows_rs8(ss, row0, fq, rsv);
#pragma unroll
        for (int ai = 0; ai < 2; ++ai)
#pragma unroll
            for (int m = 0; m < 4; ++m) {
                const int r = row0 + ai * 128 + m * 16;
                const float rs = rsv[ai * 4 + m];
                float o[8];
#pragma unroll
                for (int n = 0; n < 2; ++n) {
                    const f32x4 gt = acc[ai][0][m][n] * rs, gu = gt * (acc[ai][1][m][n] * rs), ex = gt * (-1.44269504089f);
                    f32x4 den; den[0] = __builtin_amdgcn_exp2f(ex[0]); den[1] = __builtin_amdgcn_exp2f(ex[1]); den[2] = __builtin_amdgcn_exp2f(ex[2]); den[3] = __builtin_amdgcn_exp2f(ex[3]);
                    den = den + 1.0f;
                    f32x4 rc; rc[0] = frcp(den[0]); rc[1] = frcp(den[1]); rc[2] = frcp(den[2]); rc[3] = frcp(den[3]);
                    const f32x4 res = gu * rc;
                    o[n * 4 + 0] = res[0]; o[n * 4 + 1] = res[1]; o[n * 4 + 2] = res[2]; o[n * 4 + 3] = res[3];
                }
                *(u32x4*)(act + (size_t)r * FF + col) = pack8(o);
            }
    }
};
struct EpiRes {
    bf16_t* XB; float* ssout; float scale;
    __device__ __forceinline__ void operator()(const f32x4 (&acc)[2][2][4][2], const Unit& u, int wr, int wc, int fr, int fq) const {
        const int row0 = u.pm * 256 + wr * 64 + fr, col0 = u.pn * 256 + wc * 32 + 8 * fq;
#pragma unroll
        for (int ai = 0; ai < 2; ++ai) {
            u32x4 xv[4][2];
#pragma unroll
            for (int m = 0; m < 4; ++m)
#pragma unroll
                for (int bj = 0; bj < 2; ++bj) xv[m][bj] = *(const u32x4*)(XB + (size_t)(row0 + ai * 128 + m * 16) * D + col0 + bj * 128);
#pragma unroll
            for (int m = 0; m < 4; ++m) {
                const int r = row0 + ai * 128 + m * 16;
                float ssum = 0.f;
#pragma unroll
                for (int bj = 0; bj < 2; ++bj) {
                    float o[8]; unpack8(xv[m][bj], o);
                    const f32x4 n0 = (f32x4){o[0], o[1], o[2], o[3]} + acc[ai][bj][m][0] * scale, n1 = (f32x4){o[4], o[5], o[6], o[7]} + acc[ai][bj][m][1] * scale;
                    o[0] = n0[0]; o[1] = n0[1]; o[2] = n0[2]; o[3] = n0[3]; o[4] = n1[0]; o[5] = n1[1]; o[6] = n1[2]; o[7] = n1[3];
                    *(u32x4*)(XB + (size_t)r * D + col0 + bj * 128) = pack8(o);
                    const f32x4 sq = n0 * n0 + n1 * n1;
                    ssum += (sq[0] + sq[1]) + (sq[2] + sq[3]);
                }
                ssum += __shfl_xor(ssum, 16); ssum += __shfl_xor(ssum, 32);
                if (fq == 0) ssout[(size_t)r * 16 + u.pn * 4 + wc] = ssum;
            }
        }
    }
};
struct EpiRKV {
    unsigned char* ws; unsigned char* dob;
    __device__ __forceinline__ void operator()(const f32x4 (&acc)[2][2][4][2], const Unit& u, int wr, int wc, int fr, int fq) const {
        if (u.pn < 12) {
            bf16_t* base = (u.pn < 8) ? (bf16_t*)(ws + B_R + (size_t)(u.pn >> 2) * ROWB) : (bf16_t*)(dob + DO_XB);
#pragma unroll
            for (int ai = 0; ai < 2; ++ai)
#pragma unroll
                for (int m = 0; m < 4; ++m) {
                    const int row = u.pm * 256 + ai * 128 + wr * 64 + m * 16 + fr;
#pragma unroll
                    for (int bj = 0; bj < 2; ++bj) {
                        const int c = (u.pn & 3) * 256 + bj * 128 + wc * 32 + 8 * fq;
                        float o[8] = {acc[ai][bj][m][0][0], acc[ai][bj][m][0][1], acc[ai][bj][m][0][2], acc[ai][bj][m][0][3], acc[ai][bj][m][1][0], acc[ai][bj][m][1][1], acc[ai][bj][m][1][2], acc[ai][bj][m][1][3]};
                        *(u32x4*)(base + (size_t)row * D + c) = pack8(o);
                    }
                }
        } else {
#pragma unroll
            for (int ai = 0; ai < 2; ++ai)
#pragma unroll
                for (int m = 0; m < 4; ++m) {
                    const int row = u.pm * 256 + ai * 128 + wr * 64 + m * 16 + fr;
#pragma unroll
                    for (int bj = 0; bj < 2; ++bj) {
                        const int c = (u.pn - 12) * 256 + bj * 128 + wc * 32 + 8 * fq;
                        if (c >= 384) continue;
                        float o[8];
#pragma unroll
                        for (int n = 0; n < 2; ++n)
#pragma unroll
                            for (int j = 0; j < 4; ++j) {
                                const float a = acc[ai][bj][m][n][j]; float val;
                                if (c < 64) val = 1.f - 2.f * frcp(1.f + __expf(2.f * a));
                                else if (c < 128) val = a;
                                else if (c < 288) val = fsigmoid(a);
                                else val = 0.f;
                                o[n * 4 + j] = val;
                            }
                        *(u32x4*)((bf16_t*)(dob + DO_L1) + (size_t)row * 384 + c) = pack8(o);
                    }
                }
        }
    }
};
struct EpiL2 {
    unsigned char* ws; const float* w0; const float* a0;
    __device__ __forceinline__ void operator()(const f32x4 (&acc)[2][2][4][2], const Unit& u, int wr, int wc, int fr, int fq) const {
        const int kind = u.pn >> 2;
        bf16_t* base = (bf16_t*)(ws + (kind == 2 ? L_G : B_LW + (size_t)kind * ROWB));
        const float* bsrc = kind == 0 ? w0 : a0;
        const float bmul = kind == 2 ? 0.f : 1.f;
        f32x4 bvv[2][2];
#pragma unroll
        for (int bj = 0; bj < 2; ++bj)
#pragma unroll
            for (int n = 0; n < 2; ++n) bvv[bj][n] = *(const f32x4*)(bsrc + (u.pn & 3) * 256 + bj * 128 + wc * 32 + 8 * fq + 4 * n) * bmul;
#pragma unroll
        for (int ai = 0; ai < 2; ++ai)
#pragma unroll
            for (int m = 0; m < 4; ++m) {
                const int row = u.pm * 256 + ai * 128 + wr * 64 + m * 16 + fr;
#pragma unroll
                for (int bj = 0; bj < 2; ++bj) {
                    const int c = (u.pn & 3) * 256 + bj * 128 + wc * 32 + 8 * fq;
                    float o[8];
#pragma unroll
                    for (int n = 0; n < 2; ++n) {
                        const f32x4 z = acc[ai][bj][m][n] + bvv[bj][n];
                        f32x4 res = z;
                        if (kind < 2) {
                            const f32x4 ex = z * (-1.44269504089f);
                            f32x4 den; den[0] = __builtin_amdgcn_exp2f(ex[0]); den[1] = __builtin_amdgcn_exp2f(ex[1]); den[2] = __builtin_amdgcn_exp2f(ex[2]); den[3] = __builtin_amdgcn_exp2f(ex[3]);
                            den = den + 1.0f;
                            res[0] = frcp(den[0]); res[1] = frcp(den[1]); res[2] = frcp(den[2]); res[3] = frcp(den[3]);
                            res = res * (kind == 0 ? -0.60653065971f : 1.0f);
                        }
                        o[n * 4 + 0] = res[0]; o[n * 4 + 1] = res[1]; o[n * 4 + 2] = res[2]; o[n * 4 + 3] = res[3];
                    }
                    *(u32x4*)(base + (size_t)row * D + c) = pack8(o);
                }
            }
    }
};
struct EpiCI {
    const float* ss; bf16_t* U; bf16_t* GB; float* out;
    __device__ __forceinline__ void operator()(const f32x4 (&acc)[2][2][4][2], const Unit& u, int wr, int wc, int fr, int fq) const {
        float rsv[8]; rows_rs8(ss, u.pm * 256 + wr * 64 + fr, fq, rsv);
#pragma unroll
        for (int ai = 0; ai < 2; ++ai)
#pragma unroll
            for (int m = 0; m < 4; ++m) {
                const int row = u.pm * 256 + ai * 128 + wr * 64 + m * 16 + fr;
                const float rs = rsv[ai * 4 + m];
                if (u.pn < 8) {
                    const int c = u.pn * 128 + wc * 32 + 8 * fq;
                    float o[8];
#pragma unroll
                    for (int n = 0; n < 2; ++n)
#pragma unroll
                        for (int j = 0; j < 4; ++j) o[n * 4 + j] = (acc[ai][0][m][n][j] * rs) * (acc[ai][1][m][n][j] * rs);
                    *(u32x4*)(U + (size_t)row * D + c) = pack8(o);
                    if (row < M) {
                        int t, T, seq; row_info(row, t, T, seq);
                        if (t >= T - 2) {
                            float* op = (seq < 8) ? out + O_CVP + ((size_t)seq * 2 + (t - (T - 2))) * D + c : out + O_CVS + ((size_t)(seq - 8) * 2 + (t - (T - 2))) * D + c;
                            *(f32x4*)op = (f32x4){o[0], o[1], o[2], o[3]}; *(f32x4*)(op + 4) = (f32x4){o[4], o[5], o[6], o[7]};
                        }
                    }
                } else {
#pragma unroll
                    for (int bj = 0; bj < 2; ++bj) {
                        const int c = (u.pn - 8) * 256 + bj * 128 + wc * 32 + 8 * fq;
                        float o[8];
#pragma unroll
                        for (int n = 0; n < 2; ++n)
#pragma unroll
                            for (int j = 0; j < 4; ++j) o[n * 4 + j] = acc[ai][bj][m][n][j] * rs;
                        *(u32x4*)(GB + (size_t)row * D + c) = pack8(o);
                    }
                }
            }
    }
};

struct TSrc { const float* p; int ld; int vk; int vc; const float* scale; int smode; };
__device__ __forceinline__ void tblock(LAS float* tile, const TSrc s, bf16_t* dst  , int kdst, const int tid) {
    const int kr = tid >> 4, c4 = (tid & 15) * 4;
    __syncthreads();
#pragma unroll
    for (int hf = 0; hf < 2; ++hf) {
        const int k = kr + 32 * hf;
        f32x4 v = (f32x4){0.f, 0.f, 0.f, 0.f};
        if (k < s.vk && c4 < s.vc) {
            v = *(const f32x4*)(s.p + (size_t)k * s.ld + c4);
            if (s.smode) { float sc = s.scale[k]; if (s.smode == 2) sc = 1.f - sc; v *= sc; }
        }
        tile[k * 65 + c4 + 0] = v[0]; tile[k * 65 + c4 + 1] = v[1]; tile[k * 65 + c4 + 2] = v[2]; tile[k * 65 + c4 + 3] = v[3];
    }
    __syncthreads();
    const int n = tid >> 3, k8 = (tid & 7) * 8;
    float o[8];
#pragma unroll
    for (int j = 0; j < 8; ++j) o[j] = tile[(k8 + j) * 65 + n];
    *(u32x4*)(dst + (size_t)n * kdst + k8) = pack8(o);
}
enum { T_GU = 0, T_DN, T_RKV, T_L2, T_PLAIN, T_WIN };
__device__ __forceinline__ void convert(LAS float* tile, const Ctx& cx, int type, int f, bf16_t* dst, int wg, int nwg) {
    int Nd, Kd;
    switch (type) { case T_GU: Nd = 5632; Kd = 1024; break; case T_DN: Nd = 1024; Kd = 2816; break; case T_RKV: Nd = 3584; Kd = 2048; break;
                    case T_L2: Nd = 3072; Kd = 384; break; case T_WIN: Nd = 3072; Kd = 1024; break; default: Nd = 1024; Kd = 1024; break; }
    const int nkb = Kd / 64, nblk = (Nd / 64) * nkb;
    for (int blk = wg; blk < nblk; blk += nwg) {
        const int nb = blk / nkb, kb = blk - nb * nkb, n0 = nb * 64, kd0 = kb * 64;
        TSrc s; s.p = nullptr; s.ld = 0; s.vk = 0; s.vc = 0; s.scale = nullptr; s.smode = 0;
        if (type == T_GU) {
            const int pn = n0 >> 8, bj = (n0 >> 7) & 1, i0 = n0 & 127, c0 = bj * FF + 128 * pn + i0;
            s.p = cx.p->in[7] + (size_t)f * D * 2 * FF + (size_t)kd0 * (2 * FF) + c0; s.ld = 2 * FF; s.vk = 64; s.vc = 64; s.scale = cx.p->in[6] + f * D + kd0; s.smode = 1;
        } else if (type == T_DN) {
            s.p = cx.p->in[8] + (size_t)f * FF * D + (size_t)kd0 * D + n0; s.ld = D; s.vk = 64; s.vc = 64;
        } else if (type == T_RKV) {
            const int hf = kd0 >= 1024, ks = kd0 & 1023; s.smode = hf ? 1 : 2; s.vk = 64;
            if (n0 < 3072) { const int pj = n0 >> 10, c0 = n0 & 1023, mi = pj == 0 ? 0 : (pj == 1 ? 2 : 3);
                s.p = cx.p->in[12] + (size_t)pj * D * D + (size_t)ks * D + c0; s.ld = D; s.vc = 64; s.scale = cx.p->in[11] + mi * D + ks; }
            else { const int j0 = n0 - 3072;
                if (j0 < 64) { s.p = cx.p->in[14] + (size_t)ks * 64 + j0; s.ld = 64; s.vc = 64; s.scale = cx.p->in[11] + 1 * D + ks; }
                else if (j0 < 128) { s.p = cx.p->in[17] + (size_t)ks * 64 + (j0 - 64); s.ld = 64; s.vc = 64; s.scale = cx.p->in[11] + 4 * D + ks; }
                else if (j0 < 288) { const int c0 = j0 - 128; s.p = cx.p->in[19] + (size_t)ks * 160 + c0; s.ld = 160; s.vc = (160 - c0) < 64 ? (160 - c0) : 64; s.scale = cx.p->in[11] + 5 * D + ks; }
                else { s.vk = 0; s.vc = 0; s.smode = 0; s.p = cx.p->in[14]; } }
        } else if (type == T_L2) {
            s.p = cx.p->in[15];
            if (n0 < 1024) { if (kd0 == 0) { s.p = cx.p->in[15] + n0; s.ld = D; s.vk = 64; s.vc = 64; } }
            else if (n0 < 2048) { if (kd0 == 64) { s.p = cx.p->in[18] + (n0 - 1024); s.ld = D; s.vk = 64; s.vc = 64; } }
            else { if (kd0 >= 128 && kd0 < 288) { const int k0 = kd0 - 128; s.p = cx.p->in[20] + (size_t)k0 * D + (n0 - 2048); s.ld = D; s.vk = (160 - k0) < 64 ? (160 - k0) : 64; s.vc = 64; } }
        } else if (type == T_WIN) {
            int c0;
            if (n0 < 2048) { const int pn = n0 >> 8, bj = (n0 >> 7) & 1, i0 = n0 & 127; c0 = (bj == 0 ? 1024 : 2048) + 128 * pn + i0; } else c0 = n0 - 2048;
            s.p = cx.p->in[27] + (size_t)kd0 * 3072 + c0; s.ld = 3072; s.vk = 64; s.vc = 64; s.scale = cx.p->in[9] + D + kd0; s.smode = 1;
        } else {
            s.p = cx.p->in[f] + (size_t)kd0 * D + n0; s.ld = D; s.vk = 64; s.vc = 64;
        }
        tblock(tile, s, dst + (size_t)n0 * Kd + kd0, Kd, cx.tid);
    }
}

__device__ __forceinline__ void ld8f(const float* p, float* o) { const f32x4 a = *(const f32x4*)p, b = *(const f32x4*)(p + 4); o[0] = a[0]; o[1] = a[1]; o[2] = a[2]; o[3] = a[3]; o[4] = b[0]; o[5] = b[1]; o[6] = b[2]; o[7] = b[3]; }
__device__ __forceinline__ void ld8b(const bf16_t* p, float* o) { unpack8(*(const u32x4*)p, o); }
__device__ __forceinline__ void phase_x0(const Ctx& cx, bf16_t* XB, float* ss0) {
    const int wave = cx.tid >> 6, lane = cx.tid & 63;
    for (int m = cx.bid * 8 + wave; m < MPAD; m += cx.G * 8) {
        const float* src = nullptr;
        if (m < MP) { const int b = m / PT, t = m - b * PT; src = t < NMETA ? cx.p->in[5] + (size_t)t * D : cx.p->in[0] + ((size_t)b * PTX + (t - NMETA)) * D; }
        else if (m < M) src = cx.p->in[1] + (size_t)(m - MP) * D;
        float s = 0.f;
#pragma unroll
        for (int i = 0; i < 4; ++i) {
            const int c = lane * 4 + i * 256;
            f32x4 v = src ? *(const f32x4*)(src + c) : (f32x4){0.f, 0.f, 0.f, 0.f};
            u32x2 pk; pk[0] = cvt_pk_bf16(v[0], v[1]); pk[1] = cvt_pk_bf16(v[2], v[3]);
            *(u32x2*)(XB + (size_t)m * D + c) = pk;
            s += v[0] * v[0] + v[1] * v[1] + v[2] * v[2] + v[3] * v[3];
        }
        s = wave_sum(s);
        if (lane < 16) ss0[(size_t)m * 16 + lane] = lane == 0 ? s : 0.f;
    }
}
__device__ __forceinline__ void phase_mix(const Ctx& cx, const bf16_t* XB, const float* ss, bf16_t* HH) {
    const int c = (cx.tid & 127) * 8, sub = cx.tid >> 7;
    float g[8];
    { const f32x4 g0 = *(const f32x4*)(cx.p->in[9] + c), g1 = *(const f32x4*)(cx.p->in[9] + c + 4); g[0] = g0[0]; g[1] = g0[1]; g[2] = g0[2]; g[3] = g0[3]; g[4] = g1[0]; g[5] = g1[1]; g[6] = g1[2]; g[7] = g1[3]; }
    for (int m = cx.bid * 4 + sub; m < MPAD; m += cx.G * 4) {
        float hn[8], hp[8];
        if (m < M) {
            int t, T, seq; row_info(m, t, T, seq);
            const float rs = row_rs(ss, m);
            float xc[8]; ld8b(XB + (size_t)m * D + c, xc);
#pragma unroll
            for (int j = 0; j < 8; ++j) hn[j] = xc[j] * rs * g[j];
            if (t > 0) {
                const float rp = row_rs(ss, m - 1);
                float xp[8]; ld8b(XB + (size_t)(m - 1) * D + c, xp);
#pragma unroll
                for (int j = 0; j < 8; ++j) hp[j] = xp[j] * rp * g[j];
            } else if (seq >= 8) {
                const float* sp = cx.p->in[3] + (size_t)(seq - 8) * D + c;
                const f32x4 y0 = *(const f32x4*)sp, y1 = *(const f32x4*)(sp + 4);
#pragma unroll
                for (int j = 0; j < 4; ++j) { hp[j] = y0[j]; hp[4 + j] = y1[j]; }
            } else {
#pragma unroll
                for (int j = 0; j < 8; ++j) hp[j] = 0.f;
            }
            if (t == T - 1) {
                float* op = (seq < 8) ? cx.p->out + O_SHP + (size_t)seq * D + c : cx.p->out + O_SHS + (size_t)(seq - 8) * D + c;
                *(f32x4*)op = (f32x4){hn[0], hn[1], hn[2], hn[3]}; *(f32x4*)(op + 4) = (f32x4){hn[4], hn[5], hn[6], hn[7]};
            }
        } else {
#pragma unroll
            for (int j = 0; j < 8; ++j) { hn[j] = 0.f; hp[j] = 0.f; }
        }
        *(u32x4*)(HH + (size_t)m * 2048 + c) = pack8(hn);
        *(u32x4*)(HH + (size_t)m * 2048 + 1024 + c) = pack8(hp);
    }
}
__device__ __forceinline__ void phase_post(const Ctx& cx, const bf16_t* YP, const bf16_t* YS, const float* CB, const bf16_t* V, const bf16_t* G, bf16_t* O) {
    const int c = (cx.tid & 127) * 8, sub = cx.tid >> 7;
    float lnw[8], lnb[8];
    ld8f(cx.p->in[24] + c, lnw); ld8f(cx.p->in[25] + c, lnb);
    for (int m = cx.bid * 4 + sub; m < MPAD; m += cx.G * 4) {
        float o[8];
        if (m < M) {
            float y[8], v[8], g[8];
            ld8b((m < MP ? YP + (size_t)m * D : YS + (size_t)(m - MP) * D) + c, y);
            ld8b(V + (size_t)m * D + c, v); ld8b(G + (size_t)m * D + c, g);
            const float cb = CB[(size_t)m * NH + (c >> 6)];
            float s = 0.f;
#pragma unroll
            for (int j = 0; j < 8; ++j) s += y[j];
            s = allreduce8(s);
            const float mean = s * (1.f / 64.f);
            float vs = 0.f;
#pragma unroll
            for (int j = 0; j < 8; ++j) { y[j] -= mean; vs += y[j] * y[j]; }
            vs = allreduce8(vs);
            const float rstd = rsqrtf(vs * (1.f / 64.f) + 64e-5f);
#pragma unroll
            for (int j = 0; j < 8; ++j) o[j] = (y[j] * rstd * lnw[j] + lnb[j] + cb * v[j]) * g[j];
        } else {
#pragma unroll
            for (int j = 0; j < 8; ++j) o[j] = 0.f;
        }
        *(u32x4*)(O + (size_t)m * D + c) = pack8(o);
    }
}
__device__ __forceinline__ void phase_conv(const Ctx& cx, const bf16_t* U, const bf16_t* GB, bf16_t* CV) {
    const int c = (cx.tid & 127) * 8, sub = cx.tid >> 7;
    float w0[8], w1[8], w2[8];
    ld8f(cx.p->in[28] + c, w0); ld8f(cx.p->in[28] + D + c, w1); ld8f(cx.p->in[28] + 2 * D + c, w2);
    for (int m = cx.bid * 4 + sub; m < MPAD; m += cx.G * 4) {
        float o[8];
        if (m < M) {
            int t, T, seq; row_info(m, t, T, seq);
            float u2[8], u1[8], u0[8], gb[8];
            ld8b(U + (size_t)m * D + c, u2); ld8b(GB + (size_t)m * D + c, gb);
            if (t >= 1) ld8b(U + (size_t)(m - 1) * D + c, u1);
            else if (seq >= 8) ld8f(cx.p->in[4] + ((size_t)(seq - 8) * 2 + 1) * D + c, u1);
            else {
#pragma unroll
                for (int j = 0; j < 8; ++j) u1[j] = 0.f; }
            if (t >= 2) ld8b(U + (size_t)(m - 2) * D + c, u0);
            else if (seq >= 8) ld8f(cx.p->in[4] + ((size_t)(seq - 8) * 2 + t) * D + c, u0);
            else {
#pragma unroll
                for (int j = 0; j < 8; ++j) u0[j] = 0.f; }
#pragma unroll
            for (int j = 0; j < 8; ++j) o[j] = gb[j] * (w0[j] * u0[j] + w1[j] * u1[j] + w2[j] * u2[j]);
        } else {
#pragma unroll
            for (int j = 0; j < 8; ++j) o[j] = 0.f;
        }
        *(u32x4*)(CV + (size_t)m * D + c) = pack8(o);
    }
}
__device__ __forceinline__ void phase_final(const Ctx& cx, const bf16_t* XB, const float* ss) {
    const int wave = cx.tid >> 6, lane = cx.tid & 63;
    for (int m = cx.bid * 8 + wave; m < M; m += cx.G * 8) {
        float* dst;
        if (m < MP) { const int b = m / PT, t = m - b * PT; if (t < NMETA) continue; dst = cx.p->out + O_YP + ((size_t)b * PTX + (t - NMETA)) * D; }
        else dst = cx.p->out + O_YS + (size_t)(m - MP) * D;
        const float rs = row_rs(ss, m);
#pragma unroll
        for (int i = 0; i < 4; ++i) {
            const int c = lane * 4 + i * 256;
            const u32x2 xb = *(const u32x2*)(XB + (size_t)m * D + c); const f32x4 g = *(const f32x4*)(cx.p->in[10] + c);
            const f32x4 v = {bf_lo(xb[0]), bf_hi(xb[0]), bf_lo(xb[1]), bf_hi(xb[1])};
            *(f32x4*)(dst + c) = v * rs * g;
        }
    }
}

struct ScanBufs { const bf16_t* R; const bf16_t* K; const bf16_t* V; const bf16_t* LW; const bf16_t* A; bf16_t* YP; bf16_t* YS; float* CB; };
__device__ __forceinline__ void scan_item_info(int item, int& m0, int& T, int& h, int& half, int& sb) {
    if (item < 256) { const int b = item >> 5; h = (item >> 1) & 15; half = item & 1; m0 = b * PT; T = PT; sb = -1 - b; }
    else { const int q = item - 256; sb = q >> 5; h = (q >> 1) & 15; half = q & 1; m0 = MP + sb * STN; T = STN; }
}
__device__ __forceinline__ void phase_scan(LAS float* lds, const Ctx& cx, const ScanBufs B) {
    const int tid = cx.tid, G = cx.G;
    const int nitems = 256 + 4096;
    const bool consumer = tid < 256;
    const int rp = (tid >> 4) & 15, seg = tid & 15;
    const int ptid = tid - 256, tl = ptid >> 3, cs = ptid & 7;
    int ci = cx.bid, ct0 = 0, k = 0;
    f32x2 sA0 = {0.f, 0.f}, sA1 = {0.f, 0.f}, sB0 = {0.f, 0.f}, sB1 = {0.f, 0.f};
    f32x4 pf[4][2]; bool pf_valid = false;
#pragma unroll
    for (int q = 0; q < 4; ++q) { pf[q][0] = (f32x4){0.f, 0.f, 0.f, 0.f}; pf[q][1] = pf[q][0]; }

    auto prep = [&](int pi, int pt0, int buf) __attribute__((always_inline)) {
        LAS float* ob = lds + buf * 11264;
        int item, t;
        if (pi < 256) { item = pi; t = pt0 + tl; } else { item = pi + (tl >> 3) * G; t = tl & 7; }
        if (item < nitems) {
            int pm0, pT, ph, phalf, psb; scan_item_info(item, pm0, pT, ph, phalf, psb);
            if (t < pT) {
                const size_t o = (size_t)(pm0 + t) * D + ph * 64 + cs * 8;
                float kf[8], rf[8], af[8], wf[8];
                ld8b(B.K + o, kf); ld8b(B.R + o, rf); ld8b(B.A + o, af); ld8b(B.LW + o, wf);
                const u32x2 vv = *(const u32x2*)(B.V + (size_t)(pm0 + t) * D + ph * 64 + phalf * 32 + cs * 4);
                float kkc[8], kac[8];
                ld8f(cx.p->in[21] + ph * 64 + cs * 8, kkc); ld8f(cx.p->in[22] + ph * 64 + cs * 8, kac);
                float kk[8]; float n2 = 0.f;
#pragma unroll
                for (int j = 0; j < 8; ++j) { kk[j] = kf[j] * kkc[j]; n2 += kk[j] * kk[j]; }
                n2 = allreduce8(n2);
                const float inv = 1.f / fmaxf(sqrtf(n2), 1e-12f);
                float vd[8], vb[8], vk[8];
#pragma unroll
                for (int j = 0; j < 8; ++j) { kk[j] *= inv; vb[j] = kk[j] * af[j]; vk[j] = kf[j] * (1.f + (af[j] - 1.f) * kac[j]); vd[j] = __expf(wf[j]); }
                if (phalf == 0) {
                    float rkc[8]; ld8f(cx.p->in[23] + ph * 64 + cs * 8, rkc);
                    float cbv = 0.f;
#pragma unroll
                    for (int j = 0; j < 8; ++j) cbv += rf[j] * vk[j] * rkc[j];
                    cbv = allreduce8(cbv);
                    if (cs == 0) B.CB[(size_t)(pm0 + t) * NH + ph] = cbv;
                }
                LAS float* q = ob + tl * 64 + cs * 8;
                *(LAS f32x4*)(q) = (f32x4){vd[0], vd[1], vd[2], vd[3]}; *(LAS f32x4*)(q + 4) = (f32x4){vd[4], vd[5], vd[6], vd[7]};
                *(LAS f32x4*)(q + 2048) = (f32x4){kk[0], kk[1], kk[2], kk[3]}; *(LAS f32x4*)(q + 2048 + 4) = (f32x4){kk[4], kk[5], kk[6], kk[7]};
                *(LAS f32x4*)(q + 4096) = (f32x4){vb[0], vb[1], vb[2], vb[3]}; *(LAS f32x4*)(q + 4096 + 4) = (f32x4){vb[4], vb[5], vb[6], vb[7]};
                *(LAS f32x4*)(q + 6144) = (f32x4){vk[0], vk[1], vk[2], vk[3]}; *(LAS f32x4*)(q + 6144 + 4) = (f32x4){vk[4], vk[5], vk[6], vk[7]};
                *(LAS f32x4*)(q + 8192) = (f32x4){rf[0], rf[1], rf[2], rf[3]}; *(LAS f32x4*)(q + 8192 + 4) = (f32x4){rf[4], rf[5], rf[6], rf[7]};
                *(LAS f32x4*)(ob + 10240 + tl * 32 + cs * 4) = (f32x4){bf_lo(vv[0]), bf_hi(vv[0]), bf_lo(vv[1]), bf_hi(vv[1])};
            }
        }
    };
    auto yout = [&](int pi, int pt0, int ybuf) __attribute__((always_inline)) {
        int item, t;
        if (pi < 256) { item = pi; t = pt0 + tl; } else { item = pi + (tl >> 3) * G; t = tl & 7; }
        if (item < nitems) {
            int pm0, pT, ph, phalf, psb; scan_item_info(item, pm0, pT, ph, phalf, psb);
            if (t < pT) {
                const f32x4 y = *(const LAS f32x4*)(lds + 22528 + ybuf * 1024 + tl * 32 + cs * 4);
                u32x2 pk; pk[0] = cvt_pk_bf16(y[0], y[1]); pk[1] = cvt_pk_bf16(y[2], y[3]);
                bf16_t* yb = (pm0 < MP) ? B.YP + (size_t)pm0 * D : B.YS + (size_t)(pm0 - MP) * D;
                *(u32x2*)(yb + (size_t)t * D + ph * 64 + phalf * 32 + cs * 4) = pk;
            }
        }
    };
    auto run_steps = [&](int slot0, int ns) __attribute__((always_inline)) {
        const LAS float* ob = lds + (k & 1) * 11264 + seg * 4 + slot0 * 64;
        const LAS float* vbp = lds + (k & 1) * 11264 + 10240 + 2 * rp + slot0 * 32;
        LAS float* yb = lds + 22528 + (k & 1) * 1024 + 2 * rp + slot0 * 32;
#define SCAN_LOAD(P, tt) do { const int o_ = (tt) * 64; P##d = *(const LAS f32x4*)(ob + o_); P##kk = *(const LAS f32x4*)(ob + 2048 + o_); P##b = *(const LAS f32x4*)(ob + 4096 + o_); \
            P##k = *(const LAS f32x4*)(ob + 6144 + o_); P##r = *(const LAS f32x4*)(ob + 8192 + o_); P##v = *(const LAS f32x2*)(vbp + (tt) * 32); } while (0)
#define SCAN_STEP(P, q0, q1) do { \
            const f32x2 dl = {P##d[0], P##d[1]}, dh = {P##d[2], P##d[3]}, kkl = {P##kk[0], P##kk[1]}, kkh = {P##kk[2], P##kk[3]}, bl = {P##b[0], P##b[1]}, bh = {P##b[2], P##b[3]}; \
            const f32x2 kl = {P##k[0], P##k[1]}, kh = {P##k[2], P##k[3]}, rl = {P##r[0], P##r[1]}, rh = {P##r[2], P##r[3]}; \
            f32x2 pa = sA0 * kkl; pa = sA1 * kkh + pa; f32x2 pb = sB0 * kkl; pb = sB1 * kkh + pb; \
            float p0 = pa[0] + pa[1], p1 = pb[0] + pb[1]; \
            const f32x2 sdA0 = sA0 * dl + kl * P##v[0], sdA1 = sA1 * dh + kh * P##v[0], sdB0 = sB0 * dl + kl * P##v[1], sdB1 = sB1 * dh + kh * P##v[1]; \
            p0 += dpp_f<0xB1>(p0); p1 += dpp_f<0xB1>(p1); p0 += dpp_f<0x4E>(p0); p1 += dpp_f<0x4E>(p1); p0 += dpp_f<0x124>(p0); p1 += dpp_f<0x124>(p1); p0 += dpp_f<0x128>(p0); p1 += dpp_f<0x128>(p1); \
            sA0 = sdA0 - bl * p0; sA1 = sdA1 - bh * p0; sB0 = sdB0 - bl * p1; sB1 = sdB1 - bh * p1; \
            f32x2 qa = sA0 * rl; qa = sA1 * rh + qa; f32x2 qb = sB0 * rl; qb = sB1 * rh + qb; \
            q0 = qa[0] + qa[1]; q1 = qb[0] + qb[1]; } while (0)
        f32x4 Xd, Xkk, Xb, Xk, Xr, Yd, Ykk, Yb, Yk, Yr, Zd, Zkk, Zb, Zk, Zr, Wd, Wkk, Wb, Wk, Wr; f32x2 Xv, Yv, Zv, Wv;
        const bool l0 = (seg & 1) != 0, l1 = (seg & 2) != 0;
#define SCAN_YRED(a0, a1, a2, a3, tt, ok) do { \
            const float s0 = l0 ? a0 : a1, s1 = l0 ? a2 : a3, k0 = l0 ? a1 : a0, k1 = l0 ? a3 : a2; \
            const float w0 = k0 + dpp_f<0xB1>(s0), w1 = k1 + dpp_f<0xB1>(s1); \
            const float s2 = l1 ? w0 : w1, k2 = l1 ? w1 : w0; \
            float z = k2 + dpp_f<0x4E>(s2); \
            z += dpp_f<0x124>(z); z += dpp_f<0x128>(z); \
            if (seg < 4 && (ok)) yb[((tt) + (seg >> 1)) * 32 + (seg & 1)] = z; } while (0)
        __builtin_amdgcn_s_setprio(3);
        SCAN_LOAD(X, 0); SCAN_LOAD(Y, 1);
        float pv0 = 0.f, pv1 = 0.f, pv2 = 0.f, pv3 = 0.f;
        for (int t = 0; t < ns; t += 4) {
            SCAN_LOAD(Z, t + 2); SCAN_LOAD(W, t + 3);
            __builtin_amdgcn_sched_barrier(0);
            { float v0, v1, v2, v3; SCAN_STEP(X, v0, v1); SCAN_YRED(pv0, pv1, pv2, pv3, t - 2, t > 0); SCAN_STEP(Y, v2, v3); pv0 = v0; pv1 = v1; pv2 = v2; pv3 = v3; }
            __builtin_amdgcn_sched_barrier(0);
            { const int tn = (t + 4 < ns) ? t + 4 : t; SCAN_LOAD(X, tn); SCAN_LOAD(Y, tn + 1); }
            __builtin_amdgcn_sched_barrier(0);
            { float v0, v1, v2, v3; SCAN_STEP(Z, v0, v1); SCAN_YRED(pv0, pv1, pv2, pv3, t, true); SCAN_STEP(W, v2, v3); pv0 = v0; pv1 = v1; pv2 = v2; pv3 = v3; }
            __builtin_amdgcn_sched_barrier(0);
        }
        SCAN_YRED(pv0, pv1, pv2, pv3, ns - 2, true);
        __builtin_amdgcn_s_setprio(0);
#undef SCAN_YRED
#undef SCAN_LOAD
#undef SCAN_STEP
    };
    auto state_ptr = [&](int item, bool out) __attribute__((always_inline)) -> float* {
        int pm0, pT, ph, phalf, psb; scan_item_info(item, pm0, pT, ph, phalf, psb);
        const size_t o = (((size_t)psb * NH + ph) * 64 + phalf * 32 + 2 * rp) * 64 + seg * 4;
        return out ? cx.p->out + O_WKVS + o : const_cast<float*>(cx.p->in[2]) + o;
    };

    if (ci < nitems && !consumer) prep(ci, 0, 0);
    __syncthreads();
    int pci = 0, pct0 = 0; bool have_prev = false;
    while (ci < nitems) {
        int ni, nt0 = 0;
        if (ci < 256) { ni = ci; nt0 = ct0 + 32; if (nt0 >= PT) { ni = ci + G; nt0 = 0; } } else ni = ci + 4 * G;
        if (consumer) {
            const bool next_is_group = (ni >= 256) && (ni < nitems) && (ni != ci);
            if (ci < 256) {
                if (ct0 == 0) { sA0 = (f32x2){0.f, 0.f}; sA1 = sA0; sB0 = sA0; sB1 = sA0; }
                if (next_is_group) {
#pragma unroll
                    for (int q = 0; q < 4; ++q) if (ni + q * G < nitems) { const float* sp = state_ptr(ni + q * G, false); pf[q][0] = *(const f32x4*)sp; pf[q][1] = *(const f32x4*)(sp + 64); }
                    pf_valid = true;
                }
                const int ns = (PT - ct0) < 32 ? (PT - ct0) : 32;
                run_steps(0, ns);
                if (ct0 + 32 >= PT) {
                    int pm0, pT, ph, phalf, psb; scan_item_info(ci, pm0, pT, ph, phalf, psb);
                    float* sp = cx.p->out + O_WKVP + (((size_t)(-1 - psb) * NH + ph) * 64 + phalf * 32 + 2 * rp) * 64 + seg * 4;
                    *(f32x4*)sp = (f32x4){sA0[0], sA0[1], sA1[0], sA1[1]}; *(f32x4*)(sp + 64) = (f32x4){sB0[0], sB0[1], sB1[0], sB1[1]};
                }
            } else {
                f32x4 st[4][2];
#pragma unroll
                for (int q = 0; q < 4; ++q) {
                    if (pf_valid) { st[q][0] = pf[q][0]; st[q][1] = pf[q][1]; }
                    else if (ci + q * G < nitems) { const float* sp = state_ptr(ci + q * G, false); st[q][0] = *(const f32x4*)sp; st[q][1] = *(const f32x4*)(sp + 64); }
                    else { st[q][0] = (f32x4){0.f, 0.f, 0.f, 0.f}; st[q][1] = st[q][0]; }
                }
                pf_valid = false;
                if (next_is_group) {
#pragma unroll
                    for (int q = 0; q < 4; ++q) if (ni + q * G < nitems) { const float* sp = state_ptr(ni + q * G, false); pf[q][0] = *(const f32x4*)sp; pf[q][1] = *(const f32x4*)(sp + 64); }
                    pf_valid = true;
                }
#pragma unroll
                for (int q = 0; q < 4; ++q) {
                    if (ci + q * G < nitems) {
                        sA0 = (f32x2){st[q][0][0], st[q][0][1]}; sA1 = (f32x2){st[q][0][2], st[q][0][3]}; sB0 = (f32x2){st[q][1][0], st[q][1][1]}; sB1 = (f32x2){st[q][1][2], st[q][1][3]};
                        asm volatile("" :: "v"(sA0[0]), "v"(sA1[0]), "v"(sB0[0]), "v"(sB1[0]));
                        run_steps(8 * q, 8);
                        float* sp = state_ptr(ci + q * G, true);
                        *(f32x4*)sp = (f32x4){sA0[0], sA0[1], sA1[0], sA1[1]}; *(f32x4*)(sp + 64) = (f32x4){sB0[0], sB0[1], sB1[0], sB1[1]};
                    }
                }
            }
        } else {
            if (ni < nitems) prep(ni, nt0, (k + 1) & 1);
            if (have_prev) yout(pci, pct0, (k - 1) & 1);
        }
        __syncthreads();
        pci = ci; pct0 = ct0; have_prev = true;
        ci = ni; ct0 = nt0; ++k;
    }
    if (have_prev && !consumer) yout(pci, pct0, (k - 1) & 1);
    __syncthreads();
}

#define XB_TMO      128
#define XB_XCNT(j)  (256  + 64 * (j))
#define XB_XSUB(j)  (1280 + 64 * (j))
#define XB_XGEN(j)  (2304 + 64 * (j))
#define XB_TOP      3328
#define XB_TOPGEN   3392
#define XCD_BAR_WORDS 3456
#define XB_SPIN_CAP (1u << 18)
__device__ __forceinline__ unsigned xb_ld(unsigned* p)              { return __hip_atomic_load(p, __ATOMIC_RELAXED, __HIP_MEMORY_SCOPE_AGENT); }
__device__ __forceinline__ unsigned xb_add(unsigned* p, unsigned v) { return __hip_atomic_fetch_add(p, v, __ATOMIC_RELAXED, __HIP_MEMORY_SCOPE_AGENT); }
__device__ __forceinline__ unsigned xb_xcc_id() { return (unsigned)__builtin_amdgcn_s_getreg((3 << 11) | 20) & 0xFu; }
#define XB_SPIN(cond, bar) do { unsigned _sp = 0; while (cond) { __builtin_amdgcn_s_sleep(1); \
    if ((++_sp & 255u) == 0u) { if (xb_ld(&(bar)[XB_TMO])) break; if (_sp > XB_SPIN_CAP) { atomicAdd(&(bar)[XB_TMO], 1u); break; } } } } while (0)
__device__ __forceinline__ void xcd_barrier_complete(unsigned* bar, unsigned x, unsigned G, unsigned& nloc, unsigned& nx) {
    unsigned sum, cnt, mine, sp = 0u;
    for (;;) {
        sum = 0u; cnt = 0u; mine = 0u;
#pragma unroll
        for (unsigned j = 0; j < 16; ++j) { const unsigned c = xb_ld(&bar[XB_XCNT(j)]); sum += c; cnt += (c > 0u) ? 1u : 0u; mine = (j == x) ? c : mine; }
        if (sum == G) break;
        __builtin_amdgcn_s_sleep(1);
        if ((++sp & 255u) == 0u) { if (xb_ld(&bar[XB_TMO])) break; if (sp > XB_SPIN_CAP) { atomicAdd(&bar[XB_TMO], 1u); break; } }
    }
    nloc = mine > 0u ? mine : 1u; nx = cnt > 0u ? cnt : 1u;
}
__device__ __forceinline__ void xcd_barrier(unsigned* bar, volatile LAS unsigned* st, int tid, unsigned G) {
    asm volatile("s_waitcnt vmcnt(0)" ::: "memory");
    __syncthreads();
    if (tid == 0) {
        const unsigned x = xb_xcc_id();
        __builtin_amdgcn_s_waitcnt(0);
        unsigned nloc = st[0], nx = st[1];
        if (nloc == 0u) { xcd_barrier_complete(bar, x, G, nloc, nx); st[0] = nloc; st[1] = nx; }
        const unsigned old = xb_add(&bar[XB_XSUB(x)], 1u);
        const unsigned gen = old / nloc;
        if (old + 1u == (gen + 1u) * nloc) {
            __builtin_amdgcn_fence(__ATOMIC_RELEASE, "agent");
            asm volatile("s_waitcnt vmcnt(0)" ::: "memory");
            const unsigned og = xb_add(&bar[XB_TOP], 1u);
            const unsigned tg = og / nx;
            if (og + 1u == (tg + 1u) * nx) xb_add(&bar[XB_TOPGEN], 1u);
            else XB_SPIN(xb_ld(&bar[XB_TOPGEN]) == tg, bar);
            __builtin_amdgcn_fence(__ATOMIC_ACQUIRE, "agent");
            xb_add(&bar[XB_XGEN(x)], 1u);
            asm volatile("s_waitcnt vmcnt(0)" ::: "memory");
        } else {
            XB_SPIN(xb_ld(&bar[XB_XGEN(x)]) == gen, bar);
            __builtin_amdgcn_fence(__ATOMIC_ACQUIRE, "agent");
            asm volatile("s_waitcnt vmcnt(0)" ::: "memory");
        }
    }
    __syncthreads();
}

#define X_ ((float*)(ws + WS_X))
#define SS_(i) ((float*)(ws + WS_SS))
#define XB_ ((bf16_t*)(ws + WS_X))
__global__ void __launch_bounds__(NTHREADS, 2) mega(Params p) {
    extern __shared__ __attribute__((aligned(16))) unsigned char shm[];
    LAS unsigned char* lds = (LAS unsigned char*)shm;
    LAS float* ldsf = (LAS float*)shm;
    volatile LAS unsigned* bst = (volatile LAS unsigned*)(shm + 131072);
    if (threadIdx.x == 0) { bst[0] = 0u; bst[1] = 0u; (void)xb_add((unsigned*)(p.ws + WS_BAR) + XB_XCNT(xb_xcc_id()), 1u); }
    __syncthreads();
    const int wv_ = __builtin_amdgcn_readfirstlane(threadIdx.x >> 6);
    for (int ph = 0; ph < 19; ++ph) {
#ifdef REP_MASK
        for (int rep = 0; rep < 1 + ((REP_MASK >> ph) & 1); ++rep) {
#else
        { const int rep = 0;
#endif
        Ctx cx;
        { KP kp = (KP)__builtin_amdgcn_kernarg_segment_ptr(); int t_ = wv_ * 64 + (int)__builtin_amdgcn_mbcnt_hi(~0u, __builtin_amdgcn_mbcnt_lo(~0u, 0u)), b_ = blockIdx.x, g_ = gridDim.x;
          asm volatile("" : "+s"(kp), "+v"(t_), "+s"(b_), "+s"(g_));
          cx.p = kp; cx.tid = t_; cx.bid = b_; cx.G = g_; }
        unsigned char* ws = cx.p->ws;
        unsigned char* dob = (unsigned char*)cx.p->out;
        const int G = cx.G, c = cx.bid;
        int kind, f = 0;
        switch (ph) {
            case 0: kind = 0; break;
            case 1: kind = 1; f = 0; break;  case 2: kind = 2; f = 0; break;
            case 3: kind = 3; break; case 4: kind = 4; break; case 5: kind = 5; break; case 6: kind = 6; break; case 7: kind = 7; break;
            case 8: kind = 2; f = 4; break;
            case 9: kind = 1; f = 1; break;  case 10: kind = 2; f = 1; break;
            case 11: kind = 1; f = 2; break; case 12: kind = 2; f = 2; break;
            case 13: kind = 8; break; case 14: kind = 9; break;
            case 15: kind = 2; f = 5; break;
            case 16: kind = 1; f = 3; break; case 17: kind = 2; f = 3; break;
            default: kind = 10; break;
        }
        if (kind == 0) {
            phase_x0(cx, XB_, SS_(0));
            convert(ldsf, cx, T_GU, 0, (bf16_t*)(ws + WS_SLOTA), c, G);
            convert(ldsf, cx, T_DN, 0, (bf16_t*)(ws + WS_SLOTA + SZ_GU), c, G);
            if (G != 256) {
                convert(ldsf, cx, T_RKV, 0, (bf16_t*)(ws + WS_WRKV), c, G);
                convert(ldsf, cx, T_L2, 0, (bf16_t*)(ws + WS_WL2), c, G);
                convert(ldsf, cx, T_PLAIN, 26, (bf16_t*)(ws + WS_WO), c, G);
            }
        } else if (kind == 1) {
            const int ssi = f == 0 ? 0 : (f == 1 ? 2 : (f == 2 ? 3 : 5));
            const unsigned char* slot = ws + ((f & 1) ? WS_SLOTB : WS_SLOTA);
            pg8::Gemm g; g.A = XB_; g.Bt = (const bf16_t*)slot; g.K = D;
            pg8::StaticOrder S; S.init(MPAD / 256, 22, G, c, g.K);
            EpiGU E; E.ss = SS_(ssi); E.act = (bf16_t*)(ws + B_ACT);
            pg8::gemm_phase(lds, g, S, E, cx.tid);
        } else if (kind == 2) {
            pg8::Gemm g; EpiRes E; E.XB = XB_;
            if (f < 4) { g.A = (const bf16_t*)(ws + B_ACT); g.Bt = (const bf16_t*)(ws + ((f & 1) ? WS_SLOTB : WS_SLOTA) + SZ_GU); g.K = FF; E.scale = 0.5f;
                         E.ssout = SS_(f == 0 ? 1 : (f == 1 ? 3 : (f == 2 ? 4 : 6))); }
            else if (f == 4) { g.A = (const bf16_t*)(ws + B_O); g.Bt = (const bf16_t*)(ws + WS_WO); g.K = D; E.scale = 1.f; E.ssout = SS_(2); }
            else { g.A = (const bf16_t*)(ws + B_CV); g.Bt = (const bf16_t*)(ws + WS_WOUT); g.K = D; E.scale = 1.f; E.ssout = SS_(5); }
            if (rep) E.scale = 0.f;
            if (f < 4 && G == 256) {
                u32x4* slab = (u32x4*)(ws + WS_BIG + SZ_ACT);
                pg8::SplitOrder S; S.init(MPAD / 256, 4, G, c, g.K);
                pg8::gemm_phase(lds, g, S, E, cx.tid, slab);
                if (rep == 0 && f == 0 && c >= 140) {
                    convert(ldsf, cx, T_RKV, 0, (bf16_t*)(ws + WS_WRKV), c - 140, G - 140);
                    convert(ldsf, cx, T_L2, 0, (bf16_t*)(ws + WS_WL2), c - 140, G - 140);
                    convert(ldsf, cx, T_PLAIN, 26, (bf16_t*)(ws + WS_WO), c - 140, G - 140);
                }
                xcd_barrier((unsigned*)(ws + WS_BAR), bst, cx.tid, (unsigned)G);
                if (c < 160) {
                    const int lt = c >> 3;
                    pg8::Unit u; S.tile(256 + lt, u);
                    int t_ = cx.tid; asm volatile("" : "+v"(t_));
                    const int wid = t_ >> 6, lane = t_ & 63, wr = wid >> 2, wc = wid & 3, fr = lane & 15, fq = lane >> 4;
                    const u32x4* sp = slab + (size_t)(lt * 7) * 16 * 512 + t_;
                    const int row0 = u.pm * 256 + wr * 64 + fr, col0 = u.pn * 256 + wc * 32 + 8 * fq;
                    {
                        const int am = c & 7;
                        const int ai = am >> 2, m = am & 3, r = row0 + ai * 128 + m * 16;
                        f32x4 a[2][2];
#pragma unroll
                        for (int bj = 0; bj < 2; ++bj) {
                            const int idx = (ai * 2 + bj) * 4 + m;
                            float t8[8] = {0.f, 0.f, 0.f, 0.f, 0.f, 0.f, 0.f, 0.f};
#pragma unroll
                            for (int part = 0; part < 7; ++part) { float o8[8]; unpack8(sp[(size_t)(part * 16 + idx) * 512], o8);
#pragma unroll
                                for (int jj = 0; jj < 8; ++jj) t8[jj] += o8[jj]; }
                            a[bj][0] = (f32x4){t8[0], t8[1], t8[2], t8[3]}; a[bj][1] = (f32x4){t8[4], t8[5], t8[6], t8[7]};
                        }
                        float ssum = 0.f;
#pragma unroll
                        for (int bj = 0; bj < 2; ++bj) {
                            bf16_t* xp = E.XB + (size_t)r * D + col0 + bj * 128;
                            float o[8]; unpack8(*(const u32x4*)xp, o);
#pragma unroll
                            for (int jj = 0; jj < 4; ++jj) { o[jj] += a[bj][0][jj] * E.scale; o[4 + jj] += a[bj][1][jj] * E.scale; }
                            *(u32x4*)xp = pack8(o);
#pragma unroll
                            for (int jj = 0; jj < 8; ++jj) ssum += o[jj] * o[jj];
                        }
                        ssum += __shfl_xor(ssum, 16); ssum += __shfl_xor(ssum, 32);
                        if (fq == 0) E.ssout[(size_t)r * 16 + u.pn * 4 + wc] = ssum;
                    }
                }
            } else {
            pg8::StaticOrder S; S.init(MPAD / 256, 4, G, c, g.K);
            pg8::gemm_phase(lds, g, S, E, cx.tid);
            if (rep == 0) {
            const int nbusy = (MPAD / 256) * 4 - G;
            if (G > 2 * nbusy && nbusy >= 0) {
                if (c >= nbusy) {
                    const int wg = c - nbusy, nwg = G - nbusy;
                    if (f == 4) {
                        convert(ldsf, cx, T_GU, 1, (bf16_t*)(ws + WS_SLOTB), wg, nwg);
                        convert(ldsf, cx, T_DN, 1, (bf16_t*)(ws + WS_SLOTB + SZ_GU), wg, nwg);
                        convert(ldsf, cx, T_GU, 2, (bf16_t*)(ws + WS_SLOTA), wg, nwg);
                        convert(ldsf, cx, T_DN, 2, (bf16_t*)(ws + WS_SLOTA + SZ_GU), wg, nwg);
                        convert(ldsf, cx, T_WIN, 0, (bf16_t*)(ws + WS_WIN), wg, nwg);
                        convert(ldsf, cx, T_PLAIN, 29, (bf16_t*)(ws + WS_WOUT), wg, nwg);
                    } else if (f == 2 || (f == 5 && G == 256)) {
                        convert(ldsf, cx, T_GU, 3, (bf16_t*)(ws + WS_SLOTB), wg, nwg);
                        convert(ldsf, cx, T_DN, 3, (bf16_t*)(ws + WS_SLOTB + SZ_GU), wg, nwg);
                    }
                }
            } else {
                if (f == 4) {
                    convert(ldsf, cx, T_GU, 1, (bf16_t*)(ws + WS_SLOTB), c, G);
                    convert(ldsf, cx, T_DN, 1, (bf16_t*)(ws + WS_SLOTB + SZ_GU), c, G);
                    convert(ldsf, cx, T_GU, 2, (bf16_t*)(ws + WS_SLOTA), c, G);
                    convert(ldsf, cx, T_DN, 2, (bf16_t*)(ws + WS_SLOTA + SZ_GU), c, G);
                    convert(ldsf, cx, T_WIN, 0, (bf16_t*)(ws + WS_WIN), c, G);
                    convert(ldsf, cx, T_PLAIN, 29, (bf16_t*)(ws + WS_WOUT), c, G);
                } else if (f == 2) {
                    convert(ldsf, cx, T_GU, 3, (bf16_t*)(ws + WS_SLOTB), c, G);
                    convert(ldsf, cx, T_DN, 3, (bf16_t*)(ws + WS_SLOTB + SZ_GU), c, G);
                }
            }
            }
            }
        } else if (kind == 3) {
            phase_mix(cx, XB_, SS_(1), (bf16_t*)(ws + B_HH));
        } else if (kind == 4) {
            pg8::Gemm g; g.A = (const bf16_t*)(ws + B_HH); g.Bt = (const bf16_t*)(ws + WS_WRKV); g.K = 2048;
            pg8::StaticOrder S; S.init(MPAD / 256, 14, G, c, g.K);
            EpiRKV E; E.ws = ws; E.dob = dob;
            pg8::gemm_phase(lds, g, S, E, cx.tid);
        } else if (kind == 5) {
            pg8::Gemm g; g.A = (const bf16_t*)(dob + DO_L1); g.Bt = (const bf16_t*)(ws + WS_WL2); g.K = 384;
            pg8::L2Order S; S.init(MPAD / 256, 12, G, c, g.K);
            EpiL2 E; E.ws = ws; E.w0 = cx.p->in[13]; E.a0 = cx.p->in[16];
            pg8::gemm_phase(lds, g, S, E, cx.tid);
        } else if (kind == 6) {
            ScanBufs sbf; sbf.R = (const bf16_t*)(ws + B_R); sbf.K = (const bf16_t*)(ws + B_K); sbf.V = (const bf16_t*)(dob + DO_XB); sbf.LW = (const bf16_t*)(ws + B_LW);
            sbf.A = (const bf16_t*)(ws + B_A); sbf.YP = (bf16_t*)(dob + DO_YPR); sbf.YS = (bf16_t*)(ws + L_YS); sbf.CB = (float*)(ws + WS_X + ROWB);
            phase_scan(ldsf, cx, sbf);
        } else if (kind == 7) {
            phase_post(cx, (const bf16_t*)(dob + DO_YPR), (const bf16_t*)(ws + L_YS), (const float*)(ws + WS_X + ROWB), (const bf16_t*)(dob + DO_XB),
                       (const bf16_t*)(ws + L_G), (bf16_t*)(ws + B_O));
        } else if (kind == 8) {
            pg8::Gemm g; g.A = XB_; g.Bt = (const bf16_t*)(ws + WS_WIN); g.K = D;
            pg8::StaticOrder S; S.init(MPAD / 256, 12, G, c, g.K);
            EpiCI E; E.ss = SS_(4); E.U = (bf16_t*)(ws + B_U); E.GB = (bf16_t*)(ws + B_GB); E.out = cx.p->out;
            pg8::gemm_phase(lds, g, S, E, cx.tid);
        } else if (kind == 9) {
            phase_conv(cx, (const bf16_t*)(ws + B_U), (const bf16_t*)(ws + B_GB), (bf16_t*)(ws + B_CV));
        } else {
            phase_final(cx, XB_, SS_(6));
        }
        if (ph < 18) xcd_barrier((unsigned*)(ws + WS_BAR), bst, cx.tid, (unsigned)G);
        }
    }
}

extern "C" void kernel_launch(void* const* d_in, const int* in_sizes, int n_in, void* d_out, int out_size, void* d_ws, size_t ws_size, hipStream_t stream) {
    static int grid_blocks = 0;
    if (grid_blocks == 0) {
        if (n_in != 30 || (size_t)out_size != O_END || ws_size < WS_END) {
            fprintf(stderr, "kernel_launch: unexpected shapes: n_in %d out_size %d ws_size %zu (need %zu)\n", n_in, out_size, ws_size, (size_t)WS_END);
            grid_blocks = -1; return;
        }
        int dev = 0, cus = 0, per_cu = 0;
        (void)hipGetDevice(&dev);
        (void)hipDeviceGetAttribute(&cus, hipDeviceAttributeMultiprocessorCount, dev);
        (void)hipFuncSetAttribute((const void*)mega, hipFuncAttributeMaxDynamicSharedMemorySize, LDS_BYTES);
        (void)hipOccupancyMaxActiveBlocksPerMultiprocessor(&per_cu, (const void*)mega, NTHREADS, LDS_BYTES);
        if (per_cu < 1) per_cu = 1;
        grid_blocks = cus * per_cu;
        if (grid_blocks > 256) grid_blocks = 256;
    }
    if (grid_blocks < 0) return;
    (void)hipMemsetAsync((char*)d_ws, 0, WS_CTL_END, stream);
    Params p{};
    for (int i = 0; i < 30; ++i) p.in[i] = (const float*)d_in[i];
    p.out = (float*)d_out; p.ws = (unsigned char*)d_ws;
    void* args[] = {&p};
    hipError_t e = hipLaunchCooperativeKernel((const void*)mega, dim3(grid_blocks), dim3(NTHREADS), args, LDS_BYTES, stream);
    if (e != hipSuccess) fprintf(stderr, "cooperative launch failed: %s (grid %d)\n", hipGetErrorString(e), grid_blocks);
}
```

```cpp
#include <hip/hip_runtime.h>
#include <hip/hip_cooperative_groups.h>
#include <cstdio>
#include <cstdint>
namespace cg = cooperative_groups;

#define LAS __attribute__((address_space(3)))
typedef unsigned short bf16_t;
typedef short bf16x8 __attribute__((ext_vector_type(8)));
typedef float f32x4 __attribute__((ext_vector_type(4)));
typedef float f32x2 __attribute__((ext_vector_type(2)));
typedef unsigned u32x4 __attribute__((ext_vector_type(4)));
typedef unsigned u32x2 __attribute__((ext_vector_type(2)));

constexpr int D = 1024, FF = 2816, NH = 16;
constexpr int PB = 8, PT = 2064, NMETA = 16, PTX = 2048, SBN = 128, STN = 8;
constexpr int MP = PB * PT;
constexpr int MS = SBN * STN;
constexpr int M = MP + MS;
constexpr int MPAD = 17664;
constexpr int NTHREADS = 512;
constexpr int LDS_BYTES = 131072 + 16;

constexpr size_t O_YP = 0;
constexpr size_t O_YS = O_YP + (size_t)PB * PTX * D;
constexpr size_t O_WKVP = O_YS + (size_t)MS * D;
constexpr size_t O_SHP = O_WKVP + (size_t)PB * NH * 64 * 64;
constexpr size_t O_CVP = O_SHP + (size_t)PB * D;
constexpr size_t O_WKVS = O_CVP + (size_t)PB * 2 * D;
constexpr size_t O_SHS = O_WKVS + (size_t)SBN * NH * 64 * 64;
constexpr size_t O_CVS = O_SHS + (size_t)SBN * D;
constexpr size_t O_END = O_CVS + (size_t)SBN * 2 * D;

constexpr size_t AL(size_t x) { return (x + 255) & ~(size_t)255; }
constexpr size_t ROWB = (size_t)MPAD * D * 2;
constexpr size_t WS_BAR = 0;
constexpr size_t WS_CTL_END = 16384;
constexpr size_t WS_SS = 16384;
constexpr size_t WS_SS_END = AL(WS_SS + (size_t)MPAD * 16 * 4);
constexpr size_t WS_X = WS_SS_END;
constexpr size_t WS_MISC = AL(WS_X + (size_t)MPAD * D * 4);
constexpr size_t SZ_WRKV = (size_t)3584 * 2048 * 2;
constexpr size_t SZ_WL2 = (size_t)3072 * 384 * 2;
constexpr size_t SZ_W1K = (size_t)1024 * 1024 * 2;
constexpr size_t WS_WRKV = WS_MISC;
constexpr size_t WS_WL2 = AL(WS_WRKV + SZ_WRKV);
constexpr size_t WS_WO = AL(WS_WL2 + SZ_WL2);
constexpr size_t WS_BIG = AL(WS_WO + SZ_W1K);
constexpr size_t SZ_BIG = (size_t)MPAD * 2048 * 2 * 2 + 4096;
constexpr size_t WS_LAZY = AL(WS_BIG + SZ_BIG);
constexpr size_t SZ_GU = (size_t)5632 * 1024 * 2;
constexpr size_t SZ_DN = (size_t)1024 * 2816 * 2;
constexpr size_t SZ_SLOT = SZ_GU + SZ_DN;
constexpr size_t WS_SLOTA = WS_LAZY;
constexpr size_t WS_SLOTB = WS_SLOTA + SZ_SLOT;
constexpr size_t WS_WIN = WS_SLOTB + SZ_SLOT;
constexpr size_t WS_WOUT = WS_WIN + (size_t)3072 * 1024 * 2;
constexpr size_t WS_END = WS_WOUT + SZ_W1K;
constexpr size_t B_ACT = WS_BIG;
constexpr size_t B_HH = WS_BIG;
constexpr size_t B_R = WS_BIG + 2 * ROWB;
constexpr size_t B_K = WS_BIG + 3 * ROWB;
constexpr size_t B_LW = WS_BIG;
constexpr size_t B_A = WS_BIG + ROWB;
constexpr size_t B_O = WS_BIG;
constexpr size_t B_U = WS_BIG;
constexpr size_t B_GB = WS_BIG + ROWB;
constexpr size_t B_CV = WS_BIG + 2 * ROWB;
constexpr size_t DO_XB = 0;
constexpr size_t DO_L1 = ROWB;
constexpr size_t DO_YPR = ROWB;
static_assert(DO_YPR + (size_t)MP * D * 2 <= O_WKVP * 4, "y-region overflow");
static_assert(DO_L1 + (size_t)MPAD * 384 * 2 <= O_WKVP * 4, "l1 overflow");
constexpr size_t L_G = WS_LAZY;
constexpr size_t L_YS = WS_LAZY + ROWB;
static_assert(L_YS + (size_t)MS * D * 2 <= WS_END, "lazy overflow");
constexpr size_t SZ_ACT = (size_t)MPAD * 2816 * 2;
static_assert(SZ_BIG >= SZ_ACT + (size_t)140 * 32 * 512 * 16, "ACT + split-K slab do not fit");

struct Params {
    const float* in[30];
    float* out;
    unsigned char* ws;
};
typedef const __attribute__((address_space(4))) Params* KP;
struct Ctx { KP p; int tid, bid, G; };

__device__ __forceinline__ unsigned cvt_pk_bf16(float lo, float hi) { unsigned r; asm volatile("v_cvt_pk_bf16_f32 %0, %1, %2" : "=v"(r) : "v"(lo), "v"(hi)); return r; }
__device__ __forceinline__ float bf_lo(unsigned v) { return __uint_as_float(v << 16); }
__device__ __forceinline__ float bf_hi(unsigned v) { return __uint_as_float(v & 0xffff0000u); }
__device__ __forceinline__ float frcp(float x) { return __builtin_amdgcn_rcpf(x); }
__device__ __forceinline__ float fsigmoid(float x) { return frcp(1.f + __expf(-x)); }
__device__ __forceinline__ void unpack8(u32x4 v, float* o) {
    o[0] = bf_lo(v[0]); o[1] = bf_hi(v[0]); o[2] = bf_lo(v[1]); o[3] = bf_hi(v[1]);
    o[4] = bf_lo(v[2]); o[5] = bf_hi(v[2]); o[6] = bf_lo(v[3]); o[7] = bf_hi(v[3]);
}
__device__ __forceinline__ u32x4 pack8(const float* o) {
    u32x4 r; r[0] = cvt_pk_bf16(o[0], o[1]); r[1] = cvt_pk_bf16(o[2], o[3]); r[2] = cvt_pk_bf16(o[4], o[5]); r[3] = cvt_pk_bf16(o[6], o[7]); return r;
}
template <int CTRL> __device__ __forceinline__ float dpp_f(float x) {
    return __int_as_float(__builtin_amdgcn_update_dpp(0, __float_as_int(x), CTRL, 0xF, 0xF, false));
}
__device__ __forceinline__ float allreduce16(float p) {
    p += dpp_f<0xB1>(p); p += dpp_f<0x4E>(p); p += dpp_f<0x124>(p); p += dpp_f<0x128>(p); return p;
}
__device__ __forceinline__ float allreduce8(float p) {
    p += dpp_f<0xB1>(p); p += dpp_f<0x4E>(p); p += __shfl_xor(p, 4); return p;
}
__device__ __forceinline__ float wave_sum(float p) {
#pragma unroll
    for (int o = 32; o >= 1; o >>= 1) p += __shfl_xor(p, o);
    return p;
}
__device__ __forceinline__ float row_rs(const float* ssp, int r) {
    const f32x4 a = *(const f32x4*)(ssp + (size_t)r * 16), b = *(const f32x4*)(ssp + (size_t)r * 16 + 4), c = *(const f32x4*)(ssp + (size_t)r * 16 + 8), d = *(const f32x4*)(ssp + (size_t)r * 16 + 12);
    const float s = ((a[0] + a[1]) + (a[2] + a[3])) + ((b[0] + b[1]) + (b[2] + b[3])) + ((c[0] + c[1]) + (c[2] + c[3])) + ((d[0] + d[1]) + (d[2] + d[3]));
    return rsqrtf(s * (1.f / 1024.f) + 1e-6f);
}
__device__ __forceinline__ void row_info(int m, int& t, int& T, int& seq) {
    if (m < MP) { seq = m / PT; t = m - seq * PT; T = PT; }
    else { const int q = m - MP; seq = 8 + (q >> 3); t = q & 7; T = STN; }
}

namespace pg8 {
constexpr int BM = 256, BK = 64, HALF = 128, HTB = HALF * BK * 2, STAGE_BYTES = 8 * HTB, NXCD = 8, WGM = 4;
__host__ __device__ __forceinline__ int lds_byte(int r, int c) { const int st = (r >> 4) * 2 + (c >> 5), rr = r & 15, cc = c & 31, ob = rr * 64 + cc * 2; return st * 1024 + (ob ^ (((ob >> 9) & 1) << 5)); }
__host__ __device__ __forceinline__ void stage_rc(int b, int& R, int& C) { const int st = b / 1024, sb = b % 1024, swz = sb ^ (((sb >> 9) & 1) << 5); R = (st >> 1) * 16 + swz / 64; C = (st & 1) * 32 + (swz % 64) / 2; }
__host__ __device__ __forceinline__ int perm32(int rho) { const int n = rho >> 4, i = rho & 15; return 8 * (i >> 2) + 4 * n + (i & 3); }

struct Unit { int pm, pn, k0, nt, sub; };
struct Gemm { const bf16_t* A; const bf16_t* Bt; int K; };
struct StaticOrder {
    int nM, nN, nwg, G, c;
    int ntK; int wgm;
    __device__ __forceinline__ void init(int nM_, int nN_, int G_, int c_, int K_) { nM = nM_; nN = nN_; nwg = nM * nN; G = G_; c = c_; ntK = K_ / BK; wgm = (nN_ == 22) ? 8 : 4; }
    __device__ __forceinline__ void tile(int L, Unit& u) const {
        int wgid = L; { const int q = nwg / NXCD, r = nwg % NXCD, xcd = wgid % NXCD, off = wgid / NXCD; wgid = (xcd < r ? xcd * (q + 1) : r * (q + 1) + (xcd - r) * q) + off; }
        const int nig = wgm * nN, gid = wgid / nig, fm = gid * wgm, gsz = (nM - fm) < wgm ? (nM - fm) : wgm;
        u.pm = fm + ((wgid % nig) % gsz); u.pn = (wgid % nig) / gsz; u.k0 = 0; u.nt = ntK; u.sub = -1;
    }
    __device__ __forceinline__ bool next(int i, Unit& u) const {
        const long L = (long)i * G + c; if (L >= nwg) return false;
        u.k0 = 0; u.nt = ntK; u.sub = -1;
        int wgid = (int)L; { const int q = nwg / NXCD, r = nwg % NXCD, xcd = wgid % NXCD, off = wgid / NXCD; wgid = (xcd < r ? xcd * (q + 1) : r * (q + 1) + (xcd - r) * q) + off; }
        const int nig = wgm * nN, gid = wgid / nig, fm = gid * wgm, gsz = (nM - fm) < wgm ? (nM - fm) : wgm;
        u.pm = fm + ((wgid % nig) % gsz); u.pn = (wgid % nig) / gsz; return true;
    }
};

struct SplitOrder : StaticOrder {
    __device__ __forceinline__ bool next(int i, Unit& u) const {
        if (i == 0) { tile(c, u); return true; }
        if (i == 1 && c < 100) { tile(256 + c / 5, u); const int part = c % 5; u.k0 = part < 3 ? part * 8 : 24 + (part - 3) * 10; u.nt = part < 3 ? 8 : 10; u.sub = c; return true; }
        return false;
    }
};
struct L2Order : StaticOrder {
    __device__ __forceinline__ bool next(int i, Unit& u) const {
        if (!StaticOrder::next(i, u)) return false;
        if (u.pn < 8) { u.k0 = 0; u.nt = 2; } else { u.k0 = 2; u.nt = 4; }
        return true;
    }
};
template <class Epi, class Sched>
__device__ __forceinline__ void gemm_phase(LAS unsigned char* lds, const Gemm g, const Sched& S, const Epi& E, const int tid_, u32x4* slab = nullptr) {
    const int tid = tid_, wid = __builtin_amdgcn_readfirstlane(tid >> 6), lane = tid & 63, wr = wid >> 2, wc = wid & 3, fr = lane & 15, fq = lane >> 4;
    const int K = g.K;
    unsigned voffA[2], voffB[2];
#pragma unroll
    for (int i = 0; i < 2; ++i) { int R, C; stage_rc(tid * 16 + i * 8192, R, C); const int Rb = (R & ~31) + perm32(R & 31);
        voffA[i] = (unsigned)(R * K + C) * 2u; voffB[i] = (unsigned)(Rb * K + C) * 2u; }
    const size_t kstep = (size_t)(BK * 2);
    const size_t hstep = (size_t)HALF * K * 2;
    const size_t tstep = 2 * hstep;
    const unsigned ldsw = (unsigned)wid * 1024u;
    const int aoff = lds_byte(wr * 64 + fr, fq * 8), boff = lds_byte(wc * 32 + fr, fq * 8);
#define PG8_SA(b, h) (((b) * 2 + (h)) * HTB)
#define PG8_SB(b, h) ((4 + (b) * 2 + (h)) * HTB)
#define PG8_STAGE(bufoff, gbase, voff) do { _Pragma("unroll") for (int _i = 0; _i < 2; ++_i) \
        __builtin_amdgcn_global_load_lds((const unsigned*)((const char*)(gbase) + (voff)[_i]), (LAS unsigned*)(lds + (bufoff) + ldsw + _i * 8192), 16, 0, 0); } while (0)
#define PG8_LDA(dst, b, h) do { _Pragma("unroll") for (int m = 0; m < 4; ++m) _Pragma("unroll") for (int k = 0; k < 2; ++k) dst[m][k] = *(const LAS bf16x8*)(lds + PG8_SA(b, h) + aoff + m * 2048 + k * 1024); } while (0)
#define PG8_LDB(dst, b, h) do { _Pragma("unroll") for (int n = 0; n < 2; ++n) _Pragma("unroll") for (int k = 0; k < 2; ++k) dst[n][k] = *(const LAS bf16x8*)(lds + PG8_SB(b, h) + boff + n * 2048 + k * 1024); } while (0)
#define PG8_MMA(ai, bj, At, Bt) do { __builtin_amdgcn_s_setprio(1); _Pragma("unroll") for (int m = 0; m < 4; ++m) _Pragma("unroll") for (int n = 0; n < 2; ++n) _Pragma("unroll") for (int k = 0; k < 2; ++k) \
        acc[ai][bj][m][n] = __builtin_amdgcn_mfma_f32_16x16x32_bf16(Bt[n][k], At[m][k], acc[ai][bj][m][n], 0, 0, 0); __builtin_amdgcn_s_setprio(0); } while (0)
#define PG8_WAIT_V(n) asm volatile("s_waitcnt vmcnt(" #n ")" ::: "memory")
#define PG8_WAIT_L(n) asm volatile("s_waitcnt lgkmcnt(" #n ")" ::: "memory")
#define PG8_BAR __builtin_amdgcn_s_barrier()
#define PG8_SCHED __builtin_amdgcn_sched_barrier(0)
    Unit cur, nxt; int ui = 0;
    if (!S.next(0, cur)) return;
    f32x4 acc[2][2][4][2];
#pragma unroll
    for (int a = 0; a < 2; ++a)
#pragma unroll
        for (int b = 0; b < 2; ++b)
#pragma unroll
            for (int m = 0; m < 4; ++m)
#pragma unroll
                for (int n = 0; n < 2; ++n) acc[a][b][m][n] = (f32x4){0.f, 0.f, 0.f, 0.f};
    bf16x8 At[4][2], B0[2][2], B1[2][2];
    const char* cA = (const char*)g.A + (size_t)cur.pm * tstep + (size_t)cur.k0 * kstep; const char* cB = (const char*)g.Bt + (size_t)cur.pn * tstep + (size_t)cur.k0 * kstep;
    PG8_STAGE(PG8_SB(0, 0), cB, voffB); PG8_STAGE(PG8_SA(0, 0), cA, voffA); PG8_STAGE(PG8_SB(0, 1), cB + hstep, voffB); PG8_STAGE(PG8_SA(0, 1), cA + hstep, voffA);
    if (wr == 1) PG8_BAR;
    PG8_WAIT_V(4); PG8_BAR;
    PG8_STAGE(PG8_SB(1, 0), cB + kstep, voffB); PG8_STAGE(PG8_SA(1, 0), cA + kstep, voffA); PG8_STAGE(PG8_SB(1, 1), cB + hstep + kstep, voffB);
    PG8_WAIT_V(6); PG8_BAR;
    for (;;) {
        const bool has_next = S.next(ui + 1, nxt);
        const char* nA = has_next ? (const char*)g.A + (size_t)nxt.pm * tstep + (size_t)nxt.k0 * kstep : cA; const char* nB = has_next ? (const char*)g.Bt + (size_t)nxt.pn * tstep + (size_t)nxt.k0 * kstep : cB;
        const int nt = cur.nt;
        for (int t = 0; t < nt; t += 2) {
            const bool last = (t == nt - 2);
            const char* a1 = cA + (size_t)(t + 1) * kstep;
            const char* a2 = last ? nA : cA + (size_t)(t + 2) * kstep; const char* b2 = last ? nB : cB + (size_t)(t + 2) * kstep;
            const char* a3 = a2 + kstep; const char* b3 = b2 + kstep;
            PG8_LDB(B0, 0, 0); PG8_SCHED; PG8_LDA(At, 0, 0); PG8_STAGE(PG8_SA(1, 1), a1 + hstep, voffA);
            PG8_WAIT_L(8); PG8_BAR; PG8_WAIT_L(0); PG8_MMA(0, 0, At, B0); PG8_BAR; PG8_SCHED;
            PG8_LDB(B1, 0, 1); PG8_STAGE(PG8_SB(0, 0), b2, voffB);
            PG8_BAR; PG8_WAIT_L(0); PG8_MMA(0, 1, At, B1); PG8_BAR;
            PG8_LDA(At, 0, 1); PG8_STAGE(PG8_SA(0, 0), a2, voffA);
            PG8_BAR; PG8_WAIT_L(0); PG8_MMA(1, 0, At, B0); PG8_BAR; PG8_SCHED;
            PG8_STAGE(PG8_SB(0, 1), b2 + hstep, voffB);
            PG8_WAIT_V(6); PG8_BAR; PG8_MMA(1, 1, At, B1); PG8_BAR;
            PG8_LDB(B0, 1, 0); PG8_SCHED; PG8_LDA(At, 1, 0); PG8_STAGE(PG8_SA(0, 1), a2 + hstep, voffA);
            PG8_WAIT_L(8); PG8_BAR; PG8_WAIT_L(0); PG8_MMA(0, 0, At, B0); PG8_BAR; PG8_SCHED;
            PG8_LDB(B1, 1, 1); PG8_STAGE(PG8_SB(1, 0), b3, voffB);
            PG8_BAR; PG8_WAIT_L(0); PG8_MMA(0, 1, At, B1); PG8_BAR;
            PG8_LDA(At, 1, 1); PG8_STAGE(PG8_SA(1, 0), a3, voffA);
            PG8_BAR; PG8_WAIT_L(0); PG8_MMA(1, 0, At, B0); PG8_BAR; PG8_SCHED;
            PG8_STAGE(PG8_SB(1, 1), b3 + hstep, voffB);
            PG8_WAIT_V(6); PG8_BAR; PG8_MMA(1, 1, At, B1); PG8_BAR;
        }
        if (cur.sub < 0) { int fr_ = fr, fq_ = fq; asm volatile("" : "+v"(fr_), "+v"(fq_)); E(acc, cur, wr, wc, fr_, fq_); }
        else {
            int t_ = tid; asm volatile("" : "+v"(t_));
            u32x4* sp = slab + (size_t)cur.sub * 16 * 512 + t_;
#pragma unroll
            for (int a = 0; a < 2; ++a)
#pragma unroll
                for (int b = 0; b < 2; ++b)
#pragma unroll
                    for (int m = 0; m < 4; ++m) {
                        float o[8] = {acc[a][b][m][0][0], acc[a][b][m][0][1], acc[a][b][m][0][2], acc[a][b][m][0][3], acc[a][b][m][1][0], acc[a][b][m][1][1], acc[a][b][m][1][2], acc[a][b][m][1][3]};
                        sp[(size_t)((a * 2 + b) * 4 + m) * 512] = pack8(o);
                    }
        }
        if (!has_next) break;
#pragma unroll
        for (int a = 0; a < 2; ++a)
#pragma unroll
            for (int b = 0; b < 2; ++b)
#pragma unroll
                for (int m = 0; m < 4; ++m)
#pragma unroll
                    for (int n = 0; n < 2; ++n) acc[a][b][m][n] = (f32x4){0.f, 0.f, 0.f, 0.f};
        cur = nxt; cA = nA; cB = nB; ++ui;
    }
    PG8_WAIT_V(0);
    if (wr == 0) PG8_BAR;
    PG8_BAR;
#undef PG8_SA
#undef PG8_SB
#undef PG8_STAGE
#undef PG8_LDA
#undef PG8_LDB
#undef PG8_MMA
#undef PG8_WAIT_V
#undef PG8_WAIT_L
#undef PG8_BAR
#undef PG8_SCHED
}
}
using pg8::Unit;

__device__ __forceinline__ void rows_rs8(const float* ss, int row0  , int fq, float (&rsv)[8]) {
    f32x4 part[8];
#pragma unroll
    for (int i = 0; i < 8; ++i) part[i] = *(const f32x4*)(ss + (size_t)(row0 + (i >> 2) * 128 + (i & 3) * 16) * 16 + 4 * fq);
#pragma unroll
    for (int i = 0; i < 8; ++i) {
        float t = (part[i][0] + part[i][1]) + (part[i][2] + part[i][3]);
        t += __shfl_xor(t, 16); t += __shfl_xor(t, 32);
        rsv[i] = rsqrtf(t * (1.f / 1024.f) + 1e-6f);
    }
}
struct EpiGU {
    const float* ss; bf16_t* act;
    __device__ __forceinline__ void operator()(const f32x4 (&acc)[2][2][4][2], const Unit& u, int wr, int wc, int fr, int fq) const {
        const int col = u.pn * 128 + wc * 32 + 8 * fq;
        const int row0 = u.pm * 256 + wr * 64 + fr;
        float rsv[8]; rows_rs8(ss, row0, fq, rsv);
#pragma unroll
        for (int ai = 0; ai < 2; ++ai)
#pragma unroll
            for (int m = 0; m < 4; ++m) {
                const int r = row0 + ai * 128 + m * 16;
                const float rs = rsv[ai * 4 + m];
                float o[8];
#pragma unroll
                for (int n = 0; n < 2; ++n) {
                    const f32x4 gt = acc[ai][0][m][n] * rs, gu = gt * (acc[ai][1][m][n] * rs), ex = gt * (-1.44269504089f);
                    f32x4 den; den[0] = __builtin_amdgcn_exp2f(ex[0]); den[1] = __builtin_amdgcn_exp2f(ex[1]); den[2] = __builtin_amdgcn_exp2f(ex[2]); den[3] = __builtin_amdgcn_exp2f(ex[3]);
                    den = den + 1.0f;
                    f32x4 rc; rc[0] = frcp(den[0]); rc[1] = frcp(den[1]); rc[2] = frcp(den[2]); rc[3] = frcp(den[3]);
                    const f32x4 res = gu * rc;
                    o[n * 4 + 0] = res[0]; o[n * 4 + 1] = res[1]; o[n * 4 + 2] = res[2]; o[n * 4 + 3] = res[3];
                }
                *(u32x4*)(act + (size_t)r * FF + col) = pack8(o);
            }
    }
};
struct EpiRes {
    bf16_t* XB; float* ssout; float scale;
    __device__ __forceinline__ void operator()(const f32x4 (&acc)[2][2][4][2], const Unit& u, int wr, int wc, int fr, int fq) const {
        const int row0 = u.pm * 256 + wr * 64 + fr, col0 = u.pn * 256 + wc * 32 + 8 * fq;
#pragma unroll
        for (int ai = 0; ai < 2; ++ai) {
            u32x4 xv[4][2];
#pragma unroll
            for (int m = 0; m < 4; ++m)
#pragma unroll
                for (int bj = 0; bj < 2; ++bj) xv[m][bj] = *(const u32x4*)(XB + (size_t)(row0 + ai * 128 + m * 16) * D + col0 + bj * 128);
#pragma unroll
            for (int m = 0; m < 4; ++m) {
                const int r = row0 + ai * 128 + m * 16;
                float ssum = 0.f;
#pragma unroll
                for (int bj = 0; bj < 2; ++bj) {
                    float o[8]; unpack8(xv[m][bj], o);
                    const f32x4 n0 = (f32x4){o[0], o[1], o[2], o[3]} + acc[ai][bj][m][0] * scale, n1 = (f32x4){o[4], o[5], o[6], o[7]} + acc[ai][bj][m][1] * scale;
                    o[0] = n0[0]; o[1] = n0[1]; o[2] = n0[2]; o[3] = n0[3]; o[4] = n1[0]; o[5] = n1[1]; o[6] = n1[2]; o[7] = n1[3];
                    *(u32x4*)(XB + (size_t)r * D + col0 + bj * 128) = pack8(o);
                    const f32x4 sq = n0 * n0 + n1 * n1;
                    ssum += (sq[0] + sq[1]) + (sq[2] + sq[3]);
                }
                ssum += __shfl_xor(ssum, 16); ssum += __shfl_xor(ssum, 32);
                if (fq == 0) ssout[(size_t)r * 16 + u.pn * 4 + wc] = ssum;
            }
        }
    }
};
struct EpiRKV {
    unsigned char* ws; unsigned char* dob;
    __device__ __forceinline__ void operator()(const f32x4 (&acc)[2][2][4][2], const Unit& u, int wr, int wc, int fr, int fq) const {
        if (u.pn < 12) {
            bf16_t* base = (u.pn < 8) ? (bf16_t*)(ws + B_R + (size_t)(u.pn >> 2) * ROWB) : (bf16_t*)(dob + DO_XB);
#pragma unroll
            for (int ai = 0; ai < 2; ++ai)
#pragma unroll
                for (int m = 0; m < 4; ++m) {
                    const int row = u.pm * 256 + ai * 128 + wr * 64 + m * 16 + fr;
#pragma unroll
                    for (int bj = 0; bj < 2; ++bj) {
                        const int c = (u.pn & 3) * 256 + bj * 128 + wc * 32 + 8 * fq;
                        float o[8] = {acc[ai][bj][m][0][0], acc[ai][bj][m][0][1], acc[ai][bj][m][0][2], acc[ai][bj][m][0][3], acc[ai][bj][m][1][0], acc[ai][bj][m][1][1], acc[ai][bj][m][1][2], acc[ai][bj][m][1][3]};
                        *(u32x4*)(base + (size_t)row * D + c) = pack8(o);
                    }
                }
        } else {
#pragma unroll
            for (int ai = 0; ai < 2; ++ai)
#pragma unroll
                for (int m = 0; m < 4; ++m) {
                    const int row = u.pm * 256 + ai * 128 + wr * 64 + m * 16 + fr;
#pragma unroll
                    for (int bj = 0; bj < 2; ++bj) {
                        const int c = (u.pn - 12) * 256 + bj * 128 + wc * 32 + 8 * fq;
                        if (c >= 384) continue;
                        float o[8];
#pragma unroll
                        for (int n = 0; n < 2; ++n)
#pragma unroll
                            for (int j = 0; j < 4; ++j) {
                                const float a = acc[ai][bj][m][n][j]; float val;
                                if (c < 64) val = 1.f - 2.f * frcp(1.f + __expf(2.f * a));
                                else if (c < 128) val = a;
                                else if (c < 288) val = fsigmoid(a);
                                else val = 0.f;
                                o[n * 4 + j] = val;
                            }
                        *(u32x4*)((bf16_t*)(dob + DO_L1) + (size_t)row * 384 + c) = pack8(o);
                    }
                }
        }
    }
};
struct EpiL2 {
    unsigned char* ws; const float* w0; const float* a0;
    __device__ __forceinline__ void operator()(const f32x4 (&acc)[2][2][4][2], const Unit& u, int wr, int wc, int fr, int fq) const {
        const int kind = u.pn >> 2;
        bf16_t* base = (bf16_t*)(ws + (kind == 2 ? L_G : B_LW + (size_t)kind * ROWB));
        const float* bsrc = kind == 0 ? w0 : a0;
        const float bmul = kind == 2 ? 0.f : 1.f;
        f32x4 bvv[2][2];
#pragma unroll
        for (int bj = 0; bj < 2; ++bj)
#pragma unroll
            for (int n = 0; n < 2; ++n) bvv[bj][n] = *(const f32x4*)(bsrc + (u.pn & 3) * 256 + bj * 128 + wc * 32 + 8 * fq + 4 * n) * bmul;
#pragma unroll
        for (int ai = 0; ai < 2; ++ai)
#pragma unroll
            for (int m = 0; m < 4; ++m) {
                const int row = u.pm * 256 + ai * 128 + wr * 64 + m * 16 + fr;
#pragma unroll
                for (int bj = 0; bj < 2; ++bj) {
                    const int c = (u.pn & 3) * 256 + bj * 128 + wc * 32 + 8 * fq;
                    float o[8];
#pragma unroll
                    for (int n = 0; n < 2; ++n) {
                        const f32x4 z = acc[ai][bj][m][n] + bvv[bj][n];
                        f32x4 res = z;
                        if (kind < 2) {
                            const f32x4 ex = z * (-1.44269504089f);
                            f32x4 den; den[0] = __builtin_amdgcn_exp2f(ex[0]); den[1] = __builtin_amdgcn_exp2f(ex[1]); den[2] = __builtin_amdgcn_exp2f(ex[2]); den[3] = __builtin_amdgcn_exp2f(ex[3]);
                            den = den + 1.0f;
                            res[0] = frcp(den[0]); res[1] = frcp(den[1]); res[2] = frcp(den[2]); res[3] = frcp(den[3]);
                            res = res * (kind == 0 ? -0.60653065971f : 1.0f);
                        }
                        o[n * 4 + 0] = res[0]; o[n * 4 + 1] = res[1]; o[n * 4 + 2] = res[2]; o[n * 4 + 3] = res[3];
                    }
                    *(u32x4*)(base + (size_t)row * D + c) = pack8(o);
                }
            }
    }
};
struct EpiCI {
    const float* ss; bf16_t* U; bf16_t* GB; float* out;
    __device__ __forceinline__ void operator()(const f32x4 (&acc)[2][2][4][2], const Unit& u, int wr, int wc, int fr, int fq) const {
        float rsv[8]; rows_rs8(ss, u.pm * 256 + wr * 64 + fr, fq, rsv);
#pragma unroll
        for (int ai = 0; ai < 2; ++ai)
#pragma unroll
            for (int m = 0; m < 4; ++m) {
                const int row = u.pm * 256 + ai * 128 + wr * 64 + m * 16 + fr;
                const float rs = rsv[ai * 4 + m];
                if (u.pn < 8) {
                    const int c = u.pn * 128 + wc * 32 + 8 * fq;
                    float o[8];
#pragma unroll
                    for (int n = 0; n < 2; ++n)
#pragma unroll
                        for (int j = 0; j < 4; ++j) o[n * 4 + j] = (acc[ai][0][m][n][j] * rs) * (acc[ai][1][m][n][j] * rs);
                    *(u32x4*)(U + (size_t)row * D + c) = pack8(o);
                    if (row < M) {
                        int t, T, seq; row_info(row, t, T, seq);
                        if (t >= T - 2) {
                            float* op = (seq < 8) ? out + O_CVP + ((size_t)seq * 2 + (t - (T - 2))) * D + c : out + O_CVS + ((size_t)(seq - 8) * 2 + (t - (T - 2))) * D + c;
                            *(f32x4*)op = (f32x4){o[0], o[1], o[2], o[3]}; *(f32x4*)(op + 4) = (f32x4){o[4], o[5], o[6], o[7]};
                        }
                    }
                } else {
#pragma unroll
                    for (int bj = 0; bj < 2; ++bj) {
                        const int c = (u.pn - 8) * 256 + bj * 128 + wc * 32 + 8 * fq;
                        float o[8];
#pragma unroll
                        for (int n = 0; n < 2; ++n)
#pragma unroll
                            for (int j = 0; j < 4; ++j) o[n * 4 + j] = acc[ai][bj][m][n][j] * rs;
                        *(u32x4*)(GB + (size_t)row * D + c) = pack8(o);
                    }
                }
            }
    }
};

struct TSrc { const float* p; int ld; int vk; int vc; const float* scale; int smode; };
__device__ __forceinline__ void tblock(LAS float* tile, const TSrc s, bf16_t* dst  , int kdst, const int tid) {
    const int kr = tid >> 4, c4 = (tid & 15) * 4;
    __syncthreads();
#pragma unroll
    for (int hf = 0; hf < 2; ++hf) {
        const int k = kr + 32 * hf;
        f32x4 v = (f32x4){0.f, 0.f, 0.f, 0.f};
        if (k < s.vk && c4 < s.vc) {
            v = *(const f32x4*)(s.p + (size_t)k * s.ld + c4);
            if (s.smode) { float sc = s.scale[k]; if (s.smode == 2) sc = 1.f - sc; v *= sc; }
        }
        tile[k * 65 + c4 + 0] = v[0]; tile[k * 65 + c4 + 1] = v[1]; tile[k * 65 + c4 + 2] = v[2]; tile[k * 65 + c4 + 3] = v[3];
    }
    __syncthreads();
    const int n = tid >> 3, k8 = (tid & 7) * 8;
    float o[8];
#pragma unroll
    for (int j = 0; j < 8; ++j) o[j] = tile[(k8 + j) * 65 + n];
    *(u32x4*)(dst + (size_t)n * kdst + k8) = pack8(o);
}
enum { T_GU = 0, T_DN, T_RKV, T_L2, T_PLAIN, T_WIN };
__device__ __forceinline__ void convert(LAS float* tile, const Ctx& cx, int type, int f, bf16_t* dst, int wg, int nwg) {
    int Nd, Kd;
    switch (type) { case T_GU: Nd = 5632; Kd = 1024; break; case T_DN: Nd = 1024; Kd = 2816; break; case T_RKV: Nd = 3584; Kd = 2048; break;
                    case T_L2: Nd = 3072; Kd = 384; break; case T_WIN: Nd = 3072; Kd = 1024; break; default: Nd = 1024; Kd = 1024; break; }
    const int nkb = Kd / 64, nblk = (Nd / 64) * nkb;
    for (int blk = wg; blk < nblk; blk += nwg) {
        const int nb = blk / nkb, kb = blk - nb * nkb, n0 = nb * 64, kd0 = kb * 64;
        TSrc s; s.p = nullptr; s.ld = 0; s.vk = 0; s.vc = 0; s.scale = nullptr; s.smode = 0;
        if (type == T_GU) {
            const int pn = n0 >> 8, bj = (n0 >> 7) & 1, i0 = n0 & 127, c0 = bj * FF + 128 * pn + i0;
            s.p = cx.p->in[7] + (size_t)f * D * 2 * FF + (size_t)kd0 * (2 * FF) + c0; s.ld = 2 * FF; s.vk = 64; s.vc = 64; s.scale = cx.p->in[6] + f * D + kd0; s.smode = 1;
        } else if (type == T_DN) {
            s.p = cx.p->in[8] + (size_t)f * FF * D + (size_t)kd0 * D + n0; s.ld = D; s.vk = 64; s.vc = 64;
        } else if (type == T_RKV) {
            const int hf = kd0 >= 1024, ks = kd0 & 1023; s.smode = hf ? 1 : 2; s.vk = 64;
            if (n0 < 3072) { const int pj = n0 >> 10, c0 = n0 & 1023, mi = pj == 0 ? 0 : (pj == 1 ? 2 : 3);
                s.p = cx.p->in[12] + (size_t)pj * D * D + (size_t)ks * D + c0; s.ld = D; s.vc = 64; s.scale = cx.p->in[11] + mi * D + ks; }
            else { const int j0 = n0 - 3072;
                if (j0 < 64) { s.p = cx.p->in[14] + (size_t)ks * 64 + j0; s.ld = 64; s.vc = 64; s.scale = cx.p->in[11] + 1 * D + ks; }
                else if (j0 < 128) { s.p = cx.p->in[17] + (size_t)ks * 64 + (j0 - 64); s.ld = 64; s.vc = 64; s.scale = cx.p->in[11] + 4 * D + ks; }
                else if (j0 < 288) { const int c0 = j0 - 128; s.p = cx.p->in[19] + (size_t)ks * 160 + c0; s.ld = 160; s.vc = (160 - c0) < 64 ? (160 - c0) : 64; s.scale = cx.p->in[11] + 5 * D + ks; }
                else { s.vk = 0; s.vc = 0; s.smode = 0; s.p = cx.p->in[14]; } }
        } else if (type == T_L2) {
            s.p = cx.p->in[15];
            if (n0 < 1024) { if (kd0 == 0) { s.p = cx.p->in[15] + n0; s.ld = D; s.vk = 64; s.vc = 64; } }
            else if (n0 < 2048) { if (kd0 == 64) { s.p = cx.p->in[18] + (n0 - 1024); s.ld = D; s.vk = 64; s.vc = 64; } }
            else { if (kd0 >= 128 && kd0 < 288) { const int k0 = kd0 - 128; s.p = cx.p->in[20] + (size_t)k0 * D + (n0 - 2048); s.ld = D; s.vk = (160 - k0) < 64 ? (160 - k0) : 64; s.vc = 64; } }
        } else if (type == T_WIN) {
            int c0;
            if (n0 < 2048) { const int pn = n0 >> 8, bj = (n0 >> 7) & 1, i0 = n0 & 127; c0 = (bj == 0 ? 1024 : 2048) + 128 * pn + i0; } else c0 = n0 - 2048;
            s.p = cx.p->in[27] + (size_t)kd0 * 3072 + c0; s.ld = 3072; s.vk = 64; s.vc = 64; s.scale = cx.p->in[9] + D + kd0; s.smode = 1;
        } else {
            s.p = cx.p->in[f] + (size_t)kd0 * D + n0; s.ld = D; s.vk = 64; s.vc = 64;
        }
        tblock(tile, s, dst + (size_t)n0 * Kd + kd0, Kd, cx.tid);
    }
}

__device__ __forceinline__ void ld8f(const float* p, float* o) { const f32x4 a = *(const f32x4*)p, b = *(const f32x4*)(p + 4); o[0] = a[0]; o[1] = a[1]; o[2] = a[2]; o[3] = a[3]; o[4] = b[0]; o[5] = b[1]; o[6] = b[2]; o[7] = b[3]; }
__device__ __forceinline__ void ld8b(const bf16_t* p, float* o) { unpack8(*(const u32x4*)p, o); }
__device__ __forceinline__ void phase_x0(const Ctx& cx, bf16_t* XB, float* ss0) {
    const int wave = cx.tid >> 6, lane = cx.tid & 63;
    for (int m = cx.bid * 8 + wave; m < MPAD; m += cx.G * 8) {
        const float* src = nullptr;
        if (m < MP) { const int b = m / PT, t = m - b * PT; src = t < NMETA ? cx.p->in[5] + (size_t)t * D : cx.p->in[0] + ((size_t)b * PTX + (t - NMETA)) * D; }
        else if (m < M) src = cx.p->in[1] + (size_t)(m - MP) * D;
        float s = 0.f;
#pragma unroll
        for (int i = 0; i < 4; ++i) {
            const int c = lane * 4 + i * 256;
            f32x4 v = src ? *(const f32x4*)(src + c) : (f32x4){0.f, 0.f, 0.f, 0.f};
            u32x2 pk; pk[0] = cvt_pk_bf16(v[0], v[1]); pk[1] = cvt_pk_bf16(v[2], v[3]);
            *(u32x2*)(XB + (size_t)m * D + c) = pk;
            s += v[0] * v[0] + v[1] * v[1] + v[2] * v[2] + v[3] * v[3];
        }
        s = wave_sum(s);
        if (lane < 16) ss0[(size_t)m * 16 + lane] = lane == 0 ? s : 0.f;
    }
}
__device__ __forceinline__ void phase_mix(const Ctx& cx, const bf16_t* XB, const float* ss, bf16_t* HH) {
    const int c = (cx.tid & 127) * 8, sub = cx.tid >> 7;
    float g[8];
    { const f32x4 g0 = *(const f32x4*)(cx.p->in[9] + c), g1 = *(const f32x4*)(cx.p->in[9] + c + 4); g[0] = g0[0]; g[1] = g0[1]; g[2] = g0[2]; g[3] = g0[3]; g[4] = g1[0]; g[5] = g1[1]; g[6] = g1[2]; g[7] = g1[3]; }
    for (int m = cx.bid * 4 + sub; m < MPAD; m += cx.G * 4) {
        float hn[8], hp[8];
        if (m < M) {
            int t, T, seq; row_info(m, t, T, seq);
            const float rs = row_rs(ss, m);
            float xc[8]; ld8b(XB + (size_t)m * D + c, xc);
#pragma unroll
            for (int j = 0; j < 8; ++j) hn[j] = xc[j] * rs * g[j];
            if (t > 0) {
                const float rp = row_rs(ss, m - 1);
                float xp[8]; ld8b(XB + (size_t)(m - 1) * D + c, xp);
#pragma unroll
                for (int j = 0; j < 8; ++j) hp[j] = xp[j] * rp * g[j];
            } else if (seq >= 8) {
                const float* sp = cx.p->in[3] + (size_t)(seq - 8) * D + c;
                const f32x4 y0 = *(const f32x4*)sp, y1 = *(const f32x4*)(sp + 4);
#pragma unroll
                for (int j = 0; j < 4; ++j) { hp[j] = y0[j]; hp[4 + j] = y1[j]; }
            } else {
#pragma unroll
                for (int j = 0; j < 8; ++j) hp[j] = 0.f;
            }
            if (t == T - 1) {
                float* op = (seq < 8) ? cx.p->out + O_SHP + (size_t)seq * D + c : cx.p->out + O_SHS + (size_t)(seq - 8) * D + c;
                *(f32x4*)op = (f32x4){hn[0], hn[1], hn[2], hn[3]}; *(f32x4*)(op + 4) = (f32x4){hn[4], hn[5], hn[6], hn[7]};
            }
        } else {
#pragma unroll
            for (int j = 0; j < 8; ++j) { hn[j] = 0.f; hp[j] = 0.f; }
        }
        *(u32x4*)(HH + (size_t)m * 2048 + c) = pack8(hn);
        *(u32x4*)(HH + (size_t)m * 2048 + 1024 + c) = pack8(hp);
    }
}
__device__ __forceinline__ void phase_post(const Ctx& cx, const bf16_t* YP, const bf16_t* YS, const float* CB, const bf16_t* V, const bf16_t* G, bf16_t* O) {
    const int c = (cx.tid & 127) * 8, sub = cx.tid >> 7;
    float lnw[8], lnb[8];
    ld8f(cx.p->in[24] + c, lnw); ld8f(cx.p->in[25] + c, lnb);
    for (int m = cx.bid * 4 + sub; m < MPAD; m += cx.G * 4) {
        float o[8];
        if (m < M) {
            float y[8], v[8], g[8];
            ld8b((m < MP ? YP + (size_t)m * D : YS + (size_t)(m - MP) * D) + c, y);
            ld8b(V + (size_t)m * D + c, v); ld8b(G + (size_t)m * D + c, g);
            const float cb = CB[(size_t)m * NH + (c >> 6)];
            float s = 0.f;
#pragma unroll
            for (int j = 0; j < 8; ++j) s += y[j];
            s = allreduce8(s);
            const float mean = s * (1.f / 64.f);
            float vs = 0.f;
#pragma unroll
            for (int j = 0; j < 8; ++j) { y[j] -= mean; vs += y[j] * y[j]; }
            vs = allreduce8(vs);
            const float rstd = rsqrtf(vs * (1.f / 64.f) + 64e-5f);
#pragma unroll
            for (int j = 0; j < 8; ++j) o[j] = (y[j] * rstd * lnw[j] + lnb[j] + cb * v[j]) * g[j];
        } else {
#pragma unroll
            for (int j = 0; j < 8; ++j) o[j] = 0.f;
        }
        *(u32x4*)(O + (size_t)m * D + c) = pack8(o);
    }
}
__device__ __forceinline__ void phase_conv(const Ctx& cx, const bf16_t* U, const bf16_t* GB, bf16_t* CV) {
    const int c = (cx.tid & 127) * 8, sub = cx.tid >> 7;
    float w0[8], w1[8], w2[8];
    ld8f(cx.p->in[28] + c, w0); ld8f(cx.p->in[28] + D + c, w1); ld8f(cx.p->in[28] + 2 * D + c, w2);
    for (int m = cx.bid * 4 + sub; m < MPAD; m += cx.G * 4) {
        float o[8];
        if (m < M) {
            int t, T, seq; row_info(m, t, T, seq);
            float u2[8], u1[8], u0[8], gb[8];
            ld8b(U + (size_t)m * D + c, u2); ld8b(GB + (size_t)m * D + c, gb);
            if (t >= 1) ld8b(U + (size_t)(m - 1) * D + c, u1);
            else if (seq >= 8) ld8f(cx.p->in[4] + ((size_t)(seq - 8) * 2 + 1) * D + c, u1);
            else {
#pragma unroll
                for (int j = 0; j < 8; ++j) u1[j] = 0.f; }
            if (t >= 2) ld8b(U + (size_t)(m - 2) * D + c, u0);
            else if (seq >= 8) ld8f(cx.p->in[4] + ((size_t)(seq - 8) * 2 + t) * D + c, u0);
            else {
#pragma unroll
                for (int j = 0; j < 8; ++j) u0[j] = 0.f; }
#pragma unroll
            for (int j = 0; j < 8; ++j) o[j] = gb[j] * (w0[j] * u0[j] + w1[j] * u1[j] + w2[j] * u2[j]);
        } else {
#pragma unroll
            for (int j = 0; j < 8; ++j) o[j] = 0.f;
        }
        *(u32x4*)(CV + (size_t)m * D + c) = pack8(o);
    }
}
__device__ __forceinline__ void phase_final(const Ctx& cx, const bf16_t* XB, const float* ss) {
    const int wave = cx.tid >> 6, lane = cx.tid & 63;
    for (int m = cx.bid * 8 + wave; m < M; m += cx.G * 8) {
        float* dst;
        if (m < MP) { const int b = m / PT, t = m - b * PT; if (t < NMETA) continue; dst = cx.p->out + O_YP + ((size_t)b * PTX + (t - NMETA)) * D; }
        else dst = cx.p->out + O_YS + (size_t)(m - MP) * D;
        const float rs = row_rs(ss, m);
#pragma unroll
        for (int i = 0; i < 4; ++i) {
            const int c = lane * 4 + i * 256;
            const u32x2 xb = *(const u32x2*)(XB + (size_t)m * D + c); const f32x4 g = *(const f32x4*)(cx.p->in[10] + c);
            const f32x4 v = {bf_lo(xb[0]), bf_hi(xb[0]), bf_lo(xb[1]), bf_hi(xb[1])};
            *(f32x4*)(dst + c) = v * rs * g;
        }
    }
}

struct ScanBufs { const bf16_t* R; const bf16_t* K; const bf16_t* V; const bf16_t* LW; const bf16_t* A; bf16_t* YP; bf16_t* YS; float* CB; };
__device__ __forceinline__ void scan_item_info(int item, int& m0, int& T, int& h, int& half, int& sb) {
    if (item < 256) { const int b = item >> 5; h = (item >> 1) & 15; half = item & 1; m0 = b * PT; T = PT; sb = -1 - b; }
    else { const int q = item - 256; sb = q >> 5; h = (q >> 1) & 15; half = q & 1; m0 = MP + sb * STN; T = STN; }
}
__device__ __forceinline__ void phase_scan(LAS float* lds, const Ctx& cx, const ScanBufs B) {
    const int tid = cx.tid, G = cx.G;
    const int nitems = 256 + 4096;
    const bool consumer = tid < 256;
    const int rp = (tid >> 4) & 15, seg = tid & 15;
    const int ptid = tid - 256, tl = ptid >> 3, cs = ptid & 7;
    int ci = cx.bid, ct0 = 0, k = 0;
    f32x2 sA0 = {0.f, 0.f}, sA1 = {0.f, 0.f}, sB0 = {0.f, 0.f}, sB1 = {0.f, 0.f};
    f32x4 pf[4][2]; bool pf_valid = false;
#pragma unroll
    for (int q = 0; q < 4; ++q) { pf[q][0] = (f32x4){0.f, 0.f, 0.f, 0.f}; pf[q][1] = pf[q][0]; }

    auto prep = [&](int pi, int pt0, int buf) __attribute__((always_inline)) {
        LAS float* ob = lds + buf * 11264;
        int item, t;
        if (pi < 256) { item = pi; t = pt0 + tl; } else { item = pi + (tl >> 3) * G; t = tl & 7; }
        if (item < nitems) {
            int pm0, pT, ph, phalf, psb; scan_item_info(item, pm0, pT, ph, phalf, psb);
            if (t < pT) {
                const size_t o = (size_t)(pm0 + t) * D + ph * 64 + cs * 8;
                float kf[8], rf[8], af[8], wf[8];
                ld8b(B.K + o, kf); ld8b(B.R + o, rf); ld8b(B.A + o, af); ld8b(B.LW + o, wf);
                const u32x2 vv = *(const u32x2*)(B.V + (size_t)(pm0 + t) * D + ph * 64 + phalf * 32 + cs * 4);
                float kkc[8], kac[8];
                ld8f(cx.p->in[21] + ph * 64 + cs * 8, kkc); ld8f(cx.p->in[22] + ph * 64 + cs * 8, kac);
                float kk[8]; float n2 = 0.f;
#pragma unroll
                for (int j = 0; j < 8; ++j) { kk[j] = kf[j] * kkc[j]; n2 += kk[j] * kk[j]; }
                n2 = allreduce8(n2);
                const float inv = 1.f / fmaxf(sqrtf(n2), 1e-12f);
                float vd[8], vb[8], vk[8];
#pragma unroll
                for (int j = 0; j < 8; ++j) { kk[j] *= inv; vb[j] = kk[j] * af[j]; vk[j] = kf[j] * (1.f + (af[j] - 1.f) * kac[j]); vd[j] = __expf(wf[j]); }
                if (phalf == 0) {
                    float rkc[8]; ld8f(cx.p->in[23] + ph * 64 + cs * 8, rkc);
                    float cbv = 0.f;
#pragma unroll
                    for (int j = 0; j < 8; ++j) cbv += rf[j] * vk[j] * rkc[j];
                    cbv = allreduce8(cbv);
                    if (cs == 0) B.CB[(size_t)(pm0 + t) * NH + ph] = cbv;
                }
                LAS float* q = ob + tl * 64 + cs * 8;
                *(LAS f32x4*)(q) = (f32x4){vd[0], vd[1], vd[2], vd[3]}; *(LAS f32x4*)(q + 4) = (f32x4){vd[4], vd[5], vd[6], vd[7]};
                *(LAS f32x4*)(q + 2048) = (f32x4){kk[0], kk[1], kk[2], kk[3]}; *(LAS f32x4*)(q + 2048 + 4) = (f32x4){kk[4], kk[5], kk[6], kk[7]};
                *(LAS f32x4*)(q + 4096) = (f32x4){vb[0], vb[1], vb[2], vb[3]}; *(LAS f32x4*)(q + 4096 + 4) = (f32x4){vb[4], vb[5], vb[6], vb[7]};
                *(LAS f32x4*)(q + 6144) = (f32x4){vk[0], vk[1], vk[2], vk[3]}; *(LAS f32x4*)(q + 6144 + 4) = (f32x4){vk[4], vk[5], vk[6], vk[7]};
                *(LAS f32x4*)(q + 8192) = (f32x4){rf[0], rf[1], rf[2], rf[3]}; *(LAS f32x4*)(q + 8192 + 4) = (f32x4){rf[4], rf[5], rf[6], rf[7]};
                *(LAS f32x4*)(ob + 10240 + tl * 32 + cs * 4) = (f32x4){bf_lo(vv[0]), bf_hi(vv[0]), bf_lo(vv[1]), bf_hi(vv[1])};
            }
        }
    };
    auto yout = [&](int pi, int pt0, int ybuf) __attribute__((always_inline)) {
        int item, t;
        if (pi < 256) { item = pi; t = pt0 + tl; } else { item = pi + (tl >> 3) * G; t = tl & 7; }
        if (item < nitems) {
            int pm0, pT, ph, phalf, psb; scan_item_info(item, pm0, pT, ph, phalf, psb);
            if (t < pT) {
                const f32x4 y = *(const LAS f32x4*)(lds + 22528 + ybuf * 1024 + tl * 32 + cs * 4);
                u32x2 pk; pk[0] = cvt_pk_bf16(y[0], y[1]); pk[1] = cvt_pk_bf16(y[2], y[3]);
                bf16_t* yb = (pm0 < MP) ? B.YP + (size_t)pm0 * D : B.YS + (size_t)(pm0 - MP) * D;
                *(u32x2*)(yb + (size_t)t * D + ph * 64 + phalf * 32 + cs * 4) = pk;
            }
        }
    };
    auto run_steps = [&](int slot0, int ns) __attribute__((always_inline)) {
        const LAS float* ob = lds + (k & 1) * 11264 + seg * 4 + slot0 * 64;
        const LAS float* vbp = lds + (k & 1) * 11264 + 10240 + 2 * rp + slot0 * 32;
        LAS float* yb = lds + 22528 + (k & 1) * 1024 + 2 * rp + slot0 * 32;
#define SCAN_LOAD(P, tt) do { const int o_ = (tt) * 64; P##d = *(const LAS f32x4*)(ob + o_); P##kk = *(const LAS f32x4*)(ob + 2048 + o_); P##b = *(const LAS f32x4*)(ob + 4096 + o_); \
            P##k = *(const LAS f32x4*)(ob + 6144 + o_); P##r = *(const LAS f32x4*)(ob + 8192 + o_); P##v = *(const LAS f32x2*)(vbp + (tt) * 32); } while (0)
#define SCAN_STEP(P, q0, q1) do { \
            const f32x2 dl = {P##d[0], P##d[1]}, dh = {P##d[2], P##d[3]}, kkl = {P##kk[0], P##kk[1]}, kkh = {P##kk[2], P##kk[3]}, bl = {P##b[0], P##b[1]}, bh = {P##b[2], P##b[3]}; \
            const f32x2 kl = {P##k[0], P##k[1]}, kh = {P##k[2], P##k[3]}, rl = {P##r[0], P##r[1]}, rh = {P##r[2], P##r[3]}; \
            f32x2 pa = sA0 * kkl; pa = sA1 * kkh + pa; f32x2 pb = sB0 * kkl; pb = sB1 * kkh + pb; \
            float p0 = pa[0] + pa[1], p1 = pb[0] + pb[1]; \
            const f32x2 sdA0 = sA0 * dl + kl * P##v[0], sdA1 = sA1 * dh + kh * P##v[0], sdB0 = sB0 * dl + kl * P##v[1], sdB1 = sB1 * dh + kh * P##v[1]; \
            p0 += dpp_f<0xB1>(p0); p1 += dpp_f<0xB1>(p1); p0 += dpp_f<0x4E>(p0); p1 += dpp_f<0x4E>(p1); p0 += dpp_f<0x124>(p0); p1 += dpp_f<0x124>(p1); p0 += dpp_f<0x128>(p0); p1 += dpp_f<0x128>(p1); \
            sA0 = sdA0 - bl * p0; sA1 = sdA1 - bh * p0; sB0 = sdB0 - bl * p1; sB1 = sdB1 - bh * p1; \
            f32x2 qa = sA0 * rl; qa = sA1 * rh + qa; f32x2 qb = sB0 * rl; qb = sB1 * rh + qb; \
            q0 = qa[0] + qa[1]; q1 = qb[0] + qb[1]; } while (0)
        f32x4 Xd, Xkk, Xb, Xk, Xr, Yd, Ykk, Yb, Yk, Yr, Zd, Zkk, Zb, Zk, Zr, Wd, Wkk, Wb, Wk, Wr; f32x2 Xv, Yv, Zv, Wv;
        const bool l0 = (seg & 1) != 0, l1 = (seg & 2) != 0;
#define SCAN_YRED(a0, a1, a2, a3, tt, ok) do { \
            const float s0 = l0 ? a0 : a1, s1 = l0 ? a2 : a3, k0 = l0 ? a1 : a0, k1 = l0 ? a3 : a2; \
            const float w0 = k0 + dpp_f<0xB1>(s0), w1 = k1 + dpp_f<0xB1>(s1); \
            const float s2 = l1 ? w0 : w1, k2 = l1 ? w1 : w0; \
            float z = k2 + dpp_f<0x4E>(s2); \
            z += dpp_f<0x124>(z); z += dpp_f<0x128>(z); \
            if (seg < 4 && (ok)) yb[((tt) + (seg >> 1)) * 32 + (seg & 1)] = z; } while (0)
        __builtin_amdgcn_s_setprio(3);
        SCAN_LOAD(X, 0); SCAN_LOAD(Y, 1);
        float pv0 = 0.f, pv1 = 0.f, pv2 = 0.f, pv3 = 0.f;
        for (int t = 0; t < ns; t += 4) {
            SCAN_LOAD(Z, t + 2); SCAN_LOAD(W, t + 3);
            __builtin_amdgcn_sched_barrier(0);
            { float v0, v1, v2, v3; SCAN_STEP(X, v0, v1); SCAN_YRED(pv0, pv1, pv2, pv3, t - 2, t > 0); SCAN_STEP(Y, v2, v3); pv0 = v0; pv1 = v1; pv2 = v2; pv3 = v3; }
            __builtin_amdgcn_sched_barrier(0);
            { const int tn = (t + 4 < ns) ? t + 4 : t; SCAN_LOAD(X, tn); SCAN_LOAD(Y, tn + 1); }
            __builtin_amdgcn_sched_barrier(0);
            { float v0, v1, v2, v3; SCAN_STEP(Z, v0, v1); SCAN_YRED(pv0, pv1, pv2, pv3, t, true); SCAN_STEP(W, v2, v3); pv0 = v0; pv1 = v1; pv2 = v2; pv3 = v3; }
            __builtin_amdgcn_sched_barrier(0);
        }
        SCAN_YRED(pv0, pv1, pv2, pv3, ns - 2, true);
        __builtin_amdgcn_s_setprio(0);
#undef SCAN_YRED
#undef SCAN_LOAD
#undef SCAN_STEP
    };
    auto state_ptr = [&](int item, bool out) __attribute__((always_inline)) -> float* {
        int pm0, pT, ph, phalf, psb; scan_item_info(item, pm0, pT, ph, phalf, psb);
        const size_t o = (((size_t)psb * NH + ph) * 64 + phalf * 32 + 2 * rp) * 64 + seg * 4;
        return out ? cx.p->out + O_WKVS + o : const_cast<float*>(cx.p->in[2]) + o;
    };

    if (ci < nitems && !consumer) prep(ci, 0, 0);
    __syncthreads();
    int pci = 0, pct0 = 0; bool have_prev = false;
    while (ci < nitems) {
        int ni, nt0 = 0;
        if (ci < 256) { ni = ci; nt0 = ct0 + 32; if (nt0 >= PT) { ni = ci + G; nt0 = 0; } } else ni = ci + 4 * G;
        if (consumer) {
            const bool next_is_group = (ni >= 256) && (ni < nitems) && (ni != ci);
            if (ci < 256) {
                if (ct0 == 0) { sA0 = (f32x2){0.f, 0.f}; sA1 = sA0; sB0 = sA0; sB1 = sA0; }
                if (next_is_group) {
#pragma unroll
                    for (int q = 0; q < 4; ++q) if (ni + q * G < nitems) { const float* sp = state_ptr(ni + q * G, false); pf[q][0] = *(const f32x4*)sp; pf[q][1] = *(const f32x4*)(sp + 64); }
                    pf_valid = true;
                }
                const int ns = (PT - ct0) < 32 ? (PT - ct0) : 32;
                run_steps(0, ns);
                if (ct0 + 32 >= PT) {
                    int pm0, pT, ph, phalf, psb; scan_item_info(ci, pm0, pT, ph, phalf, psb);
                    float* sp = cx.p->out + O_WKVP + (((size_t)(-1 - psb) * NH + ph) * 64 + phalf * 32 + 2 * rp) * 64 + seg * 4;
                    *(f32x4*)sp = (f32x4){sA0[0], sA0[1], sA1[0], sA1[1]}; *(f32x4*)(sp + 64) = (f32x4){sB0[0], sB0[1], sB1[0], sB1[1]};
                }
            } else {
                f32x4 st[4][2];
#pragma unroll
                for (int q = 0; q < 4; ++q) {
                    if (pf_valid) { st[q][0] = pf[q][0]; st[q][1] = pf[q][1]; }
                    else if (ci + q * G < nitems) { const float* sp = state_ptr(ci + q * G, false); st[q][0] = *(const f32x4*)sp; st[q][1] = *(const f32x4*)(sp + 64); }
                    else { st[q][0] = (f32x4){0.f, 0.f, 0.f, 0.f}; st[q][1] = st[q][0]; }
                }
                pf_valid = false;
                if (next_is_group) {
#pragma unroll
                    for (int q = 0; q < 4; ++q) if (ni + q * G < nitems) { const float* sp = state_ptr(ni + q * G, false); pf[q][0] = *(const f32x4*)sp; pf[q][1] = *(const f32x4*)(sp + 64); }
                    pf_valid = true;
                }
#pragma unroll
                for (int q = 0; q < 4; ++q) {
                    if (ci + q * G < nitems) {
                        sA0 = (f32x2){st[q][0][0], st[q][0][1]}; sA1 = (f32x2){st[q][0][2], st[q][0][3]}; sB0 = (f32x2){st[q][1][0], st[q][1][1]}; sB1 = (f32x2){st[q][1][2], st[q][1][3]};
                        asm volatile("" :: "v"(sA0[0]), "v"(sA1[0]), "v"(sB0[0]), "v"(sB1[0]));
                        run_steps(8 * q, 8);
                        float* sp = state_ptr(ci + q * G, true);
                        *(f32x4*)sp = (f32x4){sA0[0], sA0[1], sA1[0], sA1[1]}; *(f32x4*)(sp + 64) = (f32x4){sB0[0], sB0[1], sB1[0], sB1[1]};
                    }
                }
            }
        } else {
            if (ni < nitems) prep(ni, nt0, (k + 1) & 1);
            if (have_prev) yout(pci, pct0, (k - 1) & 1);
        }
        __syncthreads();
        pci = ci; pct0 = ct0; have_prev = true;
        ci = ni; ct0 = nt0; ++k;
    }
    if (have_prev && !consumer) yout(pci, pct0, (k - 1) & 1);
    __syncthreads();
}

#define XB_TMO      128
#define XB_XCNT(j)  (256  + 64 * (j))
#define XB_XSUB(j)  (1280 + 64 * (j))
#define XB_XGEN(j)  (2304 + 64 * (j))
#define XB_TOP      3328
#define XB_TOPGEN   3392
#define XCD_BAR_WORDS 3456
#define XB_SPIN_CAP (1u << 18)
__device__ __forceinline__ unsigned xb_ld(unsigned* p)              { return __hip_atomic_load(p, __ATOMIC_RELAXED, __HIP_MEMORY_SCOPE_AGENT); }
__device__ __forceinline__ unsigned xb_add(unsigned* p, unsigned v) { return __hip_atomic_fetch_add(p, v, __ATOMIC_RELAXED, __HIP_MEMORY_SCOPE_AGENT); }
__device__ __forceinline__ unsigned xb_xcc_id() { return (unsigned)__builtin_amdgcn_s_getreg((3 << 11) | 20) & 0xFu; }
#define XB_SPIN(cond, bar) do { unsigned _sp = 0; while (cond) { __builtin_amdgcn_s_sleep(1); \
    if ((++_sp & 255u) == 0u) { if (xb_ld(&(bar)[XB_TMO])) break; if (_sp > XB_SPIN_CAP) { atomicAdd(&(bar)[XB_TMO], 1u); break; } } } } while (0)
__device__ __forceinline__ void xcd_barrier_complete(unsigned* bar, unsigned x, unsigned G, unsigned& nloc, unsigned& nx) {
    unsigned sum, cnt, mine, sp = 0u;
    for (;;) {
        sum = 0u; cnt = 0u; mine = 0u;
#pragma unroll
        for (unsigned j = 0; j < 16; ++j) { const unsigned c = xb_ld(&bar[XB_XCNT(j)]); sum += c; cnt += (c > 0u) ? 1u : 0u; mine = (j == x) ? c : mine; }
        if (sum == G) break;
        __builtin_amdgcn_s_sleep(1);
        if ((++sp & 255u) == 0u) { if (xb_ld(&bar[XB_TMO])) break; if (sp > XB_SPIN_CAP) { atomicAdd(&bar[XB_TMO], 1u); break; } }
    }
    nloc = mine > 0u ? mine : 1u; nx = cnt > 0u ? cnt : 1u;
}
__device__ __forceinline__ void xcd_barrier(unsigned* bar, volatile LAS unsigned* st, int tid, unsigned G) {
    asm volatile("s_waitcnt vmcnt(0)" ::: "memory");
    __syncthreads();
    if (tid == 0) {
        const unsigned x = xb_xcc_id();
        __builtin_amdgcn_s_waitcnt(0);
        unsigned nloc = st[0], nx = st[1];
        if (nloc == 0u) { xcd_barrier_complete(bar, x, G, nloc, nx); st[0] = nloc; st[1] = nx; }
        const unsigned old = xb_add(&bar[XB_XSUB(x)], 1u);
        const unsigned gen = old / nloc;
        if (old + 1u == (gen + 1u) * nloc) {
            __builtin_amdgcn_fence(__ATOMIC_RELEASE, "agent");
            asm volatile("s_waitcnt vmcnt(0)" ::: "memory");
            const unsigned og = xb_add(&bar[XB_TOP], 1u);
            const unsigned tg = og / nx;
            if (og + 1u == (tg + 1u) * nx) xb_add(&bar[XB_TOPGEN], 1u);
            else XB_SPIN(xb_ld(&bar[XB_TOPGEN]) == tg, bar);
            __builtin_amdgcn_fence(__ATOMIC_ACQUIRE, "agent");
            xb_add(&bar[XB_XGEN(x)], 1u);
            asm volatile("s_waitcnt vmcnt(0)" ::: "memory");
        } else {
            XB_SPIN(xb_ld(&bar[XB_XGEN(x)]) == gen, bar);
            __builtin_amdgcn_fence(__ATOMIC_ACQUIRE, "agent");
            asm volatile("s_waitcnt vmcnt(0)" ::: "memory");
        }
    }
    __syncthreads();
}

#define X_ ((float*)(ws + WS_X))
#define SS_(i) ((float*)(ws + WS_SS))
#define XB_ ((bf16_t*)(ws + WS_X))
__global__ void __launch_bounds__(NTHREADS, 2) mega(Params p) {
    extern __shared__ __attribute__((aligned(16))) unsigned char shm[];
    LAS unsigned char* lds = (LAS unsigned char*)shm;
    LAS float* ldsf = (LAS float*)shm;
    volatile LAS unsigned* bst = (volatile LAS unsigned*)(shm + 131072);
    if (threadIdx.x == 0) { bst[0] = 0u; bst[1] = 0u; (void)xb_add((unsigned*)(p.ws + WS_BAR) + XB_XCNT(xb_xcc_id()), 1u); }
    __syncthreads();
    const int wv_ = __builtin_amdgcn_readfirstlane(threadIdx.x >> 6);
    for (int ph = 0; ph < 19; ++ph) {
#ifdef REP_MASK
        for (int rep = 0; rep < 1 + ((REP_MASK >> ph) & 1); ++rep) {
#else
        { const int rep = 0;
#endif
        Ctx cx;
        { KP kp = (KP)__builtin_amdgcn_kernarg_segment_ptr(); int t_ = wv_ * 64 + (int)__builtin_amdgcn_mbcnt_hi(~0u, __builtin_amdgcn_mbcnt_lo(~0u, 0u)), b_ = blockIdx.x, g_ = gridDim.x;
          asm volatile("" : "+s"(kp), "+v"(t_), "+s"(b_), "+s"(g_));
          cx.p = kp; cx.tid = t_; cx.bid = b_; cx.G = g_; }
        unsigned char* ws = cx.p->ws;
        unsigned char* dob = (unsigned char*)cx.p->out;
        const int G = cx.G, c = cx.bid;
        int kind, f = 0;
        switch (ph) {
            case 0: kind = 0; break;
            case 1: kind = 1; f = 0; break;  case 2: kind = 2; f = 0; break;
            case 3: kind = 3; break; case 4: kind = 4; break; case 5: kind = 5; break; case 6: kind = 6; break; case 7: kind = 7; break;
            case 8: kind = 2; f = 4; break;
            case 9: kind = 1; f = 1; break;  case 10: kind = 2; f = 1; break;
            case 11: kind = 1; f = 2; break; case 12: kind = 2; f = 2; break;
            case 13: kind = 8; break; case 14: kind = 9; break;
            case 15: kind = 2; f = 5; break;
            case 16: kind = 1; f = 3; break; case 17: kind = 2; f = 3; break;
            default: kind = 10; break;
        }
        if (kind == 0) {
            phase_x0(cx, XB_, SS_(0));
            convert(ldsf, cx, T_GU, 0, (bf16_t*)(ws + WS_SLOTA), c, G);
            convert(ldsf, cx, T_DN, 0, (bf16_t*)(ws + WS_SLOTA + SZ_GU), c, G);
            if (G != 256) {
                convert(ldsf, cx, T_RKV, 0, (bf16_t*)(ws + WS_WRKV), c, G);
                convert(ldsf, cx, T_L2, 0, (bf16_t*)(ws + WS_WL2), c, G);
                convert(ldsf, cx, T_PLAIN, 26, (bf16_t*)(ws + WS_WO), c, G);
            }
        } else if (kind == 1) {
            const int ssi = f == 0 ? 0 : (f == 1 ? 2 : (f == 2 ? 3 : 5));
            const unsigned char* slot = ws + ((f & 1) ? WS_SLOTB : WS_SLOTA);
            pg8::Gemm g; g.A = XB_; g.Bt = (const bf16_t*)slot; g.K = D;
            pg8::StaticOrder S; S.init(MPAD / 256, 22, G, c, g.K);
            EpiGU E; E.ss = SS_(ssi); E.act = (bf16_t*)(ws + B_ACT);
            pg8::gemm_phase(lds, g, S, E, cx.tid);
        } else if (kind == 2) {
            pg8::Gemm g; EpiRes E; E.XB = XB_;
            if (f < 4) { g.A = (const bf16_t*)(ws + B_ACT); g.Bt = (const bf16_t*)(ws + ((f & 1) ? WS_SLOTB : WS_SLOTA) + SZ_GU); g.K = FF; E.scale = 0.5f;
                         E.ssout = SS_(f == 0 ? 1 : (f == 1 ? 3 : (f == 2 ? 4 : 6))); }
            else if (f == 4) { g.A = (const bf16_t*)(ws + B_O); g.Bt = (const bf16_t*)(ws + WS_WO); g.K = D; E.scale = 1.f; E.ssout = SS_(2); }
            else { g.A = (const bf16_t*)(ws + B_CV); g.Bt = (const bf16_t*)(ws + WS_WOUT); g.K = D; E.scale = 1.f; E.ssout = SS_(5); }
            if (rep) E.scale = 0.f;
            if (f < 4 && G == 256) {
                u32x4* slab = (u32x4*)(ws + WS_BIG + SZ_ACT);
                pg8::SplitOrder S; S.init(MPAD / 256, 4, G, c, g.K);
                pg8::gemm_phase(lds, g, S, E, cx.tid, slab);
                if (rep == 0 && f == 0 && c >= 100) {
                    convert(ldsf, cx, T_RKV, 0, (bf16_t*)(ws + WS_WRKV), c - 100, G - 100);
                    convert(ldsf, cx, T_L2, 0, (bf16_t*)(ws + WS_WL2), c - 100, G - 100);
                    convert(ldsf, cx, T_PLAIN, 26, (bf16_t*)(ws + WS_WO), c - 100, G - 100);
                }
                xcd_barrier((unsigned*)(ws + WS_BAR), bst, cx.tid, (unsigned)G);
                if (c < 160) {
                    const int lt = c >> 3;
                    pg8::Unit u; S.tile(256 + lt, u);
                    int t_ = cx.tid; asm volatile("" : "+v"(t_));
                    const int wid = t_ >> 6, lane = t_ & 63, wr = wid >> 2, wc = wid & 3, fr = lane & 15, fq = lane >> 4;
                    const u32x4* sp = slab + (size_t)(lt * 5) * 16 * 512 + t_;
                    const int row0 = u.pm * 256 + wr * 64 + fr, col0 = u.pn * 256 + wc * 32 + 8 * fq;
                    {
                        const int am = c & 7;
                        const int ai = am >> 2, m = am & 3, r = row0 + ai * 128 + m * 16;
                        f32x4 a[2][2];
#pragma unroll
                        for (int bj = 0; bj < 2; ++bj) {
                            const int idx = (ai * 2 + bj) * 4 + m;
                            float t8[8] = {0.f, 0.f, 0.f, 0.f, 0.f, 0.f, 0.f, 0.f};
#pragma unroll
                            for (int part = 0; part < 5; ++part) { float o8[8]; unpack8(sp[(size_t)(part * 16 + idx) * 512], o8);
#pragma unroll
                                for (int jj = 0; jj < 8; ++jj) t8[jj] += o8[jj]; }
                            a[bj][0] = (f32x4){t8[0], t8[1], t8[2], t8[3]}; a[bj][1] = (f32x4){t8[4], t8[5], t8[6], t8[7]};
                        }
                        float ssum = 0.f;
#pragma unroll
                        for (int bj = 0; bj < 2; ++bj) {
                            bf16_t* xp = E.XB + (size_t)r * D + col0 + bj * 128;
                            float o[8]; unpack8(*(const u32x4*)xp, o);
#pragma unroll
                            for (int jj = 0; jj < 4; ++jj) { o[jj] += a[bj][0][jj] * E.scale; o[4 + jj] += a[bj][1][jj] * E.scale; }
                            *(u32x4*)xp = pack8(o);
#pragma unroll
                            for (int jj = 0; jj < 8; ++jj) ssum += o[jj] * o[jj];
                        }
                        ssum += __shfl_xor(ssum, 16); ssum += __shfl_xor(ssum, 32);
                        if (fq == 0) E.ssout[(size_t)r * 16 + u.pn * 4 + wc] = ssum;
                    }
                }
            } else {
            pg8::StaticOrder S; S.init(MPAD / 256, 4, G, c, g.K);
            pg8::gemm_phase(lds, g, S, E, cx.tid);
            if (rep == 0) {
            const int nbusy = (MPAD / 256) * 4 - G;
            if (G > 2 * nbusy && nbusy >= 0) {
                if (c >= nbusy) {
                    const int wg = c - nbusy, nwg = G - nbusy;
                    if (f == 4) {
                        convert(ldsf, cx, T_GU, 1, (bf16_t*)(ws + WS_SLOTB), wg, nwg);
                        convert(ldsf, cx, T_DN, 1, (bf16_t*)(ws + WS_SLOTB + SZ_GU), wg, nwg);
                        convert(ldsf, cx, T_GU, 2, (bf16_t*)(ws + WS_SLOTA), wg, nwg);
                        convert(ldsf, cx, T_DN, 2, (bf16_t*)(ws + WS_SLOTA + SZ_GU), wg, nwg);
                        convert(ldsf, cx, T_WIN, 0, (bf16_t*)(ws + WS_WIN), wg, nwg);
                        convert(ldsf, cx, T_PLAIN, 29, (bf16_t*)(ws + WS_WOUT), wg, nwg);
                    } else if (f == 2 || (f == 5 && G == 256)) {
                        convert(ldsf, cx, T_GU, 3, (bf16_t*)(ws + WS_SLOTB), wg, nwg);
                        convert(ldsf, cx, T_DN, 3, (bf16_t*)(ws + WS_SLOTB + SZ_GU), wg, nwg);
                    }
                }
            } else {
                if (f == 4) {
                    convert(ldsf, cx, T_GU, 1, (bf16_t*)(ws + WS_SLOTB), c, G);
                    convert(ldsf, cx, T_DN, 1, (bf16_t*)(ws + WS_SLOTB + SZ_GU), c, G);
                    convert(ldsf, cx, T_GU, 2, (bf16_t*)(ws + WS_SLOTA), c, G);
                    convert(ldsf, cx, T_DN, 2, (bf16_t*)(ws + WS_SLOTA + SZ_GU), c, G);
                    convert(ldsf, cx, T_WIN, 0, (bf16_t*)(ws + WS_WIN), c, G);
                    convert(ldsf, cx, T_PLAIN, 29, (bf16_t*)(ws + WS_WOUT), c, G);
                } else if (f == 2) {
                    convert(ldsf, cx, T_GU, 3, (bf16_t*)(ws + WS_SLOTB), c, G);
                    convert(ldsf, cx, T_DN, 3, (bf16_t*)(ws + WS_SLOTB + SZ_GU), c, G);
                }
            }
            }
            }
        } else if (kind == 3) {
            phase_mix(cx, XB_, SS_(1), (bf16_t*)(ws + B_HH));
        } else if (kind == 4) {
            pg8::Gemm g; g.A = (const bf16_t*)(ws + B_HH); g.Bt = (const bf16_t*)(ws + WS_WRKV); g.K = 2048;
            pg8::StaticOrder S; S.init(MPAD / 256, 14, G, c, g.K);
            EpiRKV E; E.ws = ws; E.dob = dob;
            pg8::gemm_phase(lds, g, S, E, cx.tid);
        } else if (kind == 5) {
            pg8::Gemm g; g.A = (const bf16_t*)(dob + DO_L1); g.Bt = (const bf16_t*)(ws + WS_WL2); g.K = 384;
            pg8::L2Order S; S.init(MPAD / 256, 12, G, c, g.K);
            EpiL2 E; E.ws = ws; E.w0 = cx.p->in[13]; E.a0 = cx.p->in[16];
            pg8::gemm_phase(lds, g, S, E, cx.tid);
        } else if (kind == 6) {
            ScanBufs sbf; sbf.R = (const bf16_t*)(ws + B_R); sbf.K = (const bf16_t*)(ws + B_K); sbf.V = (const bf16_t*)(dob + DO_XB); sbf.LW = (const bf16_t*)(ws + B_LW);
            sbf.A = (const bf16_t*)(ws + B_A); sbf.YP = (bf16_t*)(dob + DO_YPR); sbf.YS = (bf16_t*)(ws + L_YS); sbf.CB = (float*)(ws + WS_X + ROWB);
            phase_scan(ldsf, cx, sbf);
        } else if (kind == 7) {
            phase_post(cx, (const bf16_t*)(dob + DO_YPR), (const bf16_t*)(ws + L_YS), (const float*)(ws + WS_X + ROWB), (const bf16_t*)(dob + DO_XB),
                       (const bf16_t*)(ws + L_G), (bf16_t*)(ws + B_O));
        } else if (kind == 8) {
            pg8::Gemm g; g.A = XB_; g.Bt = (const bf16_t*)(ws + WS_WIN); g.K = D;
            pg8::StaticOrder S; S.init(MPAD / 256, 12, G, c, g.K);
            EpiCI E; E.ss = SS_(4); E.U = (bf16_t*)(ws + B_U); E.GB = (bf16_t*)(ws + B_GB); E.out = cx.p->out;
            pg8::gemm_phase(lds, g, S, E, cx.tid);
        } else if (kind == 9) {
            phase_conv(cx, (const bf16_t*)(ws + B_U), (const bf16_t*)(ws + B_GB), (bf16_t*)(ws + B_CV));
        } else {
            phase_final(cx, XB_, SS_(6));
        }
        if (ph < 18) xcd_barrier((unsigned*)(ws + WS_BAR), bst, cx.tid, (unsigned)G);
        }
    }
}

extern "C" void kernel_launch(void* const* d_in, const int* in_sizes, int n_in, void* d_out, int out_size, void* d_ws, size_t ws_size, hipStream_t stream) {
    static int grid_blocks = 0;
    if (grid_blocks == 0) {
        if (n_in != 30 || (size_t)out_size != O_END || ws_size < WS_END) {
            fprintf(stderr, "kernel_launch: unexpected shapes: n_in %d out_size %d ws_size %zu (need %zu)\n", n_in, out_size, ws_size, (size_t)WS_END);
            grid_blocks = -1; return;
        }
        int dev = 0, cus = 0, per_cu = 0;
        (void)hipGetDevice(&dev);
        (void)hipDeviceGetAttribute(&cus, hipDeviceAttributeMultiprocessorCount, dev);
        (void)hipFuncSetAttribute((const void*)mega, hipFuncAttributeMaxDynamicSharedMemorySize, LDS_BYTES);
        (void)hipOccupancyMaxActiveBlocksPerMultiprocessor(&per_cu, (const void*)mega, NTHREADS, LDS_BYTES);
        if (per_cu < 1) per_cu = 1;
        grid_blocks = cus * per_cu;
        if (grid_blocks > 256) grid_blocks = 256;
    }
    if (grid_blocks < 0) return;
    (void)hipMemsetAsync((char*)d_ws, 0, WS_CTL_END, stream);
    Params p{};
    for (int i = 0; i < 30; ++i) p.in[i] = (const float*)d_in[i];
    p.out = (float*)d_out; p.ws = (unsigned char*)d_ws;
    void* args[] = {&p};
    hipError_t e = hipLaunchCooperativeKernel((const void*)mega, dim3(grid_blocks), dim3(NTHREADS), args, LDS_BYTES, stream);
    if (e != hipSuccess) fprintf(stderr, "cooperative launch failed: %s (grid %d)\n", hipGetErrorString(e), grid_blocks);
}
```
